# Optimizing an MI355X kernel written in HIP

```python
import jax, jax.numpy as jnp
from jax import lax
import numpy as np

D_MODEL = 1024
BATCH = 4
SEQ = 8192
DEPTH = 2

HEAD_DIM = 64
SB_HEADS = (3 * D_MODEL) // (8 * HEAD_DIM)
FOX_HEADS = (3 * D_MODEL) // (8 * HEAD_DIM)
SB_DIM = SB_HEADS * HEAD_DIM
FOX_DIM = FOX_HEADS * HEAD_DIM
POOL_WINDOWS = (2, 4, 8, 16)
POOL_DIM = D_MODEL // 4
POOL_GROUP = POOL_DIM // len(POOL_WINDOWS)
MIX_DIM = SB_DIM + FOX_DIM + POOL_DIM
SPLIT_POINTS = [SB_DIM, 2 * SB_DIM, 3 * SB_DIM,
                3 * SB_DIM + FOX_DIM, 3 * SB_DIM + 2 * FOX_DIM, 3 * SB_DIM + 3 * FOX_DIM,
                3 * SB_DIM + 3 * FOX_DIM + FOX_HEADS]
C_IN = 3 * SB_DIM + 3 * FOX_DIM + FOX_HEADS + POOL_DIM
Q_BLOCK = 128
MEM_LEN = 256
XA_HEADS = 4
XA_HEAD_DIM = D_MODEL // XA_HEADS
D_FF = ((8 * D_MODEL // 3 + 255) // 256) * 256
N_EXPERTS = 8
TOP_K = 2
MOE_BLOCK = 256
N_DENSE = (DEPTH + 1) // 2
N_MOE = DEPTH // 2
EPS = 1e-6

kernel_name = 'hymba_sb_fox_pool_moe_trunk'


def rmsnorm(x, g):
    xf = x.astype(jnp.float32)
    y = xf * lax.rsqrt(jnp.mean(xf * xf, axis=-1, keepdims=True) + EPS)
    return (y * g.astype(jnp.float32)).astype(x.dtype)


def _heads(t, n):
    b, s, _ = t.shape
    return t.reshape(b, s, n, HEAD_DIM).transpose(0, 2, 1, 3)


def _merge_blocks(o):
    nb, b, h, q, dh = o.shape
    return o.transpose(1, 0, 3, 2, 4).reshape(b, nb * q, h * dh)


def stick_breaking_attention(q, k, v):
    _, _, s_len, dh = q.shape
    scale = dh ** -0.5
    s_idx = jnp.arange(s_len)

    def block(i):
        t0 = i * Q_BLOCK
        qb = lax.dynamic_slice_in_dim(q, t0, Q_BLOCK, axis=2)
        z = jnp.einsum('bhqd,bhsd->bhqs', qb, k).astype(jnp.float32) * scale
        t_idx = t0 + jnp.arange(Q_BLOCK)
        mask = s_idx[None, :] < t_idx[:, None]
        log_beta = jax.nn.log_sigmoid(z)
        log_keep = jnp.where(mask, log_beta - z, 0.0)
        later = lax.cumsum(log_keep, axis=3, reverse=True) - log_keep
        w = jnp.where(mask, jnp.exp(log_beta + later), 0.0)
        return jnp.einsum('bhqs,bhsd->bhqd', w.astype(v.dtype), v)

    return _merge_blocks(lax.map(block, jnp.arange(s_len // Q_BLOCK)))


def forgetting_attention(q, k, v, log_f_cum):
    _, _, s_len, dh = q.shape
    scale = dh ** -0.5
    s_idx = jnp.arange(s_len)

    def block(i):
        t0 = i * Q_BLOCK
        qb = lax.dynamic_slice_in_dim(q, t0, Q_BLOCK, axis=2)
        cq = lax.dynamic_slice_in_dim(log_f_cum, t0, Q_BLOCK, axis=2)
        logits = (jnp.einsum('bhqd,bhsd->bhqs', qb, k).astype(jnp.float32) * scale
                  + cq[..., :, None] - log_f_cum[..., None, :])
        t_idx = t0 + jnp.arange(Q_BLOCK)
        mask = s_idx[None, :] <= t_idx[:, None]
        p = jax.nn.softmax(jnp.where(mask, logits, -jnp.inf), axis=-1)
        return jnp.einsum('bhqs,bhsd->bhqd', p.astype(v.dtype), v)

    return _merge_blocks(lax.map(block, jnp.arange(s_len // Q_BLOCK)))


def multiscale_pool(u, pool_w, pool_scale):
    _, s_len, _ = u.shape
    pos = jnp.arange(s_len)
    outs = []
    for g, win in enumerate(POOL_WINDOWS):
        ug = u[..., g * POOL_GROUP:(g + 1) * POOL_GROUP].astype(jnp.float32)
        cs = jnp.cumsum(ug, axis=1)
        cs_prev = jnp.pad(cs, ((0, 0), (win, 0), (0, 0)))[:, :s_len]
        count = jnp.minimum(pos + 1, win).astype(jnp.float32)[None, :, None]
        r = ((cs - cs_prev) / count - ug).astype(u.dtype)
        outs.append(r @ pool_w[g])
    return jnp.concatenate(outs, axis=-1) * pool_scale


def hybrid_mixer(hn, w_in, b_forget, pool_w, pool_scale, w_out):
    proj = hn @ w_in
    sq, sk, sv, fq, fk, fv, f_logit, u = jnp.split(proj, SPLIT_POINTS, axis=-1)
    sb = stick_breaking_attention(_heads(sq, SB_HEADS), _heads(sk, SB_HEADS), _heads(sv, SB_HEADS))
    log_f = jax.nn.log_sigmoid((f_logit + b_forget).astype(jnp.float32))
    log_f_cum = jnp.cumsum(log_f, axis=1).transpose(0, 2, 1)
    fox = forgetting_attention(_heads(fq, FOX_HEADS), _heads(fk, FOX_HEADS), _heads(fv, FOX_HEADS), log_f_cum)
    pool = multiscale_pool(u, pool_w, pool_scale)
    return jnp.concatenate([sb, fox, pool], axis=-1) @ w_out


def memory_cross_attention(hn, mn, wq, wkv, wo):
    b, s_len, _ = hn.shape
    m_len = mn.shape[1]
    q = (hn @ wq).reshape(b, s_len, XA_HEADS, XA_HEAD_DIM)
    k, v = jnp.split(mn @ wkv, 2, axis=-1)
    k = k.reshape(b, m_len, XA_HEADS, XA_HEAD_DIM)
    v = v.reshape(b, m_len, XA_HEADS, XA_HEAD_DIM)
    logits = jnp.einsum('bqhd,bmhd->bhqm', q, k).astype(jnp.float32) * (XA_HEAD_DIM ** -0.5)
    p = jax.nn.softmax(logits, axis=-1)
    o = jnp.einsum('bhqm,bmhd->bqhd', p.astype(v.dtype), v).reshape(b, s_len, D_MODEL)
    return o @ wo


def swiglu(h, w_gate, w_up, w_down):
    return (jax.nn.silu(h @ w_gate) * (h @ w_up)) @ w_down


def moe_swiglu(h, router_w, w_gate, w_up, w_down):
    b, s_len, d = h.shape
    xf = h.reshape(-1, d)
    n_tok = xf.shape[0]
    n_pairs = n_tok * TOP_K
    logits = (xf @ router_w).astype(jnp.float32)
    top_val, top_idx = lax.top_k(logits, TOP_K)
    gates = jax.nn.softmax(top_val, axis=-1)
    e_flat = top_idx.reshape(-1)
    tok_flat = jnp.repeat(jnp.arange(n_tok), TOP_K)
    g_flat = gates.reshape(-1)
    order = jnp.argsort(e_flat)
    e_s, tok_s, g_s = e_flat[order], tok_flat[order], g_flat[order]
    counts = jnp.bincount(e_flat, length=N_EXPERTS)
    padded = ((counts + MOE_BLOCK - 1) // MOE_BLOCK) * MOE_BLOCK
    start = jnp.cumsum(counts) - counts
    pend = jnp.cumsum(padded)
    pstart = pend - padded
    dest = pstart[e_s] + (jnp.arange(n_pairs) - start[e_s])
    n_blocks = -(-n_pairs // MOE_BLOCK) + N_EXPERTS
    n_rows = n_blocks * MOE_BLOCK
    buf_tok = jnp.zeros((n_rows,), jnp.int32).at[dest].set(tok_s.astype(jnp.int32))
    buf_g = jnp.zeros((n_rows,), jnp.float32).at[dest].set(g_s)
    blk_e = jnp.clip(jnp.searchsorted(pend, jnp.arange(n_blocks) * MOE_BLOCK, side='right'), 0, N_EXPERTS - 1)
    xs = xf[buf_tok].reshape(n_blocks, MOE_BLOCK, d)

    def expert_block(args):
        xb, e = args
        return swiglu(xb, w_gate[e], w_up[e], w_down[e])

    ys = lax.map(expert_block, (xs, blk_e)).reshape(n_rows, d)
    ys = ys * buf_g[:, None].astype(ys.dtype)
    out = jnp.zeros((n_tok, d), h.dtype).at[buf_tok].add(ys)
    return out.reshape(b, s_len, d)


def setup_inputs(seed: int = 0) -> dict:
    key = jax.random.key(seed)
    ks = jax.random.split(key, 26)
    f32 = jnp.float32

    def nrm(k, shape, fan_in):
        return jax.random.normal(k, shape, f32) * (fan_in ** -0.5)

    def gain(k, shape):
        return 1.0 + 0.05 * jax.random.normal(k, shape, f32)

    return {
        'x': jax.random.normal(ks[0], (BATCH, SEQ, D_MODEL), f32),
        'mem': jax.random.normal(ks[1], (BATCH, MEM_LEN, D_MODEL), f32),
        'mix_norm_pre': gain(ks[2], (DEPTH, D_MODEL)),
        'mix_norm_post': gain(ks[3], (DEPTH, D_MODEL)),
        'w_in': nrm(ks[4], (DEPTH, D_MODEL, C_IN), D_MODEL),
        'b_forget': 2.0 + 0.5 * jax.random.normal(ks[5], (DEPTH, FOX_HEADS), f32),
        'pool_w': nrm(ks[6], (DEPTH, len(POOL_WINDOWS), POOL_GROUP, POOL_GROUP), POOL_GROUP),
        'pool_scale': 1.0 + 0.1 * jax.random.normal(ks[7], (DEPTH, POOL_DIM), f32),
        'w_out': nrm(ks[8], (DEPTH, MIX_DIM, D_MODEL), MIX_DIM),
        'xa_norm_pre': gain(ks[9], (DEPTH, D_MODEL)),
        'xa_norm_post': gain(ks[10], (DEPTH, D_MODEL)),
        'mem_norm': gain(ks[11], (DEPTH, D_MODEL)),
        'xa_wq': nrm(ks[12], (DEPTH, D_MODEL, D_MODEL), D_MODEL),
        'xa_wkv': nrm(ks[13], (DEPTH, D_MODEL, 2 * D_MODEL), D_MODEL),
        'xa_wo': nrm(ks[14], (DEPTH, D_MODEL, D_MODEL), D_MODEL),
        'ffn_norm_pre': gain(ks[15], (DEPTH, D_MODEL)),
        'ffn_norm_post': gain(ks[16], (DEPTH, D_MODEL)),
        'dense_w_gate': nrm(ks[17], (N_DENSE, D_MODEL, D_FF), D_MODEL),
        'dense_w_up': nrm(ks[18], (N_DENSE, D_MODEL, D_FF), D_MODEL),
        'dense_w_down': nrm(ks[19], (N_DENSE, D_FF, D_MODEL), D_FF),
        'router_w': nrm(ks[20], (N_MOE, D_MODEL, N_EXPERTS), D_MODEL),
        'moe_w_gate': nrm(ks[21], (N_MOE, N_EXPERTS, D_MODEL, D_FF), D_MODEL),
        'moe_w_up': nrm(ks[22], (N_MOE, N_EXPERTS, D_MODEL, D_FF), D_MODEL),
        'moe_w_down': nrm(ks[23], (N_MOE, N_EXPERTS, D_FF, D_MODEL), D_FF),
    }


def reference(x, mem, mix_norm_pre, mix_norm_post, w_in, b_forget, pool_w, pool_scale, w_out,
              xa_norm_pre, xa_norm_post, mem_norm, xa_wq, xa_wkv, xa_wo,
              ffn_norm_pre, ffn_norm_post, dense_w_gate, dense_w_up, dense_w_down,
              router_w, moe_w_gate, moe_w_up, moe_w_down):
    h = x
    for i in range(DEPTH):
        a = hybrid_mixer(rmsnorm(h, mix_norm_pre[i]), w_in[i], b_forget[i], pool_w[i], pool_scale[i], w_out[i])
        h = h + rmsnorm(a, mix_norm_post[i])
        c = memory_cross_attention(rmsnorm(h, xa_norm_pre[i]), rmsnorm(mem, mem_norm[i]),
                                   xa_wq[i], xa_wkv[i], xa_wo[i])
        h = h + rmsnorm(c, xa_norm_post[i])
        hn = rmsnorm(h, ffn_norm_pre[i])
        j = i // 2
        if i % 2 == 0:
            f = swiglu(hn, dense_w_gate[j], dense_w_up[j], dense_w_down[j])
        else:
            f = moe_swiglu(hn, router_w[j], moe_w_gate[j], moe_w_up[j], moe_w_down[j])
        h = h + rmsnorm(f, ffn_norm_post[i])
    return h
```

```cpp
#include <hip/hip_runtime.h>
#include <cstdio>
#include <cstdint>

#ifndef MK_ONE_LAUNCH
#define MK_ONE_LAUNCH 1
#endif

namespace pg8 {
#define PG8_LAS __attribute__((address_space(3)))
typedef unsigned short bf16_t;
typedef short bf16x8 __attribute__((ext_vector_type(8)));
typedef float f32x4 __attribute__((ext_vector_type(4)));
typedef unsigned u32x4 __attribute__((ext_vector_type(4)));
constexpr int BM = 256, BK = 64, HALF = 128, HTB = HALF * BK * 2  , STAGE_BYTES = 8 * HTB, NXCD = 8, WGM = 8;

__host__ __device__ __forceinline__ int lds_byte(int r, int c) { const int st = (r >> 4) * 2 + (c >> 5), rr = r & 15, cc = c & 31, ob = rr * 64 + cc * 2; return st * 1024 + (ob ^ (((ob >> 9) & 1) << 5)); }
__host__ __device__ __forceinline__ void stage_rc(int b, int& R, int& C) { const int st = b / 1024, sb = b % 1024, swz = sb ^ (((sb >> 9) & 1) << 5); R = (st >> 1) * 16 + swz / 64; C = (st & 1) * 32 + (swz % 64) / 2; }
__host__ __device__ __forceinline__ int perm32(int rho) { const int n = rho >> 4, i = rho & 15; return 8 * (i >> 2) + 4 * n + (i & 3); }

struct Unit { int pm, pn; const char* a; const char* b; };
struct Gemm { const bf16_t* A; const bf16_t* Bt; int M, N, K; };

__device__ __forceinline__ bool order_map(int i, int G, int c, int nM, int nN, int& pm, int& pn) {
    const int nwg = nM * nN; const long L = (long)i * G + c; if (L >= nwg) return false;
    int wgid = (int)L; { const int q = nwg / NXCD, r = nwg % NXCD, xcd = wgid % NXCD, off = wgid / NXCD; wgid = (xcd < r ? xcd * (q + 1) : r * (q + 1) + (xcd - r) * q) + off; }
    const int nig = WGM * nN, gid = wgid / nig, fm = gid * WGM, gsz = (nM - fm) < WGM ? (nM - fm) : WGM;
    pm = fm + ((wgid % nig) % gsz); pn = (wgid % nig) / gsz; return true;
}
struct StaticOrder {
    int nM, nN, G, c; const char* A; const char* B; size_t tstep;
    __device__ void init(const Gemm& g, int G_, int c_) { nM = g.M / BM; nN = g.N / BM; G = G_; c = c_; A = (const char*)g.A; B = (const char*)g.Bt; tstep = (size_t)BM * g.K * 2; }
    __device__ __forceinline__ bool next(int i, Unit& u) const {
        if (!order_map(i, G, c, nM, nN, u.pm, u.pn)) return false;
        u.a = A + (size_t)u.pm * tstep; u.b = B + (size_t)u.pn * tstep; return true;
    }
};
struct MoeOrder {
    int nM, nN, G, c, pb0, pbA; const char* A; const char* W; size_t tstep, wstride; const int* blk_e;
    __device__ __forceinline__ bool next(int i, Unit& u) const {
        int pm, pn; if (!order_map(i, G, c, nM, nN, pm, pn)) return false;
        u.pm = pb0 + pm; u.pn = pn; const int e = blk_e[u.pm];
        u.a = A + (size_t)(u.pm - pbA) * tstep; u.b = W + (size_t)e * wstride + (size_t)pn * tstep; return true;
    }
};

__device__ __forceinline__ unsigned cvt_pk_bf16(float lo, float hi) { unsigned r; asm volatile("v_cvt_pk_bf16_f32 %0, %1, %2" : "=v"(r) : "v"(lo), "v"(hi)); return r; }

struct EpiBf16 {
    static constexpr bool PERM = true;
    bf16_t* O; int ldc; int pm_off;
    __device__ __forceinline__ void operator()(const f32x4 (&acc)[2][2][4][2], const Unit& u, int wr, int wc, int fr, int fq) const {
        const int row0 = (u.pm - pm_off) * BM + wr * 64 + fr; const int col0 = u.pn * BM + wc * 32 + 8 * fq;
#pragma unroll
        for (int ai = 0; ai < 2; ++ai)
#pragma unroll
            for (int m = 0; m < 4; ++m) { bf16_t* rowp = O + (size_t)(row0 + ai * HALF + m * 16) * ldc + col0;
#pragma unroll
                for (int bj = 0; bj < 2; ++bj) { const f32x4 v0 = acc[ai][bj][m][0], v1 = acc[ai][bj][m][1];
                    u32x4 w; w.x = cvt_pk_bf16(v0[0], v0[1]); w.y = cvt_pk_bf16(v0[2], v0[3]); w.z = cvt_pk_bf16(v1[0], v1[1]); w.w = cvt_pk_bf16(v1[2], v1[3]);
                    *(u32x4*)(rowp + bj * HALF) = w; } }
    }
};
__device__ __forceinline__ float silu_mul(float g, float u) { return g * __builtin_amdgcn_rcpf(1.0f + __expf(-g)) * u; }
struct EpiSwiGLU {
    static constexpr bool PERM = true;
    bf16_t* O; int ldc; int pm_off;
    __device__ __forceinline__ void operator()(const f32x4 (&acc)[2][2][4][2], const Unit& u, int wr, int wc, int fr, int fq) const {
        const int row0 = (u.pm - pm_off) * BM + wr * 64 + fr; const int col0 = u.pn * HALF + wc * 32 + 8 * fq;
#pragma unroll
        for (int ai = 0; ai < 2; ++ai)
#pragma unroll
            for (int m = 0; m < 4; ++m) { bf16_t* rowp = O + (size_t)(row0 + ai * HALF + m * 16) * ldc + col0;
                const f32x4 g0 = acc[ai][0][m][0], g1 = acc[ai][0][m][1], u0 = acc[ai][1][m][0], u1 = acc[ai][1][m][1];
                u32x4 w; w.x = cvt_pk_bf16(silu_mul(g0[0], u0[0]), silu_mul(g0[1], u0[1])); w.y = cvt_pk_bf16(silu_mul(g0[2], u0[2]), silu_mul(g0[3], u0[3]));
                w.z = cvt_pk_bf16(silu_mul(g1[0], u1[0]), silu_mul(g1[1], u1[1])); w.w = cvt_pk_bf16(silu_mul(g1[2], u1[2]), silu_mul(g1[3], u1[3]));
                *(u32x4*)rowp = w; }
    }
};

template <class Epi, class Sched, bool ALIGN_EPI = false, bool SP2 = false>
__device__ __forceinline__ void gemm_phase(PG8_LAS unsigned char* lds, const int K, const Sched& S, const Epi& E) {
    int tid_ = threadIdx.x; asm volatile("" : "+v"(tid_));
    const int tid = tid_, wid = __builtin_amdgcn_readfirstlane(tid >> 6), lane = tid & 63, wr = wid >> 2, wc = wid & 3, fr = lane & 15, fq = lane >> 4;
    const int nt = K / BK;
    unsigned voffA[2], voffB[2];
#pragma unroll
    for (int i = 0; i < 2; ++i) { int R, C; stage_rc(tid * 16 + i * 8192, R, C); const int Rb = Epi::PERM ? ((R & ~31) + perm32(R & 31)) : R;
        voffA[i] = (unsigned)(R * K + C) * 2u; voffB[i] = (unsigned)(Rb * K + C) * 2u; }
    const size_t kstep = (size_t)(BK * 2);
    const size_t hstep = (size_t)HALF * K * 2;
    const unsigned ldsw = (unsigned)wid * 1024u;
    const int aoff = lds_byte(wr * 64 + fr, fq * 8), boff = lds_byte(wc * 32 + fr, fq * 8);
#define PG8_SA(b, h) (((b) * 2 + (h)) * HTB)
#define PG8_SB(b, h) ((4 + (b) * 2 + (h)) * HTB)
#define PG8_STAGE(bufoff, gbase, voff) do { _Pragma("unroll") for (int _i = 0; _i < 2; ++_i) \
        __builtin_amdgcn_global_load_lds((const unsigned*)((const char*)(gbase) + (voff)[_i]), (PG8_LAS unsigned*)(lds + (bufoff) + ldsw + _i * 8192), 16, 0, 0); } while (0)
#define PG8_LDA(dst, b, h) do { _Pragma("unroll") for (int m = 0; m < 4; ++m) _Pragma("unroll") for (int k = 0; k < 2; ++k) dst[m][k] = *(const PG8_LAS bf16x8*)(lds + PG8_SA(b, h) + aoff + m * 2048 + k * 1024); } while (0)
#define PG8_LDB(dst, b, h) do { _Pragma("unroll") for (int n = 0; n < 2; ++n) _Pragma("unroll") for (int k = 0; k < 2; ++k) dst[n][k] = *(const PG8_LAS bf16x8*)(lds + PG8_SB(b, h) + boff + n * 2048 + k * 1024); } while (0)
#define PG8_MMA(ai, bj, At, Bt) do { __builtin_amdgcn_s_setprio(1); _Pragma("unroll") for (int m = 0; m < 4; ++m) _Pragma("unroll") for (int n = 0; n < 2; ++n) _Pragma("unroll") for (int k = 0; k < 2; ++k) \
        acc[ai][bj][m][n] = __builtin_amdgcn_mfma_f32_16x16x32_bf16(Bt[n][k], At[m][k], acc[ai][bj][m][n], 0, 0, 0); __builtin_amdgcn_s_setprio(0); } while (0)
#define PG8_WAIT_V(n) asm volatile("s_waitcnt vmcnt(" #n ")" ::: "memory")
#define PG8_WAIT_L(n) asm volatile("s_waitcnt lgkmcnt(" #n ")" ::: "memory")
#define PG8_BAR __builtin_amdgcn_s_barrier()
#define PG8_SCHED __builtin_amdgcn_sched_barrier(0)
    Unit cur, nxt; int ui = 0;
    if (!S.next(0, cur)) return;
    f32x4 acc[2][2][4][2];
#pragma unroll
    for (int a = 0; a < 2; ++a)
#pragma unroll
        for (int b = 0; b < 2; ++b)
#pragma unroll
            for (int m = 0; m < 4; ++m)
#pragma unroll
                for (int n = 0; n < 2; ++n) acc[a][b][m][n] = (f32x4){0.f, 0.f, 0.f, 0.f};
    bf16x8 At[4][2], B0[2][2], B1[2][2];
    const char* cA = cur.a; const char* cB = cur.b;
    if constexpr (SP2) {
        PG8_STAGE(PG8_SB(0, 0), cB, voffB); PG8_STAGE(PG8_SB(0, 1), cB + hstep, voffB); PG8_STAGE(PG8_SA(0, 0), cA, voffA); PG8_STAGE(PG8_SA(0, 1), cA + hstep, voffA);
        if (wr == 1) PG8_BAR;
        PG8_WAIT_V(2); PG8_BAR;
        PG8_STAGE(PG8_SB(1, 0), cB + kstep, voffB); PG8_STAGE(PG8_SA(1, 0), cA + kstep, voffA); PG8_STAGE(PG8_SB(1, 1), cB + hstep + kstep, voffB);
        PG8_WAIT_V(6); PG8_BAR;
    } else {
        PG8_STAGE(PG8_SB(0, 0), cB, voffB); PG8_STAGE(PG8_SA(0, 0), cA, voffA); PG8_STAGE(PG8_SB(0, 1), cB + hstep, voffB); PG8_STAGE(PG8_SA(0, 1), cA + hstep, voffA);
        if (wr == 1) PG8_BAR;
        PG8_WAIT_V(4); PG8_BAR;
        PG8_STAGE(PG8_SB(1, 0), cB + kstep, voffB); PG8_STAGE(PG8_SA(1, 0), cA + kstep, voffA); PG8_STAGE(PG8_SB(1, 1), cB + hstep + kstep, voffB);
        PG8_WAIT_V(6); PG8_BAR;
    }
    for (;;) {
        const bool has_next = S.next(ui + 1, nxt);
        const char* nA = has_next ? nxt.a : cA; const char* nB = has_next ? nxt.b : cB;
        for (int t = 0; t < nt; t += 2) {
            const bool last = (t == nt - 2);
            const char* a1 = cA + (size_t)(t + 1) * kstep;
            const char* a2 = last ? nA : cA + (size_t)(t + 2) * kstep; const char* b2 = last ? nB : cB + (size_t)(t + 2) * kstep;
            const char* a3 = a2 + kstep; const char* b3 = b2 + kstep;
            if constexpr (SP2) {
            PG8_LDB(B0, 0, 0); PG8_LDB(B1, 0, 1); PG8_SCHED; PG8_LDA(At, 0, 0); PG8_STAGE(PG8_SA(1, 1), a1 + hstep, voffA);
            PG8_WAIT_V(8); PG8_WAIT_L(0); PG8_BAR; PG8_MMA(0, 0, At, B0); PG8_MMA(0, 1, At, B1); PG8_BAR; PG8_SCHED;
            PG8_LDA(At, 0, 1); PG8_STAGE(PG8_SB(0, 0), b2, voffB); PG8_STAGE(PG8_SB(0, 1), b2 + hstep, voffB); PG8_STAGE(PG8_SA(0, 0), a2, voffA);
            PG8_WAIT_V(8); PG8_WAIT_L(0); PG8_BAR; PG8_MMA(1, 0, At, B0); PG8_MMA(1, 1, At, B1); PG8_BAR; PG8_SCHED;
            PG8_LDB(B0, 1, 0); PG8_LDB(B1, 1, 1); PG8_SCHED; PG8_LDA(At, 1, 0); PG8_STAGE(PG8_SA(0, 1), a2 + hstep, voffA);
            PG8_WAIT_V(8); PG8_WAIT_L(0); PG8_BAR; PG8_MMA(0, 0, At, B0); PG8_MMA(0, 1, At, B1); PG8_BAR; PG8_SCHED;
            PG8_LDA(At, 1, 1); PG8_STAGE(PG8_SB(1, 0), b3, voffB); PG8_STAGE(PG8_SB(1, 1), b3 + hstep, voffB); PG8_STAGE(PG8_SA(1, 0), a3, voffA);
            PG8_WAIT_V(8); PG8_WAIT_L(0); PG8_BAR; PG8_MMA(1, 0, At, B0); PG8_MMA(1, 1, At, B1); PG8_BAR; PG8_SCHED;
            } else {
            PG8_LDB(B0, 0, 0); PG8_SCHED; PG8_LDA(At, 0, 0); PG8_STAGE(PG8_SA(1, 1), a1 + hstep, voffA);
            PG8_WAIT_L(8); PG8_BAR; PG8_WAIT_L(0); PG8_MMA(0, 0, At, B0); PG8_BAR; PG8_SCHED;
            PG8_LDB(B1, 0, 1); PG8_STAGE(PG8_SB(0, 0), b2, voffB);
            PG8_BAR; PG8_WAIT_L(0); PG8_MMA(0, 1, At, B1); PG8_BAR;
            PG8_LDA(At, 0, 1); PG8_STAGE(PG8_SA(0, 0), a2, voffA);
            PG8_BAR; PG8_WAIT_L(0); PG8_MMA(1, 0, At, B0); PG8_BAR; PG8_SCHED;
            PG8_STAGE(PG8_SB(0, 1), b2 + hstep, voffB);
            PG8_WAIT_V(6); PG8_BAR; PG8_MMA(1, 1, At, B1); PG8_BAR;
            PG8_LDB(B0, 1, 0); PG8_SCHED; PG8_LDA(At, 1, 0); PG8_STAGE(PG8_SA(0, 1), a2 + hstep, voffA);
            PG8_WAIT_L(8); PG8_BAR; PG8_WAIT_L(0); PG8_MMA(0, 0, At, B0); PG8_BAR; PG8_SCHED;
            PG8_LDB(B1, 1, 1); PG8_STAGE(PG8_SB(1, 0), b3, voffB);
            PG8_BAR; PG8_WAIT_L(0); PG8_MMA(0, 1, At, B1); PG8_BAR;
            PG8_LDA(At, 1, 1); PG8_STAGE(PG8_SA(1, 0), a3, voffA);
            PG8_BAR; PG8_WAIT_L(0); PG8_MMA(1, 0, At, B0); PG8_BAR; PG8_SCHED;
            PG8_STAGE(PG8_SB(1, 1), b3 + hstep, voffB);
            PG8_WAIT_V(6); PG8_BAR; PG8_MMA(1, 1, At, B1); PG8_BAR;
            }
        }
        if constexpr (ALIGN_EPI) { if (wr == 0) PG8_BAR; }
        E(acc, cur, wr, wc, fr, fq);
        if (!has_next) break;
#pragma unroll
        for (int a = 0; a < 2; ++a)
#pragma unroll
            for (int b = 0; b < 2; ++b)
#pragma unroll
                for (int m = 0; m < 4; ++m)
#pragma unroll
                    for (int n = 0; n < 2; ++n) acc[a][b][m][n] = (f32x4){0.f, 0.f, 0.f, 0.f};
        cur = nxt; cA = nA; cB = nB; ++ui;
        if constexpr (ALIGN_EPI) { if (wr == 1) PG8_BAR; }
    }
    PG8_WAIT_V(0);
    if constexpr (!ALIGN_EPI) { if (wr == 0) PG8_BAR; }
    PG8_BAR;
#undef PG8_SA
#undef PG8_SB
#undef PG8_STAGE
#undef PG8_LDA
#undef PG8_LDB
#undef PG8_MMA
#undef PG8_WAIT_V
#undef PG8_WAIT_L
#undef PG8_BAR
#undef PG8_SCHED
}
}

constexpr int NBATCH = 4, SEQ = 8192, D = 1024, NTOK = NBATCH * SEQ, DEPTH = 2;
constexpr int HD = 64, NSB = 6, NFX = 6, SBD = 384, FXD = 384, POOLD = 256, CIN = 2566;
constexpr int MEML = 256, NMEM = NBATCH * MEML, XAH = 4, XAD = 256;
constexpr int DFF = 2816, NE = 8;
constexpr float EPS = 1e-6f;
constexpr int PP = 2560, C_SQ = 0, C_SK = 384, C_SV = 768, C_FQ = 1152, C_FK = 1536, C_FV = 1920, C_U = 2304;
constexpr int MAXBLK = 264, CHUNK_BLK = 132;

constexpr size_t MiB = 1u << 20;
constexpr size_t WS_CTL = 0, CTL_ZERO_BYTES = 1 * MiB;
constexpr size_t WS_WF   = 1 * MiB;
constexpr size_t WS_WR   = WS_WF + 65536;
constexpr size_t WS_BLKE = WS_WR + 32768;
constexpr size_t WS_LOGF = 2 * MiB;
constexpr size_t WS_CCUM = 3 * MiB;
constexpr size_t WS_TOKT = 4 * MiB;
constexpr size_t WS_MN   = 5 * MiB;
constexpr size_t WS_XKV  = 7 * MiB;
constexpr size_t WS_WS1  = 16 * MiB;
constexpr size_t WS_WMOE = 31 * MiB;
constexpr size_t WS_R2   = 163 * MiB;
constexpr size_t WS_R1   = 295 * MiB;
constexpr size_t WS_END  = 295 * MiB + 190316544;
constexpr size_t OW_IN = 0, OW_OUT = 5 * MiB, OW_Q = 7 * MiB, OW_KV = 9 * MiB, OW_O = 13 * MiB, OW_LAYER = 15 * MiB;
constexpr size_t WS_WS0 = WS_WMOE;
constexpr size_t WS_WGU0 = WS_WS0 + OW_LAYER;
constexpr size_t WS_WD0 = WS_WGU0 + 11 * MiB;
constexpr size_t MOE_GU_BYTES = (size_t)2 * DFF * D * 2, MOE_D_BYTES = (size_t)D * DFF * 2, MOE_E_BYTES = MOE_GU_BYTES + MOE_D_BYTES;
static_assert(WS_WD0 + MOE_D_BYTES <= WS_WMOE + 132 * MiB && 8 * MOE_E_BYTES <= 132 * MiB, "weights map");
constexpr size_t R2_HN = WS_R2, R2_MIX = WS_R2 + 64 * MiB;
constexpr size_t R1_PROJ = WS_R1;
constexpr size_t R1_A = WS_R1, R1_B = WS_R1 + 64 * MiB;
constexpr size_t R1_ACT = WS_R1;
constexpr size_t R2_XS = WS_R2;
static_assert((size_t)NTOK * DFF * 2 <= 190316544 && (size_t)CHUNK_BLK * 256 * DFF * 2 <= 190316544 && (size_t)MAXBLK * 256 * D * 2 <= 132 * MiB, "arena map");
constexpr int CW_CNT = 64;
constexpr int CW_BAR = 4096;

constexpr int RING_OFF = 0, RING_BYTES = 131072;
constexpr int LDSCTL_OFF = RING_BYTES, MISC_OFF = LDSCTL_OFF + 320;
constexpr int LDS_BYTES = 147456;
constexpr int NWAVES = 8;

#define GAS __attribute__((address_space(1)))
#define LAS __attribute__((address_space(3)))
typedef unsigned short bf16;
typedef unsigned v4u __attribute__((ext_vector_type(4)));
typedef unsigned v2u __attribute__((ext_vector_type(2)));
typedef float f32x4 __attribute__((ext_vector_type(4)));
typedef GAS unsigned gu32;
#define RLX_AGENT __ATOMIC_RELAXED, __HIP_MEMORY_SCOPE_AGENT
#define LDS_WAIT() asm volatile("s_waitcnt lgkmcnt(0)" ::: "memory")
#define VM_WAIT() asm volatile("s_waitcnt vmcnt(0)" ::: "memory")
__device__ __forceinline__ unsigned f2bf(float f) { unsigned u = __builtin_bit_cast(unsigned, f); return (u + 0x7fffu + ((u >> 16) & 1u)) >> 16; }
__device__ __forceinline__ unsigned pk2(float lo, float hi) { return f2bf(lo) | (f2bf(hi) << 16); }
__device__ __forceinline__ float bflo(unsigned u) { return __uint_as_float(u << 16); }
__device__ __forceinline__ float bfhi(unsigned u) { return __uint_as_float(u & 0xffff0000u); }
__device__ __forceinline__ float bf2f(bf16 b) { return __uint_as_float(((unsigned)b) << 16); }

#define XB_TMO      128
#define XB_XCNT(j)  (256  + 64 * (j))
#define XB_XSUB(j)  (1280 + 64 * (j))
#define XB_XGEN(j)  (2304 + 64 * (j))
#define XB_TOP      3328
#define XB_TOPGEN   3392
#define XCD_BAR_WORDS 3456
#define XB_SPIN_CAP (1u << 22)

__device__ __forceinline__ unsigned xb_ld(unsigned* p)              { return __hip_atomic_load(p, __ATOMIC_RELAXED, __HIP_MEMORY_SCOPE_AGENT); }
__device__ __forceinline__ unsigned xb_add(unsigned* p, unsigned v) { return __hip_atomic_fetch_add(p, v, __ATOMIC_RELAXED, __HIP_MEMORY_SCOPE_AGENT); }
__device__ __forceinline__ unsigned xb_xcc_id() { return (unsigned)__builtin_amdgcn_s_getreg((3 << 11) | 20) & 0xFu; }
#define XB_SPIN(cond, bar) do { unsigned _sp = 0; while (cond) { __builtin_amdgcn_s_sleep(1); \
    if ((++_sp & 255u) == 0u) { if (xb_ld(&(bar)[XB_TMO])) break; if (_sp > XB_SPIN_CAP) { atomicAdd(&(bar)[XB_TMO], 1u); break; } } } } while (0)

struct XcdBarrier { unsigned* bar; unsigned x; volatile LAS unsigned* st; };

__device__ __forceinline__ XcdBarrier xcd_barrier_post(unsigned* bar, volatile LAS unsigned* st) {
    XcdBarrier b; b.bar = bar; b.x = xb_xcc_id(); b.st = st;
    if (threadIdx.x == 0) (void)xb_add(&bar[XB_XCNT(b.x)], 1u);
    return b;
}
__device__ __forceinline__ void xcd_barrier_complete(unsigned* bar, unsigned x, unsigned& nloc, unsigned& nx) {
    const unsigned G = gridDim.x * gridDim.y * gridDim.z;
    unsigned sum, cnt, mine, sp = 0u;
    for (;;) {
        sum = 0u; cnt = 0u; mine = 0u;
#pragma unroll
        for (unsigned j = 0; j < 16; ++j) { const unsigned c = xb_ld(&bar[XB_XCNT(j)]); sum += c; cnt += (c > 0u) ? 1u : 0u; mine = (j == x) ? c : mine; }
        if (sum == G) break;
        __builtin_amdgcn_s_sleep(1);
        if ((++sp & 255u) == 0u) { if (xb_ld(&bar[XB_TMO])) break; if (sp > XB_SPIN_CAP) { atomicAdd(&bar[XB_TMO], 1u); break; } }
    }
    nloc = mine > 0u ? mine : 1u; nx = cnt > 0u ? cnt : 1u;
}
__device__ __forceinline__ void xcd_barrier(const XcdBarrier& b) {
    asm volatile("s_waitcnt vmcnt(0)" ::: "memory");
    __syncthreads();
    if (threadIdx.x == 0) {
        unsigned* bar = b.bar;
        __builtin_amdgcn_s_waitcnt(0);
        unsigned nloc = b.st[0], nx = b.st[1];
        if (nloc == 0u) { xcd_barrier_complete(bar, b.x, nloc, nx); b.st[0] = nloc; b.st[1] = nx; }
        const unsigned old = xb_add(&bar[XB_XSUB(b.x)], 1u);
        const unsigned gen = old / nloc;
        if (old + 1u == (gen + 1u) * nloc) {
            __builtin_amdgcn_fence(__ATOMIC_RELEASE, "agent");
            asm volatile("s_waitcnt vmcnt(0)" ::: "memory");
            const unsigned og = xb_add(&bar[XB_TOP], 1u);
            const unsigned tg = og / nx;
            if (og + 1u == (tg + 1u) * nx) xb_add(&bar[XB_TOPGEN], 1u);
            else XB_SPIN(xb_ld(&bar[XB_TOPGEN]) == tg, bar);
            __builtin_amdgcn_fence(__ATOMIC_ACQUIRE, "agent");
            xb_add(&bar[XB_XGEN(b.x)], 1u);
            asm volatile("s_waitcnt vmcnt(0)" ::: "memory");
        } else {
            XB_SPIN(xb_ld(&bar[XB_XGEN(b.x)]) == gen, bar);
            __builtin_amdgcn_fence(__ATOMIC_ACQUIRE, "agent");
            asm volatile("s_waitcnt vmcnt(0)" ::: "memory");
        }
    }
    __syncthreads();
}

enum In { I_X = 0, I_MEM, I_MIXPRE, I_MIXPOST, I_WIN, I_BF, I_POOLW, I_POOLS, I_WOUT, I_XAPRE, I_XAPOST, I_MEMN, I_XQ, I_XKV, I_XO, I_FFPRE, I_FFPOST,
          I_DG, I_DU, I_DD, I_RW, I_MG, I_MU, I_MD };

struct Args { const float* in[24]; float* out; unsigned char* ws; int ph_lo, ph_hi; };
__device__ __forceinline__ const __attribute__((address_space(4))) Args* kargs() { const __attribute__((address_space(4))) Args* p = (const __attribute__((address_space(4))) Args*)__builtin_amdgcn_kernarg_segment_ptr(); asm volatile("" : "+s"(p)); return p; }
#define WSB (kargs()->ws)
#define INP(i) (kargs()->in[i])
#define OUTP (kargs()->out)
struct Frame {
    LAS unsigned char* lds;
    gu32* ctl;
    int tid, lane, wave;
    int vcu, G;
};


__device__ __forceinline__ void fresh(Frame& F) { int t = threadIdx.x; asm volatile("" : "+v"(t)); F.tid = t; F.lane = t & 63; F.wave = __builtin_amdgcn_readfirstlane(t >> 6); }
__device__ __forceinline__ float wave_sum(float v) {
#pragma unroll
    for (int o = 1; o < 64; o <<= 1) v += __shfl_xor(v, o);
    return v;
}
__device__ __forceinline__ float wave_max(float v) {
#pragma unroll
    for (int o = 1; o < 64; o <<= 1) v = fmaxf(v, __shfl_xor(v, o));
    return v;
}
__device__ __forceinline__ float log_sigmoid(float x) { return x < 0.f ? x - log1pf(__expf(x)) : -log1pf(__expf(-x)); }

__device__ __forceinline__ void transpose_item(const float* W, int ldw, int col0, int k0, bf16* WT, int ldwt, int row0, LAS float* scr, int lane) {
#pragma unroll 8
    for (int i = 0; i < 32; ++i) { const int kk = 2 * i + (lane >> 5); scr[kk * 33 + (lane & 31)] = W[(size_t)(k0 + kk) * ldw + col0 + (lane & 31)]; }
    LDS_WAIT(); asm volatile("" ::: "memory");
    const int c = lane & 7;
#pragma unroll
    for (int j = 0; j < 4; ++j) { const int n = (lane >> 3) + 8 * j; const LAS float* s = scr + (8 * c) * 33 + n;
        v4u o; o.x = pk2(s[0 * 33], s[1 * 33]); o.y = pk2(s[2 * 33], s[3 * 33]); o.z = pk2(s[4 * 33], s[5 * 33]); o.w = pk2(s[6 * 33], s[7 * 33]);
        *(GAS v4u*)(WT + (size_t)(row0 + n) * ldwt + k0 + 8 * c) = o; }
    LDS_WAIT(); asm volatile("" ::: "memory");
}
__device__ __forceinline__ void transpose_mat(Frame& F, const float* W, int ldw, int col0, int ncols, int K, bf16* WT, int row0, LAS float* scr) {
    const int gw = F.vcu * NWAVES + F.wave, NGW = F.G * NWAVES; const int nkb = K / 64, nitems = nkb * (ncols / 32);
    for (int it = gw; it < nitems; it += NGW) { const int kb = it % nkb, nb = it / nkb; transpose_item(W, ldw, col0 + 32 * nb, 64 * kb, WT, K, row0 + 32 * nb, scr, F.lane); }
}
__device__ __forceinline__ void transpose_gu(Frame& F, const float* Wg, const float* Wu, bf16* WT, LAS float* scr) {
    const int gw = F.vcu * NWAVES + F.wave, NGW = F.G * NWAVES; const int nkb = D / 64, ncb = DFF / 32, nitems = 2 * nkb * ncb;
    for (int it = gw; it < nitems; it += NGW) { const int kb = it % nkb, r = it / nkb, nb = r % ncb, which = r / ncb; const int n0 = 32 * nb;
        transpose_item(which ? Wu : Wg, DFF, n0, 64 * kb, WT, D, 256 * (n0 / 128) + 128 * which + (n0 % 128), scr, F.lane); }
}
__device__ __forceinline__ void convert_layer_small(Frame& F, int l, bf16* base, LAS float* scr) {
    const float* win = INP(I_WIN) + (size_t)l * D * CIN;
    bf16* wt = base + OW_IN / 2;
    transpose_mat(F, win, CIN, 0, 2304, D, wt, 0, scr);
    transpose_mat(F, win, CIN, 2310, 256, D, wt, 2304, scr);
    transpose_mat(F, INP(I_WOUT) + (size_t)l * D * D, D, 0, D, D, base + OW_OUT / 2, 0, scr);
    transpose_mat(F, INP(I_XQ) + (size_t)l * D * D, D, 0, D, D, base + OW_Q / 2, 0, scr);
    transpose_mat(F, INP(I_XKV) + (size_t)l * D * 2 * D, 2 * D, 0, 2 * D, D, base + OW_KV / 2, 0, scr);
    transpose_mat(F, INP(I_XO) + (size_t)l * D * D, D, 0, D, D, base + OW_O / 2, 0, scr);
    float* wf = (float*)(WSB + WS_WF) + (size_t)l * 8 * D;
    for (int i = (F.vcu * NWAVES + F.wave) * 64 + F.lane; i < 6 * D; i += F.G * NWAVES * 64) { const int j = i / D, k = i % D; wf[j * D + k] = win[(size_t)k * CIN + 2304 + j]; }
}

template <int DELTA, bool WRITE_H, bool WRITE_HN, int EXTRA>
__device__ __forceinline__ void thin_rows(Frame& F, const float* h_in, const bf16* delta, const float* g_post, float* h_out, const float* g_pre, bf16* hn_out,
                                          const float* wx, const float* bfo, float* logf, int* tokt, gu32* cnt) {
    const int gw = F.vcu * NWAVES + F.wave, NGW = F.G * NWAVES, lane = F.lane;
    for (int row = gw; row < NTOK; row += NGW) {
        f32x4 v[4];
#pragma unroll
        for (int j = 0; j < 4; ++j) v[j] = *(const f32x4*)(h_in + (size_t)row * D + 4 * lane + 256 * j);
        if constexpr (DELTA != 0) {
            f32x4 d[4];
            if constexpr (DELTA == 1) {
#pragma unroll
                for (int j = 0; j < 4; ++j) { const v2u r = *(const v2u*)(delta + (size_t)row * D + 4 * lane + 256 * j); d[j] = (f32x4){bflo(r.x), bfhi(r.x), bflo(r.y), bfhi(r.y)}; }
            } else {
                const int d0 = tokt[row * 8 + 1], d1 = tokt[row * 8 + 4]; const float g0 = __int_as_float(tokt[row * 8 + 2]), g1 = __int_as_float(tokt[row * 8 + 5]);
#pragma unroll
                for (int j = 0; j < 4; ++j) { const v2u r0 = *(const v2u*)(delta + (size_t)d0 * D + 4 * lane + 256 * j), r1 = *(const v2u*)(delta + (size_t)d1 * D + 4 * lane + 256 * j);
                    d[j] = (f32x4){g0 * bflo(r0.x) + g1 * bflo(r1.x), g0 * bfhi(r0.x) + g1 * bfhi(r1.x), g0 * bflo(r0.y) + g1 * bflo(r1.y), g0 * bfhi(r0.y) + g1 * bfhi(r1.y)}; }
            }
            float ss = 0.f;
#pragma unroll
            for (int j = 0; j < 4; ++j) ss += (d[j].x * d[j].x + d[j].y * d[j].y) + (d[j].z * d[j].z + d[j].w * d[j].w);
            const float rs = rsqrtf(wave_sum(ss) * (1.f / D) + EPS);
#pragma unroll
            for (int j = 0; j < 4; ++j) { const f32x4 g = *(const f32x4*)(g_post + 4 * lane + 256 * j); v[j] = v[j] + d[j] * rs * g; }
        }
        if constexpr (WRITE_H) {
#pragma unroll
            for (int j = 0; j < 4; ++j) *(f32x4*)(h_out + (size_t)row * D + 4 * lane + 256 * j) = v[j];
        }
        if constexpr (WRITE_HN) {
            float ss = 0.f;
#pragma unroll
            for (int j = 0; j < 4; ++j) ss += (v[j].x * v[j].x + v[j].y * v[j].y) + (v[j].z * v[j].z + v[j].w * v[j].w);
            const float rs = rsqrtf(wave_sum(ss) * (1.f / D) + EPS);
#pragma unroll
            for (int j = 0; j < 4; ++j) { const f32x4 g = *(const f32x4*)(g_pre + 4 * lane + 256 * j); v[j] = v[j] * rs * g;
                v2u o; o.x = pk2(v[j].x, v[j].y); o.y = pk2(v[j].z, v[j].w); *(v2u*)(hn_out + (size_t)row * D + 4 * lane + 256 * j) = o; }
            if constexpr (EXTRA == 1) {
                float lg[6];
#pragma unroll
                for (int e = 0; e < 6; ++e) { float s = 0.f;
#pragma unroll
                    for (int j = 0; j < 4; ++j) { const f32x4 w = *(const f32x4*)(wx + e * D + 4 * lane + 256 * j); s += (v[j].x * w.x + v[j].y * w.y) + (v[j].z * w.z + v[j].w * w.w); }
                    lg[e] = wave_sum(s); }
                if (lane < 6) { float x = lg[0];
#pragma unroll
                    for (int e = 1; e < 6; ++e) x = (lane == e) ? lg[e] : x;
                    logf[(size_t)row * 8 + lane] = log_sigmoid(x + bfo[lane]); }
            }
            if constexpr (EXTRA == 2) {
                float lg[8];
#pragma unroll
                for (int e = 0; e < 8; ++e) { float s = 0.f;
#pragma unroll
                    for (int j = 0; j < 4; ++j) { const f32x4 w = *(const f32x4*)(wx + e * D + 4 * lane + 256 * j); s += (v[j].x * w.x + v[j].y * w.y) + (v[j].z * w.z + v[j].w * w.w); }
                    lg[e] = wave_sum(s); }
                int e0 = 0; float v0 = lg[0];
#pragma unroll
                for (int e = 1; e < 8; ++e) if (lg[e] > v0) { v0 = lg[e]; e0 = e; }
                int e1 = -1; float v1 = -INFINITY;
#pragma unroll
                for (int e = 0; e < 8; ++e) if (e != e0 && lg[e] > v1) { v1 = lg[e]; e1 = e; }
                if (lane == 0) {
                    const float g0 = 1.f / (1.f + __expf(v1 - v0)), g1 = 1.f - g0;
                    const unsigned p0 = __hip_atomic_fetch_add(cnt + e0, 1u, RLX_AGENT), p1 = __hip_atomic_fetch_add(cnt + e1, 1u, RLX_AGENT);
                    int* t = tokt + (size_t)row * 8; t[0] = e0; t[1] = (int)p0; t[2] = __float_as_int(g0); t[3] = e1; t[4] = (int)p1; t[5] = __float_as_int(g1);
                }
            }
        }
    }
}
__device__ __forceinline__ void mem_norm(Frame& F, const float* mem, const float* g, bf16* mn) {
    const int gw = F.vcu * NWAVES + F.wave, NGW = F.G * NWAVES, lane = F.lane;
    for (int row = gw; row < NMEM; row += NGW) {
        f32x4 v[4]; float ss = 0.f;
#pragma unroll
        for (int j = 0; j < 4; ++j) { v[j] = *(const f32x4*)(mem + (size_t)row * D + 4 * lane + 256 * j); ss += (v[j].x * v[j].x + v[j].y * v[j].y) + (v[j].z * v[j].z + v[j].w * v[j].w); }
        const float rs = rsqrtf(wave_sum(ss) * (1.f / D) + EPS);
#pragma unroll
        for (int j = 0; j < 4; ++j) { const f32x4 gg = *(const f32x4*)(g + 4 * lane + 256 * j); v[j] = v[j] * rs * gg;
            v2u o; o.x = pk2(v[j].x, v[j].y); o.y = pk2(v[j].z, v[j].w); *(v2u*)(mn + (size_t)row * D + 4 * lane + 256 * j) = o; }
    }
}
__device__ __forceinline__ void scan_logf(Frame& F, const float* logf, float* ccum) {
    if (blockIdx.x >= NBATCH * NFX) return;
    const int b = blockIdx.x / NFX, h = blockIdx.x % NFX, tid = F.tid;
    LAS float* wsum = (LAS float*)(F.lds + RING_OFF);
    float x[16]; float run = 0.f;
#pragma unroll
    for (int i = 0; i < 16; ++i) { run += logf[((size_t)b * SEQ + tid * 16 + i) * 8 + h]; x[i] = run; }
    float incl = run;
#pragma unroll
    for (int o = 1; o < 64; o <<= 1) { const float t = __shfl_up(incl, o); if (F.lane >= o) incl += t; }
    if (F.lane == 63) wsum[F.wave] = incl;
    LDS_WAIT(); __syncthreads();
    float base = incl - run;
    for (int w = 0; w < F.wave; ++w) base += wsum[w];
    float* o = ccum + ((size_t)b * NFX + h) * SEQ + tid * 16;
#pragma unroll
    for (int i = 0; i < 16; ++i) o[i] = base + x[i];
    __syncthreads();
}

__device__ __forceinline__ void load_row64(const bf16* p, float* q) {
#pragma unroll
    for (int i = 0; i < 8; ++i) { const v4u r = *(const v4u*)(p + 8 * i); q[8 * i + 0] = bflo(r.x); q[8 * i + 1] = bfhi(r.x); q[8 * i + 2] = bflo(r.y); q[8 * i + 3] = bfhi(r.y);
        q[8 * i + 4] = bflo(r.z); q[8 * i + 5] = bfhi(r.z); q[8 * i + 6] = bflo(r.w); q[8 * i + 7] = bfhi(r.w); }
}
__device__ __forceinline__ void store_row64(bf16* p, const float* o, float sc) {
#pragma unroll
    for (int i = 0; i < 8; ++i) { v4u w; w.x = pk2(o[8 * i] * sc, o[8 * i + 1] * sc); w.y = pk2(o[8 * i + 2] * sc, o[8 * i + 3] * sc); w.z = pk2(o[8 * i + 4] * sc, o[8 * i + 5] * sc); w.w = pk2(o[8 * i + 6] * sc, o[8 * i + 7] * sc);
        *(v4u*)(p + 8 * i) = w; }
}
__device__ __forceinline__ void sb_naive(Frame& F, const bf16* proj, bf16* mix) {
    const int gw = F.vcu * NWAVES + F.wave, NGW = F.G * NWAVES, lane = F.lane;
    const int NU = NBATCH * NSB * (SEQ / 64);
    for (int u = gw; u < NU; u += NGW) {
        const int bh = u / (SEQ / 64), tb = (SEQ / 64 - 1) - u % (SEQ / 64), b = bh / NSB, h = bh % NSB, t0 = tb * 64, t = t0 + lane;
        const bf16* base = proj + (size_t)b * SEQ * PP;
        float q[64], o[64];
        load_row64(base + (size_t)t * PP + C_SQ + h * HD, q);
#pragma unroll
        for (int d = 0; d < 64; ++d) o[d] = 0.f;
        float R = 0.f;
        for (int s = t0 + 62; s >= 0; --s) {
            const bf16* kr = base + (size_t)s * PP + C_SK + h * HD; const bf16* vr = base + (size_t)s * PP + C_SV + h * HD;
            float kk[64]; load_row64(kr, kk);
            float z = 0.f;
#pragma unroll
            for (int d = 0; d < 64; ++d) z += q[d] * kk[d];
            z *= 0.125f;
            const bool act = s < t;
            const float lb = log_sigmoid(z), lk = lb - z;
            const float w = act ? __expf(lb + R) : 0.f;
            load_row64(vr, kk);
#pragma unroll
            for (int d = 0; d < 64; ++d) o[d] += w * kk[d];
            R += act ? lk : 0.f;
            if (__all(R < -104.f)) break;
        }
        store_row64(mix + ((size_t)b * SEQ + t) * D + h * HD, o, 1.f);
    }
}
__device__ __forceinline__ void fox_naive(Frame& F, const bf16* proj, const float* ccum, bf16* mix) {
    const int gw = F.vcu * NWAVES + F.wave, NGW = F.G * NWAVES, lane = F.lane;
    const int NU = NBATCH * NFX * (SEQ / 64);
    for (int u = gw; u < NU; u += NGW) {
        const int bh = u / (SEQ / 64), tb = (SEQ / 64 - 1) - u % (SEQ / 64), b = bh / NFX, h = bh % NFX, t0 = tb * 64, t = t0 + lane;
        const bf16* base = proj + (size_t)b * SEQ * PP; const float* cc = ccum + (size_t)bh * SEQ;
        float q[64], o[64];
        load_row64(base + (size_t)t * PP + C_FQ + h * HD, q);
#pragma unroll
        for (int d = 0; d < 64; ++d) o[d] = 0.f;
        const float ct = cc[t]; float m = -INFINITY, l = 0.f;
        for (int s = t0 + 63; s >= 0; --s) {
            const bf16* kr = base + (size_t)s * PP + C_FK + h * HD; const bf16* vr = base + (size_t)s * PP + C_FV + h * HD;
            float kk[64]; load_row64(kr, kk);
            float z = 0.f;
#pragma unroll
            for (int d = 0; d < 64; ++d) z += q[d] * kk[d];
            const bool act = s <= t;
            const float lg = act ? (z * 0.125f + (ct - cc[s])) : -INFINITY;
            const float mn = fmaxf(m, lg);
            const float sc = (mn == m) ? 1.f : __expf(m - mn);
            const float p = act ? __expf(lg - mn) : 0.f;
            m = mn; l = l * sc + p;
            load_row64(vr, kk);
#pragma unroll
            for (int d = 0; d < 64; ++d) o[d] = o[d] * sc + p * kk[d];
        }
        store_row64(mix + ((size_t)b * SEQ + t) * D + SBD + h * HD, o, 1.f / l);
    }
}
__device__ __forceinline__ void pool_units(Frame& F, const bf16* proj, const float* pool_w, const float* pool_scale, bf16* mix) {
    LAS float* U = (LAS float*)(F.lds + RING_OFF);
    LAS float* R = U + 143 * 64;
    LAS float* W = R + 128 * 64;
    const int NU = (NTOK / 128) * 4, tid = F.tid;
    for (int u = F.vcu; u < NU; u += F.G) {
        const int g = u & 3, tile = u >> 2, tok0 = tile * 128, pos0 = tok0 % SEQ, win = 2 << g;
        for (int i = tid; i < 143 * 64; i += 512) { const int r = i >> 6, c = i & 63; const int pos = pos0 - 15 + r;
            U[i] = pos >= 0 ? bf2f(proj[(size_t)(tok0 - 15 + r) * PP + C_U + g * 64 + c]) : 0.f; }
        for (int i = tid; i < 64 * 64; i += 512) W[i] = pool_w[g * 4096 + i];
        LDS_WAIT(); __syncthreads();
        for (int i = tid; i < 128 * 64; i += 512) { const int r = i >> 6, c = i & 63; const int pos = pos0 + r; const int cntw = (pos + 1 < win) ? pos + 1 : win;
            float s = 0.f; for (int j = 0; j < cntw; ++j) s += U[(15 + r - j) * 64 + c];
            R[i] = s / (float)cntw - U[(15 + r) * 64 + c]; }
        LDS_WAIT(); __syncthreads();
        { const int co = tid & 63, tq = tid >> 6; float acc[16];
#pragma unroll
          for (int j = 0; j < 16; ++j) acc[j] = 0.f;
          for (int ci = 0; ci < 64; ++ci) { const float w = W[ci * 64 + co];
#pragma unroll
              for (int j = 0; j < 16; ++j) acc[j] += R[(tq * 16 + j) * 64 + ci] * w; }
          const float ps = pool_scale[g * 64 + co];
#pragma unroll
          for (int j = 0; j < 16; ++j) mix[(size_t)(tok0 + tq * 16 + j) * D + SBD + FXD + g * 64 + co] = (bf16)f2bf(acc[j] * ps); }
        __syncthreads();
    }
}
__device__ __forceinline__ void xa_naive(Frame& F, const bf16* xq, const bf16* xkv, bf16* xo) {
    const int gw = F.vcu * NWAVES + F.wave, NGW = F.G * NWAVES, lane = F.lane;
    LAS float* qs = (LAS float*)(F.lds + RING_OFF) + F.wave * 512;
    LAS float* ps = qs + 256;
    for (int tok = gw; tok < NTOK; tok += NGW) {
        const int b = tok / SEQ;
        for (int hd = 0; hd < XAH; ++hd) {
            { const v2u r = *(const v2u*)(xq + (size_t)tok * D + hd * XAD + 4 * lane); qs[4 * lane] = bflo(r.x); qs[4 * lane + 1] = bfhi(r.x); qs[4 * lane + 2] = bflo(r.y); qs[4 * lane + 3] = bfhi(r.y); }
            LDS_WAIT();
            float lg[4] = {0.f, 0.f, 0.f, 0.f};
            for (int d8 = 0; d8 < 32; ++d8) {
                const f32x4 qa = *(const LAS f32x4*)(qs + 8 * d8), qb = *(const LAS f32x4*)(qs + 8 * d8 + 4);
#pragma unroll
                for (int j = 0; j < 4; ++j) { const v4u r = *(const v4u*)(xkv + (size_t)(b * MEML + lane + 64 * j) * (2 * D) + hd * XAD + 8 * d8);
                    lg[j] += (qa.x * bflo(r.x) + qa.y * bfhi(r.x)) + (qa.z * bflo(r.y) + qa.w * bfhi(r.y)) + (qb.x * bflo(r.z) + qb.y * bfhi(r.z)) + (qb.z * bflo(r.w) + qb.w * bfhi(r.w)); }
            }
            float mx = -INFINITY;
#pragma unroll
            for (int j = 0; j < 4; ++j) { lg[j] *= 0.0625f; mx = fmaxf(mx, lg[j]); }
            mx = wave_max(mx);
            float sm = 0.f;
#pragma unroll
            for (int j = 0; j < 4; ++j) { lg[j] = __expf(lg[j] - mx); sm += lg[j]; }
            sm = wave_sum(sm); const float inv = 1.f / sm;
#pragma unroll
            for (int j = 0; j < 4; ++j) ps[lane + 64 * j] = lg[j] * inv;
            LDS_WAIT();
            float o0 = 0.f, o1 = 0.f, o2 = 0.f, o3 = 0.f;
            for (int key = 0; key < MEML; ++key) { const float p = ps[key]; const v2u r = *(const v2u*)(xkv + (size_t)(b * MEML + key) * (2 * D) + D + hd * XAD + 4 * lane);
                o0 += p * bflo(r.x); o1 += p * bfhi(r.x); o2 += p * bflo(r.y); o3 += p * bfhi(r.y); }
            v2u w; w.x = pk2(o0, o1); w.y = pk2(o2, o3); *(v2u*)(xo + (size_t)tok * D + hd * XAD + 4 * lane) = w;
            LDS_WAIT();
        }
    }
}
__device__ __forceinline__ void moe_offsets(const gu32* cnt, int (&pstart)[8], int& nblk) {
    int acc = 0;
#pragma unroll
    for (int e = 0; e < 8; ++e) { const int c = (int)__hip_atomic_load(cnt + e, RLX_AGENT); pstart[e] = acc; acc += ((c + 255) >> 8) << 8; }
    nblk = acc >> 8;
}
__device__ __forceinline__ void moe_gather(Frame& F, const bf16* hn, bf16* xs, int* tokt, int* blke) {
    int pstart[8], nblk; moe_offsets(F.ctl + CW_CNT, pstart, nblk);
    if (blockIdx.x == 0 && F.tid < MAXBLK + 1) {
        if (F.tid == MAXBLK) blke[MAXBLK] = nblk;
        else { int e = 0;
#pragma unroll
            for (int j = 1; j < 8; ++j) if (F.tid * 256 >= pstart[j]) e = j;
            blke[F.tid] = e; }
    }
    const int gw = F.vcu * NWAVES + F.wave, NGW = F.G * NWAVES, lane = F.lane;
    for (int row = gw; row < NTOK; row += NGW) {
        int* t = tokt + (size_t)row * 8; const int e0 = t[0], p0 = t[1], e1 = t[3], p1 = t[4];
        int s0 = 0, s1 = 0;
#pragma unroll
        for (int j = 0; j < 8; ++j) { s0 = (e0 == j) ? pstart[j] : s0; s1 = (e1 == j) ? pstart[j] : s1; }
        const int d0 = s0 + p0, d1 = s1 + p1;
#pragma unroll
        for (int j = 0; j < 2; ++j) { const v4u r = *(const v4u*)(hn + (size_t)row * D + 8 * lane + 512 * j);
            *(v4u*)(xs + (size_t)d0 * D + 8 * lane + 512 * j) = r; *(v4u*)(xs + (size_t)d1 * D + 8 * lane + 512 * j) = r; }
        asm volatile("" ::: "memory");
        if (lane == 0) { t[1] = d0; t[4] = d1; }
    }
}

constexpr int NPHASE = 29;
__global__ void __launch_bounds__(NWAVES * 64, 2) fwd(Args args) {
    extern __shared__ __attribute__((aligned(16))) unsigned char lds[];
    Frame F;
    F.lds = (LAS unsigned char*)lds;
    F.tid = threadIdx.x; F.lane = F.tid & 63; F.wave = __builtin_amdgcn_readfirstlane(F.tid >> 6);
    F.G = gridDim.x; { const int bx = blockIdx.x; F.vcu = (F.G % 8 == 0) ? (bx % 8) * (F.G / 8) + bx / 8 : bx; }
    F.ctl = (gu32*)(args.ws + WS_CTL);
    volatile LAS unsigned* MISC = (volatile LAS unsigned*)(F.lds + MISC_OFF);
    for (int u = F.tid; u < (LDS_BYTES - LDSCTL_OFF) / 4; u += NWAVES * 64) ((LAS unsigned*)(F.lds + LDSCTL_OFF))[u] = 0u;
    __syncthreads();
    XcdBarrier bar; bar.bar = (unsigned*)(F.ctl + CW_BAR); bar.x = 0; bar.st = nullptr;
    const int lo = args.ph_lo, hi = args.ph_hi;
    if (hi - lo > 1) bar = xcd_barrier_post((unsigned*)(F.ctl + CW_BAR), MISC + 8);
#ifndef PHASE_MASK
#define PHASE_MASK 0xffffffffull
#endif
#define IN(k) ((((unsigned long long)(PHASE_MASK) >> (k)) & 1ull) && lo <= (k) && (k) < hi && (fresh(F), true))
#define SEAM(k) do { if (IN(k) && IN((k) + 1)) xcd_barrier(bar); } while (0)
#define ws WSB
#define scr ((LAS float*)(F.lds + RING_OFF + F.wave * 16384))
#define HN ((bf16*)(ws + R2_HN))
#define MIX ((bf16*)(ws + R2_MIX))
#define PROJ ((bf16*)(ws + R1_PROJ))
#define BA ((bf16*)(ws + R1_A))
#define BB ((bf16*)(ws + R1_B))
#define ACT ((bf16*)(ws + R1_ACT))
#define XS ((bf16*)(ws + R2_XS))
#define LOGF ((float*)(ws + WS_LOGF))
#define CCUM ((float*)(ws + WS_CCUM))
#define TOKT ((int*)(ws + WS_TOKT))
#define BLKE ((int*)(ws + WS_BLKE))
#define MN ((bf16*)(ws + WS_MN))
#define XKV ((bf16*)(ws + WS_XKV))
    const int bx = (int)blockIdx.x;

#define GEMM_PLAIN(Aptr, Btptr, M_, N_, K_, Optr, ldc_) do { pg8::Gemm g{(const pg8::bf16_t*)(Aptr), (const pg8::bf16_t*)(Btptr), (M_), (N_), (K_)}; pg8::StaticOrder S; S.init(g, F.G, bx); \
        pg8::EpiBf16 E{(pg8::bf16_t*)(Optr), (ldc_), 0}; pg8::gemm_phase<pg8::EpiBf16, pg8::StaticOrder, true, true>(F.lds + RING_OFF, (K_), S, E); } while (0)

    if (IN(0)) {
        convert_layer_small(F, 0, (bf16*)(ws + WS_WS0), scr);
        convert_layer_small(F, 1, (bf16*)(ws + WS_WS1), scr);
        transpose_gu(F, INP(I_DG), INP(I_DU), (bf16*)(ws + WS_WGU0), scr);
        transpose_mat(F, INP(I_DD), D, 0, D, DFF, (bf16*)(ws + WS_WD0), 0, scr);
        { float* wr = (float*)(ws + WS_WR); for (int i = (F.vcu * NWAVES + F.wave) * 64 + F.lane; i < 8 * D; i += F.G * NWAVES * 64) { const int e = i / D, k = i % D; wr[e * D + k] = INP(I_RW)[(size_t)k * NE + e]; } }
        mem_norm(F, INP(I_MEM), INP(I_MEMN), MN);
    }
    SEAM(0);
    if (IN(1)) {
        thin_rows<0, false, true, 1>(F, INP(I_X), nullptr, nullptr, nullptr, INP(I_MIXPRE), HN, (const float*)(ws + WS_WF), INP(I_BF), LOGF, nullptr, nullptr);
    }
    SEAM(1);
#pragma unroll
    for (int l = 0; l < DEPTH; ++l) {
        const int pb = 2 + l * 11;
        const int p0 = (l == 0) ? 2 : 15;
        (void)pb;
        const bf16* WSL = (const bf16*)(ws + (l == 0 ? WS_WS0 : WS_WS1));
        const float* h_res = (l == 0) ? INP(I_X) : OUTP;
        if (IN(p0)) {
            scan_logf(F, LOGF, CCUM);
            GEMM_PLAIN(HN, WSL + OW_IN / 2, NTOK, PP, D, PROJ, PP);
            GEMM_PLAIN(MN, WSL + OW_KV / 2, NMEM, 2 * D, D, XKV, 2 * D);
        }
        SEAM(p0);
        if (IN(p0 + 1)) {
#ifndef SKIP_SB
            sb_naive(F, PROJ, MIX);
#endif
#ifndef SKIP_FOX
            fox_naive(F, PROJ, CCUM, MIX);
#endif
            pool_units(F, PROJ, INP(I_POOLW) + (size_t)l * 4 * 4096, INP(I_POOLS) + (size_t)l * POOLD, MIX);
        }
        SEAM(p0 + 1);
        if (IN(p0 + 2)) GEMM_PLAIN(MIX, WSL + OW_OUT / 2, NTOK, D, D, BA, D);
        SEAM(p0 + 2);
        if (IN(p0 + 3)) thin_rows<1, true, true, 0>(F, h_res, BA, INP(I_MIXPOST) + l * D, OUTP, INP(I_XAPRE) + l * D, HN, nullptr, nullptr, nullptr, nullptr, nullptr);
        SEAM(p0 + 3);
        if (IN(p0 + 4)) GEMM_PLAIN(HN, WSL + OW_Q / 2, NTOK, D, D, BB, D);
        SEAM(p0 + 4);
#ifndef SKIP_XA
        if (IN(p0 + 5)) xa_naive(F, BB, XKV, BA);
#endif
        SEAM(p0 + 5);
        if (IN(p0 + 6)) GEMM_PLAIN(BA, WSL + OW_O / 2, NTOK, D, D, BB, D);
        SEAM(p0 + 6);
        if (l == 0) {
            if (IN(9)) thin_rows<1, true, true, 0>(F, OUTP, BB, INP(I_XAPOST), OUTP, INP(I_FFPRE), HN, nullptr, nullptr, nullptr, nullptr, nullptr);
            SEAM(9);
            if (IN(10)) { pg8::Gemm g{(const pg8::bf16_t*)HN, (const pg8::bf16_t*)(ws + WS_WGU0), NTOK, 2 * DFF, D}; pg8::StaticOrder S; S.init(g, F.G, bx);
                pg8::EpiSwiGLU E{(pg8::bf16_t*)ACT, DFF, 0}; pg8::gemm_phase<pg8::EpiSwiGLU, pg8::StaticOrder, true, true>(F.lds + RING_OFF, D, S, E); }
            SEAM(10);
            if (IN(11)) GEMM_PLAIN(ACT, ws + WS_WD0, NTOK, D, DFF, MIX, D);
            SEAM(11);
            if (IN(12)) thin_rows<1, true, true, 1>(F, OUTP, MIX, INP(I_FFPOST), OUTP, INP(I_MIXPRE) + D, HN, (const float*)(ws + WS_WF) + 8 * D, INP(I_BF) + NFX, LOGF, nullptr, nullptr);
            SEAM(12);
            if (IN(13)) {
                for (int e = 0; e < NE; ++e) {
                    bf16* we = (bf16*)(ws + WS_WMOE + (size_t)e * MOE_E_BYTES);
                    transpose_gu(F, INP(I_MG) + (size_t)e * D * DFF, INP(I_MU) + (size_t)e * D * DFF, we, scr);
                    transpose_mat(F, INP(I_MD) + (size_t)e * DFF * D, D, 0, D, DFF, we + MOE_GU_BYTES / 2, 0, scr);
                }
                mem_norm(F, INP(I_MEM), INP(I_MEMN) + D, MN);
            }
            SEAM(13);
            SEAM(14);
        } else {
            if (IN(22)) thin_rows<1, true, true, 2>(F, OUTP, BB, INP(I_XAPOST) + D, OUTP, INP(I_FFPRE) + D, BA, (const float*)(ws + WS_WR), nullptr, nullptr, TOKT, F.ctl + CW_CNT);
            SEAM(22);
            if (IN(23)) moe_gather(F, BA, XS, TOKT, BLKE);
            SEAM(23);
#pragma unroll
            for (int ch = 0; ch < 2; ++ch) {
                const int nblk = BLKE[MAXBLK]; const int c0 = ch * CHUNK_BLK, c1 = (nblk < c0 + CHUNK_BLK) ? nblk : c0 + CHUNK_BLK; const int nb = c1 > c0 ? c1 - c0 : 0;
                if (IN(24 + 2 * ch)) { pg8::MoeOrder S{nb, 2 * DFF / 256, F.G, bx, c0, 0, (const char*)XS, (const char*)(ws + WS_WMOE), (size_t)256 * D * 2, MOE_E_BYTES, BLKE};
                    pg8::EpiSwiGLU E{(pg8::bf16_t*)ACT, DFF, c0}; pg8::gemm_phase<pg8::EpiSwiGLU, pg8::MoeOrder, true, true>(F.lds + RING_OFF, D, S, E); }
                SEAM(24 + 2 * ch);
                if (IN(25 + 2 * ch)) { pg8::MoeOrder S{nb, D / 256, F.G, bx, c0, c0, (const char*)ACT, (const char*)(ws + WS_WMOE + MOE_GU_BYTES), (size_t)256 * DFF * 2, MOE_E_BYTES, BLKE};
                    pg8::EpiBf16 E{(pg8::bf16_t*)XS, D, 0}; pg8::gemm_phase<pg8::EpiBf16, pg8::MoeOrder, true, true>(F.lds + RING_OFF, DFF, S, E); }
                SEAM(25 + 2 * ch);
            }
            if (IN(28)) thin_rows<2, true, false, 0>(F, OUTP, XS, INP(I_FFPOST) + D, OUTP, nullptr, nullptr, nullptr, nullptr, nullptr, TOKT, nullptr);
        }
    }
#undef IN
#undef SEAM
#undef ws
#undef scr
#undef HN
#undef MIX
#undef PROJ
#undef BA
#undef BB
#undef ACT
#undef XS
#undef LOGF
#undef CCUM
#undef TOKT
#undef BLKE
#undef MN
#undef XKV
}

extern "C" void kernel_launch(void* const* d_in, const int* in_sizes, int n_in, void* d_out, int out_size, void* d_ws, size_t ws_size, hipStream_t stream) {
    static int grid = 0;
    if (grid == 0) {
        if (n_in != 24 || in_sizes[0] != NTOK * D || out_size != NTOK * D || ws_size < WS_END) { fprintf(stderr, "kernel_launch: unexpected shapes / workspace (%d inputs, ws %zu < %zu)\n", n_in, ws_size, (size_t)WS_END); grid = -1; return; }
        int dev = 0, cus = 0, per_cu = 0;
        if (hipGetDevice(&dev) != hipSuccess || hipDeviceGetAttribute(&cus, hipDeviceAttributeMultiprocessorCount, dev) != hipSuccess) { grid = -1; return; }
        if (hipFuncSetAttribute((const void*)fwd, hipFuncAttributeMaxDynamicSharedMemorySize, LDS_BYTES) != hipSuccess) { fprintf(stderr, "kernel_launch: hipFuncSetAttribute failed\n"); grid = -1; return; }
        if (hipOccupancyMaxActiveBlocksPerMultiprocessor(&per_cu, (const void*)fwd, NWAVES * 64, LDS_BYTES) != hipSuccess || per_cu < 1) { fprintf(stderr, "kernel_launch: occupancy query reports %d\n", per_cu); }
        (void)hipGetLastError();
        grid = cus;
    }
    if (grid < 0) return;
    (void)hipMemsetAsync((char*)d_ws + WS_CTL, 0, CTL_ZERO_BYTES, stream);
    Args a{};
    for (int i = 0; i < 24; ++i) a.in[i] = (const float*)d_in[i];
    a.out = (float*)d_out; a.ws = (unsigned char*)d_ws;
#if MK_ONE_LAUNCH
    a.ph_lo = 0; a.ph_hi = NPHASE;
    hipLaunchKernelGGL(fwd, dim3(grid), dim3(NWAVES * 64), LDS_BYTES, stream, a);
#else
    for (int p = 0; p < NPHASE; ++p) {
        if (p == 14) continue;
        a.ph_lo = p; a.ph_hi = p + 1;
        hipLaunchKernelGGL(fwd, dim3(grid), dim3(NWAVES * 64), LDS_BYTES, stream, a);
    }
#endif
}
```

```cpp
#include <hip/hip_runtime.h>
#include <cstdio>
#include <cstdint>

#ifndef MK_ONE_LAUNCH
#define MK_ONE_LAUNCH 1
#endif

namespace pg8 {
#define PG8_LAS __attribute__((address_space(3)))
typedef unsigned short bf16_t;
typedef short bf16x8 __attribute__((ext_vector_type(8)));
typedef float f32x4 __attribute__((ext_vector_type(4)));
typedef unsigned u32x4 __attribute__((ext_vector_type(4)));
constexpr int BM = 256, BK = 64, HALF = 128, HTB = HALF * BK * 2  , STAGE_BYTES = 8 * HTB, NXCD = 8, WGM = 8;

__host__ __device__ __forceinline__ int lds_byte(int r, int c) { const int st = (r >> 4) * 2 + (c >> 5), rr = r & 15, cc = c & 31, ob = rr * 64 + cc * 2; return st * 1024 + (ob ^ (((ob >> 9) & 1) << 5)); }
__host__ __device__ __forceinline__ void stage_rc(int b, int& R, int& C) { const int st = b / 1024, sb = b % 1024, swz = sb ^ (((sb >> 9) & 1) << 5); R = (st >> 1) * 16 + swz / 64; C = (st & 1) * 32 + (swz % 64) / 2; }
__host__ __device__ __forceinline__ int perm32(int rho) { const int n = rho >> 4, i = rho & 15; return 8 * (i >> 2) + 4 * n + (i & 3); }

struct Unit { int pm, pn; const char* a; const char* b; };
struct Gemm { const bf16_t* A; const bf16_t* Bt; int M, N, K; };

__device__ __forceinline__ bool order_map(int i, int G, int c, int nM, int nN, int& pm, int& pn) {
    const int nwg = nM * nN; const long L = (long)i * G + c; if (L >= nwg) return false;
    int wgid = (int)L; { const int q = nwg / NXCD, r = nwg % NXCD, xcd = wgid % NXCD, off = wgid / NXCD; wgid = (xcd < r ? xcd * (q + 1) : r * (q + 1) + (xcd - r) * q) + off; }
    const int nig = WGM * nN, gid = wgid / nig, fm = gid * WGM, gsz = (nM - fm) < WGM ? (nM - fm) : WGM;
    pm = fm + ((wgid % nig) % gsz); pn = (wgid % nig) / gsz; return true;
}
struct StaticOrder {
    int nM, nN, G, c; const char* A; const char* B; size_t tstep;
    __device__ void init(const Gemm& g, int G_, int c_) { nM = g.M / BM; nN = g.N / BM; G = G_; c = c_; A = (const char*)g.A; B = (const char*)g.Bt; tstep = (size_t)BM * g.K * 2; }
    __device__ __forceinline__ bool next(int i, Unit& u) const {
        if (!order_map(i, G, c, nM, nN, u.pm, u.pn)) return false;
        u.a = A + (size_t)u.pm * tstep; u.b = B + (size_t)u.pn * tstep; return true;
    }
};
struct MoeOrder {
    int nM, nN, G, c, pb0, pbA; const char* A; const char* W; size_t tstep, wstride; const int* blk_e;
    __device__ __forceinline__ bool next(int i, Unit& u) const {
        int pm, pn; if (!order_map(i, G, c, nM, nN, pm, pn)) return false;
        u.pm = pb0 + pm; u.pn = pn; const int e = blk_e[u.pm];
        u.a = A + (size_t)(u.pm - pbA) * tstep; u.b = W + (size_t)e * wstride + (size_t)pn * tstep; return true;
    }
};

__device__ __forceinline__ unsigned cvt_pk_bf16(float lo, float hi) { unsigned r; asm volatile("v_cvt_pk_bf16_f32 %0, %1, %2" : "=v"(r) : "v"(lo), "v"(hi)); return r; }

struct EpiBf16 {
    static constexpr bool PERM = true;
    bf16_t* O; int ldc; int pm_off;
    __device__ __forceinline__ void operator()(const f32x4 (&acc)[2][2][4][2], const Unit& u, int wr, int wc, int fr, int fq) const {
        const int row0 = (u.pm - pm_off) * BM + wr * 64 + fr; const int col0 = u.pn * BM + wc * 32 + 8 * fq;
#pragma unroll
        for (int ai = 0; ai < 2; ++ai)
#pragma unroll
            for (int m = 0; m < 4; ++m) { bf16_t* rowp = O + (size_t)(row0 + ai * HALF + m * 16) * ldc + col0;
#pragma unroll
                for (int bj = 0; bj < 2; ++bj) { const f32x4 v0 = acc[ai][bj][m][0], v1 = acc[ai][bj][m][1];
                    u32x4 w; w.x = cvt_pk_bf16(v0[0], v0[1]); w.y = cvt_pk_bf16(v0[2], v0[3]); w.z = cvt_pk_bf16(v1[0], v1[1]); w.w = cvt_pk_bf16(v1[2], v1[3]);
                    *(u32x4*)(rowp + bj * HALF) = w; } }
    }
};
__device__ __forceinline__ float silu_mul(float g, float u) { return g * __builtin_amdgcn_rcpf(1.0f + __expf(-g)) * u; }
struct EpiSwiGLU {
    static constexpr bool PERM = true;
    bf16_t* O; int ldc; int pm_off;
    __device__ __forceinline__ void operator()(const f32x4 (&acc)[2][2][4][2], const Unit& u, int wr, int wc, int fr, int fq) const {
        const int row0 = (u.pm - pm_off) * BM + wr * 64 + fr; const int col0 = u.pn * HALF + wc * 32 + 8 * fq;
#pragma unroll
        for (int ai = 0; ai < 2; ++ai)
#pragma unroll
            for (int m = 0; m < 4; ++m) { bf16_t* rowp = O + (size_t)(row0 + ai * HALF + m * 16) * ldc + col0;
                const f32x4 g0 = acc[ai][0][m][0], g1 = acc[ai][0][m][1], u0 = acc[ai][1][m][0], u1 = acc[ai][1][m][1];
                u32x4 w; w.x = cvt_pk_bf16(silu_mul(g0[0], u0[0]), silu_mul(g0[1], u0[1])); w.y = cvt_pk_bf16(silu_mul(g0[2], u0[2]), silu_mul(g0[3], u0[3]));
                w.z = cvt_pk_bf16(silu_mul(g1[0], u1[0]), silu_mul(g1[1], u1[1])); w.w = cvt_pk_bf16(silu_mul(g1[2], u1[2]), silu_mul(g1[3], u1[3]));
                *(u32x4*)rowp = w; }
    }
};

template <class Epi, class Sched, bool ALIGN_EPI = false, bool SP2 = false>
__device__ __forceinline__ void gemm_phase(PG8_LAS unsigned char* lds, const int K, const Sched& S, const Epi& E) {
    int tid_ = threadIdx.x; asm volatile("" : "+v"(tid_));
    const int tid = tid_, wid = __builtin_amdgcn_readfirstlane(tid >> 6), lane = tid & 63, wr = wid >> 2, wc = wid & 3, fr = lane & 15, fq = lane >> 4;
    const int nt = K / BK;
    unsigned voffA[2], voffB[2];
#pragma unroll
    for (int i = 0; i < 2; ++i) { int R, C; stage_rc(tid * 16 + i * 8192, R, C); const int Rb = Epi::PERM ? ((R & ~31) + perm32(R & 31)) : R;
        voffA[i] = (unsigned)(R * K + C) * 2u; voffB[i] = (unsigned)(Rb * K + C) * 2u; }
    const size_t kstep = (size_t)(BK * 2);
    const size_t hstep = (size_t)HALF * K * 2;
    const unsigned ldsw = (unsigned)wid * 1024u;
    const int aoff = lds_byte(wr * 64 + fr, fq * 8), boff = lds_byte(wc * 32 + fr, fq * 8);
#define PG8_SA(b, h) (((b) * 2 + (h)) * HTB)
#define PG8_SB(b, h) ((4 + (b) * 2 + (h)) * HTB)
#define PG8_STAGE(bufoff, gbase, voff) do { _Pragma("unroll") for (int _i = 0; _i < 2; ++_i) \
        __builtin_amdgcn_global_load_lds((const unsigned*)((const char*)(gbase) + (voff)[_i]), (PG8_LAS unsigned*)(lds + (bufoff) + ldsw + _i * 8192), 16, 0, 0); } while (0)
#define PG8_LDA(dst, b, h) do { _Pragma("unroll") for (int m = 0; m < 4; ++m) _Pragma("unroll") for (int k = 0; k < 2; ++k) dst[m][k] = *(const PG8_LAS bf16x8*)(lds + PG8_SA(b, h) + aoff + m * 2048 + k * 1024); } while (0)
#define PG8_LDB(dst, b, h) do { _Pragma("unroll") for (int n = 0; n < 2; ++n) _Pragma("unroll") for (int k = 0; k < 2; ++k) dst[n][k] = *(const PG8_LAS bf16x8*)(lds + PG8_SB(b, h) + boff + n * 2048 + k * 1024); } while (0)
#define PG8_MMA(ai, bj, At, Bt) do { __builtin_amdgcn_s_setprio(1); _Pragma("unroll") for (int m = 0; m < 4; ++m) _Pragma("unroll") for (int n = 0; n < 2; ++n) _Pragma("unroll") for (int k = 0; k < 2; ++k) \
        acc[ai][bj][m][n] = __builtin_amdgcn_mfma_f32_16x16x32_bf16(Bt[n][k], At[m][k], acc[ai][bj][m][n], 0, 0, 0); __builtin_amdgcn_s_setprio(0); } while (0)
#define PG8_WAIT_V(n) asm volatile("s_waitcnt vmcnt(" #n ")" ::: "memory")
#define PG8_WAIT_L(n) asm volatile("s_waitcnt lgkmcnt(" #n ")" ::: "memory")
#define PG8_BAR __builtin_amdgcn_s_barrier()
#define PG8_SCHED __builtin_amdgcn_sched_barrier(0)
    Unit cur, nxt; int ui = 0;
    if (!S.next(0, cur)) return;
    f32x4 acc[2][2][4][2];
#pragma unroll
    for (int a = 0; a < 2; ++a)
#pragma unroll
        for (int b = 0; b < 2; ++b)
#pragma unroll
            for (int m = 0; m < 4; ++m)
#pragma unroll
                for (int n = 0; n < 2; ++n) acc[a][b][m][n] = (f32x4){0.f, 0.f, 0.f, 0.f};
    bf16x8 At[4][2], B0[2][2], B1[2][2];
    const char* cA = cur.a; const char* cB = cur.b;
    if constexpr (SP2) {
        PG8_STAGE(PG8_SB(0, 0), cB, voffB); PG8_STAGE(PG8_SB(0, 1), cB + hstep, voffB); PG8_STAGE(PG8_SA(0, 0), cA, voffA); PG8_STAGE(PG8_SA(0, 1), cA + hstep, voffA);
        if (wr == 1) PG8_BAR;
        PG8_WAIT_V(2); PG8_BAR;
        PG8_STAGE(PG8_SB(1, 0), cB + kstep, voffB); PG8_STAGE(PG8_SA(1, 0), cA + kstep, voffA); PG8_STAGE(PG8_SB(1, 1), cB + hstep + kstep, voffB);
        PG8_WAIT_V(6); PG8_BAR;
    } else {
        PG8_STAGE(PG8_SB(0, 0), cB, voffB); PG8_STAGE(PG8_SA(0, 0), cA, voffA); PG8_STAGE(PG8_SB(0, 1), cB + hstep, voffB); PG8_STAGE(PG8_SA(0, 1), cA + hstep, voffA);
        if (wr == 1) PG8_BAR;
        PG8_WAIT_V(4); PG8_BAR;
        PG8_STAGE(PG8_SB(1, 0), cB + kstep, voffB); PG8_STAGE(PG8_SA(1, 0), cA + kstep, voffA); PG8_STAGE(PG8_SB(1, 1), cB + hstep + kstep, voffB);
        PG8_WAIT_V(6); PG8_BAR;
    }
    for (;;) {
        const bool has_next = S.next(ui + 1, nxt);
        const char* nA = has_next ? nxt.a : cA; const char* nB = has_next ? nxt.b : cB;
        for (int t = 0; t < nt; t += 2) {
            const bool last = (t == nt - 2);
            const char* a1 = cA + (size_t)(t + 1) * kstep;
            const char* a2 = last ? nA : cA + (size_t)(t + 2) * kstep; const char* b2 = last ? nB : cB + (size_t)(t + 2) * kstep;
            const char* a3 = a2 + kstep; const char* b3 = b2 + kstep;
            if constexpr (SP2) {
            PG8_LDB(B0, 0, 0); PG8_LDB(B1, 0, 1); PG8_SCHED; PG8_LDA(At, 0, 0); PG8_STAGE(PG8_SA(1, 1), a1 + hstep, voffA);
            PG8_WAIT_V(8); PG8_WAIT_L(0); PG8_BAR; PG8_MMA(0, 0, At, B0); PG8_MMA(0, 1, At, B1); PG8_BAR; PG8_SCHED;
            PG8_LDA(At, 0, 1); PG8_STAGE(PG8_SB(0, 0), b2, voffB); PG8_STAGE(PG8_SB(0, 1), b2 + hstep, voffB); PG8_STAGE(PG8_SA(0, 0), a2, voffA);
            PG8_WAIT_V(8); PG8_WAIT_L(0); PG8_BAR; PG8_MMA(1, 0, At, B0); PG8_MMA(1, 1, At, B1); PG8_BAR; PG8_SCHED;
            PG8_LDB(B0, 1, 0); PG8_LDB(B1, 1, 1); PG8_SCHED; PG8_LDA(At, 1, 0); PG8_STAGE(PG8_SA(0, 1), a2 + hstep, voffA);
            PG8_WAIT_V(8); PG8_WAIT_L(0); PG8_BAR; PG8_MMA(0, 0, At, B0); PG8_MMA(0, 1, At, B1); PG8_BAR; PG8_SCHED;
            PG8_LDA(At, 1, 1); PG8_STAGE(PG8_SB(1, 0), b3, voffB); PG8_STAGE(PG8_SB(1, 1), b3 + hstep, voffB); PG8_STAGE(PG8_SA(1, 0), a3, voffA);
            PG8_WAIT_V(8); PG8_WAIT_L(0); PG8_BAR; PG8_MMA(1, 0, At, B0); PG8_MMA(1, 1, At, B1); PG8_BAR; PG8_SCHED;
            } else {
            PG8_LDB(B0, 0, 0); PG8_SCHED; PG8_LDA(At, 0, 0); PG8_STAGE(PG8_SA(1, 1), a1 + hstep, voffA);
            PG8_WAIT_L(8); PG8_BAR; PG8_WAIT_L(0); PG8_MMA(0, 0, At, B0); PG8_BAR; PG8_SCHED;
            PG8_LDB(B1, 0, 1); PG8_STAGE(PG8_SB(0, 0), b2, voffB);
            PG8_BAR; PG8_WAIT_L(0); PG8_MMA(0, 1, At, B1); PG8_BAR;
            PG8_LDA(At, 0, 1); PG8_STAGE(PG8_SA(0, 0), a2, voffA);
            PG8_BAR; PG8_WAIT_L(0); PG8_MMA(1, 0, At, B0); PG8_BAR; PG8_SCHED;
            PG8_STAGE(PG8_SB(0, 1), b2 + hstep, voffB);
            PG8_WAIT_V(6); PG8_BAR; PG8_MMA(1, 1, At, B1); PG8_BAR;
            PG8_LDB(B0, 1, 0); PG8_SCHED; PG8_LDA(At, 1, 0); PG8_STAGE(PG8_SA(0, 1), a2 + hstep, voffA);
            PG8_WAIT_L(8); PG8_BAR; PG8_WAIT_L(0); PG8_MMA(0, 0, At, B0); PG8_BAR; PG8_SCHED;
            PG8_LDB(B1, 1, 1); PG8_STAGE(PG8_SB(1, 0), b3, voffB);
            PG8_BAR; PG8_WAIT_L(0); PG8_MMA(0, 1, At, B1); PG8_BAR;
            PG8_LDA(At, 1, 1); PG8_STAGE(PG8_SA(1, 0), a3, voffA);
            PG8_BAR; PG8_WAIT_L(0); PG8_MMA(1, 0, At, B0); PG8_BAR; PG8_SCHED;
            PG8_STAGE(PG8_SB(1, 1), b3 + hstep, voffB);
            PG8_WAIT_V(6); PG8_BAR; PG8_MMA(1, 1, At, B1); PG8_BAR;
            }
        }
        if constexpr (ALIGN_EPI) { if (wr == 0) PG8_BAR; }
        E(acc, cur, wr, wc, fr, fq);
        if (!has_next) break;
#pragma unroll
        for (int a = 0; a < 2; ++a)
#pragma unroll
            for (int b = 0; b < 2; ++b)
#pragma unroll
                for (int m = 0; m < 4; ++m)
#pragma unroll
                    for (int n = 0; n < 2; ++n) acc[a][b][m][n] = (f32x4){0.f, 0.f, 0.f, 0.f};
        cur = nxt; cA = nA; cB = nB; ++ui;
        if constexpr (ALIGN_EPI) { if (wr == 1) PG8_BAR; }
    }
    PG8_WAIT_V(0);
    if constexpr (!ALIGN_EPI) { if (wr == 0) PG8_BAR; }
    PG8_BAR;
#undef PG8_SA
#undef PG8_SB
#undef PG8_STAGE
#undef PG8_LDA
#undef PG8_LDB
#undef PG8_MMA
#undef PG8_WAIT_V
#undef PG8_WAIT_L
#undef PG8_BAR
#undef PG8_SCHED
}
}

constexpr int NBATCH = 4, SEQ = 8192, D = 1024, NTOK = NBATCH * SEQ, DEPTH = 2;
constexpr int HD = 64, NSB = 6, NFX = 6, SBD = 384, FXD = 384, POOLD = 256, CIN = 2566;
constexpr int MEML = 256, NMEM = NBATCH * MEML, XAH = 4, XAD = 256;
constexpr int DFF = 2816, NE = 8;
constexpr float EPS = 1e-6f;
constexpr int PP = 1792, C_SQ = 0, C_SK = 384, C_FQ = 768, C_FK = 1152, C_U = 1536;
constexpr int VTN = 768;
constexpr int MAXBLK = 264, CHUNK_BLK = 132;

constexpr size_t MiB = 1u << 20;
constexpr size_t WS_CTL = 0, CTL_ZERO_BYTES = 1 * MiB;
constexpr size_t WS_WF   = 1 * MiB;
constexpr size_t WS_WR   = WS_WF + 65536;
constexpr size_t WS_BLKE = WS_WR + 32768;
constexpr size_t WS_LOGF = 2 * MiB;
constexpr size_t WS_CCUM = 3 * MiB;
constexpr size_t WS_TOKT = 4 * MiB;
constexpr size_t WS_MN   = 5 * MiB;
constexpr size_t WS_XKV  = 7 * MiB;
constexpr size_t WS_WS1  = 16 * MiB;
constexpr size_t WS_WMOE = 31 * MiB;
constexpr size_t WS_R2   = 163 * MiB;
constexpr size_t WS_R1   = 295 * MiB;
constexpr size_t WS_END  = 295 * MiB + 190316544;
constexpr size_t OW_IN = 0, OW_OUT = 5 * MiB, OW_Q = 7 * MiB, OW_KV = 9 * MiB, OW_O = 13 * MiB, OW_LAYER = 15 * MiB;
constexpr size_t WS_WS0 = WS_WMOE;
constexpr size_t WS_WGU0 = WS_WS0 + OW_LAYER;
constexpr size_t WS_WD0 = WS_WGU0 + 11 * MiB;
constexpr size_t MOE_GU_BYTES = (size_t)2 * DFF * D * 2, MOE_D_BYTES = (size_t)D * DFF * 2, MOE_E_BYTES = MOE_GU_BYTES + MOE_D_BYTES;
static_assert(WS_WD0 + MOE_D_BYTES <= WS_WMOE + 132 * MiB && 8 * MOE_E_BYTES <= 132 * MiB, "weights map");
constexpr size_t R2_HN = WS_R2, R2_MIX = WS_R2 + 64 * MiB;
constexpr size_t R1_PROJ = WS_R1;
constexpr size_t R1_VT = WS_R1 + 112 * MiB;
constexpr size_t R1_A = WS_R1, R1_B = WS_R1 + 64 * MiB;
constexpr size_t R1_ACT = WS_R1;
constexpr size_t R2_XS = WS_R2;
static_assert((size_t)NTOK * DFF * 2 <= 190316544 && (size_t)CHUNK_BLK * 256 * DFF * 2 <= 190316544 && (size_t)MAXBLK * 256 * D * 2 <= 132 * MiB, "arena map");
constexpr int CW_CNT = 64;
constexpr int CW_KMAX = 128;
constexpr int CW_BAR = 4096;

constexpr int RING_OFF = 0, RING_BYTES = 131072;
constexpr int LDSCTL_OFF = RING_BYTES, MISC_OFF = LDSCTL_OFF + 320;
constexpr int LDS_BYTES = 147456;
constexpr int NWAVES = 8;

#define GAS __attribute__((address_space(1)))
#define LAS __attribute__((address_space(3)))
typedef unsigned short bf16;
typedef unsigned v4u __attribute__((ext_vector_type(4)));
typedef unsigned v2u __attribute__((ext_vector_type(2)));
typedef float f32x4 __attribute__((ext_vector_type(4)));
typedef GAS unsigned gu32;
#define RLX_AGENT __ATOMIC_RELAXED, __HIP_MEMORY_SCOPE_AGENT
#define LDS_WAIT() asm volatile("s_waitcnt lgkmcnt(0)" ::: "memory")
#define VM_WAIT() asm volatile("s_waitcnt vmcnt(0)" ::: "memory")
__device__ __forceinline__ unsigned f2bf(float f) { unsigned u = __builtin_bit_cast(unsigned, f); return (u + 0x7fffu + ((u >> 16) & 1u)) >> 16; }
__device__ __forceinline__ unsigned pk2(float lo, float hi) { return f2bf(lo) | (f2bf(hi) << 16); }
__device__ __forceinline__ float bflo(unsigned u) { return __uint_as_float(u << 16); }
__device__ __forceinline__ float bfhi(unsigned u) { return __uint_as_float(u & 0xffff0000u); }
__device__ __forceinline__ float bf2f(bf16 b) { return __uint_as_float(((unsigned)b) << 16); }

#define XB_TMO      128
#define XB_XCNT(j)  (256  + 64 * (j))
#define XB_XSUB(j)  (1280 + 64 * (j))
#define XB_XGEN(j)  (2304 + 64 * (j))
#define XB_TOP      3328
#define XB_TOPGEN   3392
#define XCD_BAR_WORDS 3456
#define XB_SPIN_CAP (1u << 22)

__device__ __forceinline__ unsigned xb_ld(unsigned* p)              { return __hip_atomic_load(p, __ATOMIC_RELAXED, __HIP_MEMORY_SCOPE_AGENT); }
__device__ __forceinline__ unsigned xb_add(unsigned* p, unsigned v) { return __hip_atomic_fetch_add(p, v, __ATOMIC_RELAXED, __HIP_MEMORY_SCOPE_AGENT); }
__device__ __forceinline__ unsigned xb_xcc_id() { return (unsigned)__builtin_amdgcn_s_getreg((3 << 11) | 20) & 0xFu; }
#define XB_SPIN(cond, bar) do { unsigned _sp = 0; while (cond) { __builtin_amdgcn_s_sleep(1); \
    if ((++_sp & 255u) == 0u) { if (xb_ld(&(bar)[XB_TMO])) break; if (_sp > XB_SPIN_CAP) { atomicAdd(&(bar)[XB_TMO], 1u); break; } } } } while (0)

struct XcdBarrier { unsigned* bar; unsigned x; volatile LAS unsigned* st; };

__device__ __forceinline__ XcdBarrier xcd_barrier_post(unsigned* bar, volatile LAS unsigned* st) {
    XcdBarrier b; b.bar = bar; b.x = xb_xcc_id(); b.st = st;
    if (threadIdx.x == 0) (void)xb_add(&bar[XB_XCNT(b.x)], 1u);
    return b;
}
__device__ __forceinline__ void xcd_barrier_complete(unsigned* bar, unsigned x, unsigned& nloc, unsigned& nx) {
    const unsigned G = gridDim.x * gridDim.y * gridDim.z;
    unsigned sum, cnt, mine, sp = 0u;
    for (;;) {
        sum = 0u; cnt = 0u; mine = 0u;
#pragma unroll
        for (unsigned j = 0; j < 16; ++j) { const unsigned c = xb_ld(&bar[XB_XCNT(j)]); sum += c; cnt += (c > 0u) ? 1u : 0u; mine = (j == x) ? c : mine; }
        if (sum == G) break;
        __builtin_amdgcn_s_sleep(1);
        if ((++sp & 255u) == 0u) { if (xb_ld(&bar[XB_TMO])) break; if (sp > XB_SPIN_CAP) { atomicAdd(&bar[XB_TMO], 1u); break; } }
    }
    nloc = mine > 0u ? mine : 1u; nx = cnt > 0u ? cnt : 1u;
}
__device__ __forceinline__ void xcd_barrier(const XcdBarrier& b) {
    asm volatile("s_waitcnt vmcnt(0)" ::: "memory");
    __syncthreads();
    if (threadIdx.x == 0) {
        unsigned* bar = b.bar;
        __builtin_amdgcn_s_waitcnt(0);
        unsigned nloc = b.st[0], nx = b.st[1];
        if (nloc == 0u) { xcd_barrier_complete(bar, b.x, nloc, nx); b.st[0] = nloc; b.st[1] = nx; }
        const unsigned old = xb_add(&bar[XB_XSUB(b.x)], 1u);
        const unsigned gen = old / nloc;
        if (old + 1u == (gen + 1u) * nloc) {
            __builtin_amdgcn_fence(__ATOMIC_RELEASE, "agent");
            asm volatile("s_waitcnt vmcnt(0)" ::: "memory");
            const unsigned og = xb_add(&bar[XB_TOP], 1u);
            const unsigned tg = og / nx;
            if (og + 1u == (tg + 1u) * nx) xb_add(&bar[XB_TOPGEN], 1u);
            else XB_SPIN(xb_ld(&bar[XB_TOPGEN]) == tg, bar);
            __builtin_amdgcn_fence(__ATOMIC_ACQUIRE, "agent");
            xb_add(&bar[XB_XGEN(b.x)], 1u);
            asm volatile("s_waitcnt vmcnt(0)" ::: "memory");
        } else {
            XB_SPIN(xb_ld(&bar[XB_XGEN(b.x)]) == gen, bar);
            __builtin_amdgcn_fence(__ATOMIC_ACQUIRE, "agent");
            asm volatile("s_waitcnt vmcnt(0)" ::: "memory");
        }
    }
    __syncthreads();
}

enum In { I_X = 0, I_MEM, I_MIXPRE, I_MIXPOST, I_WIN, I_BF, I_POOLW, I_POOLS, I_WOUT, I_XAPRE, I_XAPOST, I_MEMN, I_XQ, I_XKV, I_XO, I_FFPRE, I_FFPOST,
          I_DG, I_DU, I_DD, I_RW, I_MG, I_MU, I_MD };

struct Args { const float* in[24]; float* out; unsigned char* ws; int ph_lo, ph_hi; };
__device__ __forceinline__ const __attribute__((address_space(4))) Args* kargs() { const __attribute__((address_space(4))) Args* p = (const __attribute__((address_space(4))) Args*)__builtin_amdgcn_kernarg_segment_ptr(); asm volatile("" : "+s"(p)); return p; }
#define WSB (kargs()->ws)
#define INP(i) (kargs()->in[i])
#define OUTP (kargs()->out)
struct Frame {
    LAS unsigned char* lds;
    gu32* ctl;
    int tid, lane, wave;
    int vcu, G;
};


__device__ __forceinline__ void fresh(Frame& F) { int t = threadIdx.x; asm volatile("" : "+v"(t)); F.tid = t; F.lane = t & 63; F.wave = __builtin_amdgcn_readfirstlane(t >> 6); }
__device__ __forceinline__ float wave_sum(float v) {
#pragma unroll
    for (int o = 1; o < 64; o <<= 1) v += __shfl_xor(v, o);
    return v;
}
__device__ __forceinline__ float wave_max(float v) {
#pragma unroll
    for (int o = 1; o < 64; o <<= 1) v = fmaxf(v, __shfl_xor(v, o));
    return v;
}
__device__ __forceinline__ float log_sigmoid(float x) { return x < 0.f ? x - log1pf(__expf(x)) : -log1pf(__expf(-x)); }

__device__ __forceinline__ void transpose_item(const float* W, int ldw, int col0, int k0, bf16* WT, int ldwt, int row0, LAS float* scr, int lane) {
#pragma unroll 8
    for (int i = 0; i < 32; ++i) { const int kk = 2 * i + (lane >> 5); scr[kk * 33 + (lane & 31)] = W[(size_t)(k0 + kk) * ldw + col0 + (lane & 31)]; }
    LDS_WAIT(); asm volatile("" ::: "memory");
    const int c = lane & 7;
#pragma unroll
    for (int j = 0; j < 4; ++j) { const int n = (lane >> 3) + 8 * j; const LAS float* s = scr + (8 * c) * 33 + n;
        v4u o; o.x = pk2(s[0 * 33], s[1 * 33]); o.y = pk2(s[2 * 33], s[3 * 33]); o.z = pk2(s[4 * 33], s[5 * 33]); o.w = pk2(s[6 * 33], s[7 * 33]);
        *(GAS v4u*)(WT + (size_t)(row0 + n) * ldwt + k0 + 8 * c) = o; }
    LDS_WAIT(); asm volatile("" ::: "memory");
}
__device__ __forceinline__ void transpose_mat(Frame& F, const float* W, int ldw, int col0, int ncols, int K, bf16* WT, int row0, LAS float* scr) {
    const int gw = F.vcu * NWAVES + F.wave, NGW = F.G * NWAVES; const int nkb = K / 64, nitems = nkb * (ncols / 32);
    for (int it = gw; it < nitems; it += NGW) { const int kb = it % nkb, nb = it / nkb; transpose_item(W, ldw, col0 + 32 * nb, 64 * kb, WT, K, row0 + 32 * nb, scr, F.lane); }
}
__device__ __forceinline__ void transpose_gu(Frame& F, const float* Wg, const float* Wu, bf16* WT, LAS float* scr) {
    const int gw = F.vcu * NWAVES + F.wave, NGW = F.G * NWAVES; const int nkb = D / 64, ncb = DFF / 32, nitems = 2 * nkb * ncb;
    for (int it = gw; it < nitems; it += NGW) { const int kb = it % nkb, r = it / nkb, nb = r % ncb, which = r / ncb; const int n0 = 32 * nb;
        transpose_item(which ? Wu : Wg, DFF, n0, 64 * kb, WT, D, 256 * (n0 / 128) + 128 * which + (n0 % 128), scr, F.lane); }
}
__device__ __forceinline__ void convert_layer_small(Frame& F, int l, bf16* base, LAS float* scr) {
    const float* win = INP(I_WIN) + (size_t)l * D * CIN;
    bf16* wt = base + OW_IN / 2;
    transpose_mat(F, win, CIN, 0, 768, D, wt, 0, scr);
    transpose_mat(F, win, CIN, 1152, 768, D, wt, 768, scr);
    transpose_mat(F, win, CIN, 2310, 256, D, wt, 1536, scr);
    transpose_mat(F, win, CIN, 768, 384, D, wt, 1792, scr);
    transpose_mat(F, win, CIN, 1920, 384, D, wt, 2176, scr);
    transpose_mat(F, INP(I_WOUT) + (size_t)l * D * D, D, 0, D, D, base + OW_OUT / 2, 0, scr);
    transpose_mat(F, INP(I_XQ) + (size_t)l * D * D, D, 0, D, D, base + OW_Q / 2, 0, scr);
    transpose_mat(F, INP(I_XKV) + (size_t)l * D * 2 * D, 2 * D, 0, 2 * D, D, base + OW_KV / 2, 0, scr);
    transpose_mat(F, INP(I_XO) + (size_t)l * D * D, D, 0, D, D, base + OW_O / 2, 0, scr);
    float* wf = (float*)(WSB + WS_WF) + (size_t)l * 8 * D;
    for (int i = (F.vcu * NWAVES + F.wave) * 64 + F.lane; i < 6 * D; i += F.G * NWAVES * 64) { const int j = i / D, k = i % D; wf[j * D + k] = win[(size_t)k * CIN + 2304 + j]; }
}

template <int DELTA, bool WRITE_H, bool WRITE_HN, int EXTRA>
__device__ __forceinline__ void thin_rows(Frame& F, const float* h_in, const bf16* delta, const float* g_post, float* h_out, const float* g_pre, bf16* hn_out,
                                          const float* wx, const float* bfo, float* logf, int* tokt, gu32* cnt) {
    const int gw = F.vcu * NWAVES + F.wave, NGW = F.G * NWAVES, lane = F.lane;
    for (int row = gw; row < NTOK; row += NGW) {
        f32x4 v[4];
#pragma unroll
        for (int j = 0; j < 4; ++j) v[j] = *(const f32x4*)(h_in + (size_t)row * D + 4 * lane + 256 * j);
        if constexpr (DELTA != 0) {
            f32x4 d[4];
            if constexpr (DELTA == 1) {
#pragma unroll
                for (int j = 0; j < 4; ++j) { const v2u r = *(const v2u*)(delta + (size_t)row * D + 4 * lane + 256 * j); d[j] = (f32x4){bflo(r.x), bfhi(r.x), bflo(r.y), bfhi(r.y)}; }
            } else {
                const int d0 = tokt[row * 8 + 1], d1 = tokt[row * 8 + 4]; const float g0 = __int_as_float(tokt[row * 8 + 2]), g1 = __int_as_float(tokt[row * 8 + 5]);
#pragma unroll
                for (int j = 0; j < 4; ++j) { const v2u r0 = *(const v2u*)(delta + (size_t)d0 * D + 4 * lane + 256 * j), r1 = *(const v2u*)(delta + (size_t)d1 * D + 4 * lane + 256 * j);
                    d[j] = (f32x4){g0 * bflo(r0.x) + g1 * bflo(r1.x), g0 * bfhi(r0.x) + g1 * bfhi(r1.x), g0 * bflo(r0.y) + g1 * bflo(r1.y), g0 * bfhi(r0.y) + g1 * bfhi(r1.y)}; }
            }
            float ss = 0.f;
#pragma unroll
            for (int j = 0; j < 4; ++j) ss += (d[j].x * d[j].x + d[j].y * d[j].y) + (d[j].z * d[j].z + d[j].w * d[j].w);
            const float rs = rsqrtf(wave_sum(ss) * (1.f / D) + EPS);
#pragma unroll
            for (int j = 0; j < 4; ++j) { const f32x4 g = *(const f32x4*)(g_post + 4 * lane + 256 * j); v[j] = v[j] + d[j] * rs * g; }
        }
        if constexpr (WRITE_H) {
#pragma unroll
            for (int j = 0; j < 4; ++j) *(f32x4*)(h_out + (size_t)row * D + 4 * lane + 256 * j) = v[j];
        }
        if constexpr (WRITE_HN) {
            float ss = 0.f;
#pragma unroll
            for (int j = 0; j < 4; ++j) ss += (v[j].x * v[j].x + v[j].y * v[j].y) + (v[j].z * v[j].z + v[j].w * v[j].w);
            const float rs = rsqrtf(wave_sum(ss) * (1.f / D) + EPS);
#pragma unroll
            for (int j = 0; j < 4; ++j) { const f32x4 g = *(const f32x4*)(g_pre + 4 * lane + 256 * j); v[j] = v[j] * rs * g;
                v2u o; o.x = pk2(v[j].x, v[j].y); o.y = pk2(v[j].z, v[j].w); *(v2u*)(hn_out + (size_t)row * D + 4 * lane + 256 * j) = o; }
            if constexpr (EXTRA == 1) {
                float lg[6];
#pragma unroll
                for (int e = 0; e < 6; ++e) { float s = 0.f;
#pragma unroll
                    for (int j = 0; j < 4; ++j) { const f32x4 w = *(const f32x4*)(wx + e * D + 4 * lane + 256 * j); s += (v[j].x * w.x + v[j].y * w.y) + (v[j].z * w.z + v[j].w * w.w); }
                    lg[e] = wave_sum(s); }
                if (lane < 6) { float x = lg[0];
#pragma unroll
                    for (int e = 1; e < 6; ++e) x = (lane == e) ? lg[e] : x;
                    logf[(size_t)row * 8 + lane] = log_sigmoid(x + bfo[lane]); }
            }
            if constexpr (EXTRA == 2) {
                float lg[8];
#pragma unroll
                for (int e = 0; e < 8; ++e) { float s = 0.f;
#pragma unroll
                    for (int j = 0; j < 4; ++j) { const f32x4 w = *(const f32x4*)(wx + e * D + 4 * lane + 256 * j); s += (v[j].x * w.x + v[j].y * w.y) + (v[j].z * w.z + v[j].w * w.w); }
                    lg[e] = wave_sum(s); }
                int e0 = 0; float v0 = lg[0];
#pragma unroll
                for (int e = 1; e < 8; ++e) if (lg[e] > v0) { v0 = lg[e]; e0 = e; }
                int e1 = -1; float v1 = -INFINITY;
#pragma unroll
                for (int e = 0; e < 8; ++e) if (e != e0 && lg[e] > v1) { v1 = lg[e]; e1 = e; }
                if (lane == 0) {
                    const float g0 = 1.f / (1.f + __expf(v1 - v0)), g1 = 1.f - g0;
                    const unsigned p0 = __hip_atomic_fetch_add(cnt + e0, 1u, RLX_AGENT), p1 = __hip_atomic_fetch_add(cnt + e1, 1u, RLX_AGENT);
                    int* t = tokt + (size_t)row * 8; t[0] = e0; t[1] = (int)p0; t[2] = __float_as_int(g0); t[3] = e1; t[4] = (int)p1; t[5] = __float_as_int(g1);
                }
            }
        }
    }
}
__device__ __forceinline__ void mem_norm(Frame& F, const float* mem, const float* g, bf16* mn) {
    const int gw = F.vcu * NWAVES + F.wave, NGW = F.G * NWAVES, lane = F.lane;
    for (int row = gw; row < NMEM; row += NGW) {
        f32x4 v[4]; float ss = 0.f;
#pragma unroll
        for (int j = 0; j < 4; ++j) { v[j] = *(const f32x4*)(mem + (size_t)row * D + 4 * lane + 256 * j); ss += (v[j].x * v[j].x + v[j].y * v[j].y) + (v[j].z * v[j].z + v[j].w * v[j].w); }
        const float rs = rsqrtf(wave_sum(ss) * (1.f / D) + EPS);
#pragma unroll
        for (int j = 0; j < 4; ++j) { const f32x4 gg = *(const f32x4*)(g + 4 * lane + 256 * j); v[j] = v[j] * rs * gg;
            v2u o; o.x = pk2(v[j].x, v[j].y); o.y = pk2(v[j].z, v[j].w); *(v2u*)(mn + (size_t)row * D + 4 * lane + 256 * j) = o; }
    }
}
__device__ __forceinline__ void scan_logf(Frame& F, const float* logf, float* ccum) {
    if (blockIdx.x >= NBATCH * NFX) return;
    const int b = blockIdx.x / NFX, h = blockIdx.x % NFX, tid = F.tid;
    LAS float* wsum = (LAS float*)(F.lds + RING_OFF);
    float x[16]; float run = 0.f;
#pragma unroll
    for (int i = 0; i < 16; ++i) { run += logf[((size_t)b * SEQ + tid * 16 + i) * 8 + h]; x[i] = run; }
    float incl = run;
#pragma unroll
    for (int o = 1; o < 64; o <<= 1) { const float t = __shfl_up(incl, o); if (F.lane >= o) incl += t; }
    if (F.lane == 63) wsum[F.wave] = incl;
    LDS_WAIT(); __syncthreads();
    float base = incl - run;
    for (int w = 0; w < F.wave; ++w) base += wsum[w];
    float* o = ccum + ((size_t)b * NFX + h) * SEQ + tid * 16;
#pragma unroll
    for (int i = 0; i < 16; ++i) o[i] = base + x[i];
    __syncthreads();
}

__device__ __forceinline__ void load_row64(const bf16* p, float* q) {
#pragma unroll
    for (int i = 0; i < 8; ++i) { const v4u r = *(const v4u*)(p + 8 * i); q[8 * i + 0] = bflo(r.x); q[8 * i + 1] = bfhi(r.x); q[8 * i + 2] = bflo(r.y); q[8 * i + 3] = bfhi(r.y);
        q[8 * i + 4] = bflo(r.z); q[8 * i + 5] = bfhi(r.z); q[8 * i + 6] = bflo(r.w); q[8 * i + 7] = bfhi(r.w); }
}
__device__ __forceinline__ void load_col64(const bf16* p, float* q) {
#pragma unroll
    for (int i = 0; i < 64; ++i) q[i] = bf2f(p[(size_t)i * NTOK]);
}
__device__ __forceinline__ void store_row64(bf16* p, const float* o, float sc) {
#pragma unroll
    for (int i = 0; i < 8; ++i) { v4u w; w.x = pk2(o[8 * i] * sc, o[8 * i + 1] * sc); w.y = pk2(o[8 * i + 2] * sc, o[8 * i + 3] * sc); w.z = pk2(o[8 * i + 4] * sc, o[8 * i + 5] * sc); w.w = pk2(o[8 * i + 6] * sc, o[8 * i + 7] * sc);
        *(v4u*)(p + 8 * i) = w; }
}
__device__ __forceinline__ void sb_naive(Frame& F, const bf16* proj, const bf16* vt, bf16* mix) {
    const int gw = F.vcu * NWAVES + F.wave, NGW = F.G * NWAVES, lane = F.lane;
    const int NU = NBATCH * NSB * (SEQ / 64);
    for (int u = gw; u < NU; u += NGW) {
        const int bh = u / (SEQ / 64), tb = (SEQ / 64 - 1) - u % (SEQ / 64), b = bh / NSB, h = bh % NSB, t0 = tb * 64, t = t0 + lane;
        const bf16* base = proj + (size_t)b * SEQ * PP;
        float q[64], o[64];
        load_row64(base + (size_t)t * PP + C_SQ + h * HD, q);
#pragma unroll
        for (int d = 0; d < 64; ++d) o[d] = 0.f;
        float R = 0.f;
        for (int s = t0 + 62; s >= 0; --s) {
            const bf16* kr = base + (size_t)s * PP + C_SK + h * HD; const bf16* vr = vt + (size_t)(h * HD) * NTOK + (size_t)b * SEQ + s;
            float kk[64]; load_row64(kr, kk);
            float z = 0.f;
#pragma unroll
            for (int d = 0; d < 64; ++d) z += q[d] * kk[d];
            z *= 0.125f;
            const bool act = s < t;
            const float lb = log_sigmoid(z), lk = lb - z;
            const float w = act ? __expf(lb + R) : 0.f;
            load_col64(vr, kk);
#pragma unroll
            for (int d = 0; d < 64; ++d) o[d] += w * kk[d];
            R += act ? lk : 0.f;
            if (__all(R < -104.f)) break;
        }
        store_row64(mix + ((size_t)b * SEQ + t) * D + h * HD, o, 1.f);
    }
}
__device__ __forceinline__ void fox_naive(Frame& F, const bf16* proj, const bf16* vt, const float* ccum, bf16* mix) {
    const int gw = F.vcu * NWAVES + F.wave, NGW = F.G * NWAVES, lane = F.lane;
    const int NU = NBATCH * NFX * (SEQ / 64);
    for (int u = gw; u < NU; u += NGW) {
        const int bh = u / (SEQ / 64), tb = (SEQ / 64 - 1) - u % (SEQ / 64), b = bh / NFX, h = bh % NFX, t0 = tb * 64, t = t0 + lane;
        const bf16* base = proj + (size_t)b * SEQ * PP; const float* cc = ccum + (size_t)bh * SEQ;
        float q[64], o[64];
        load_row64(base + (size_t)t * PP + C_FQ + h * HD, q);
#pragma unroll
        for (int d = 0; d < 64; ++d) o[d] = 0.f;
        const float ct = cc[t]; float m = -INFINITY, l = 0.f;
        for (int s = t0 + 63; s >= 0; --s) {
            const bf16* kr = base + (size_t)s * PP + C_FK + h * HD; const bf16* vr = vt + (size_t)(SBD + h * HD) * NTOK + (size_t)b * SEQ + s;
            float kk[64]; load_row64(kr, kk);
            float z = 0.f;
#pragma unroll
            for (int d = 0; d < 64; ++d) z += q[d] * kk[d];
            const bool act = s <= t;
            const float lg = act ? (z * 0.125f + (ct - cc[s])) : -INFINITY;
            const float mn = fmaxf(m, lg);
            const float sc = (mn == m) ? 1.f : __expf(m - mn);
            const float p = act ? __expf(lg - mn) : 0.f;
            m = mn; l = l * sc + p;
            load_col64(vr, kk);
#pragma unroll
            for (int d = 0; d < 64; ++d) o[d] = o[d] * sc + p * kk[d];
        }
        store_row64(mix + ((size_t)b * SEQ + t) * D + SBD + h * HD, o, 1.f / l);
    }
}
__device__ __forceinline__ void pool_units(Frame& F, const bf16* proj, const float* pool_w, const float* pool_scale, bf16* mix) {
    LAS float* U = (LAS float*)(F.lds + RING_OFF);
    LAS float* R = U + 143 * 64;
    LAS float* W = R + 128 * 64;
    const int NU = (NTOK / 128) * 4, tid = F.tid;
    for (int u = F.vcu; u < NU; u += F.G) {
        const int g = u & 3, tile = u >> 2, tok0 = tile * 128, pos0 = tok0 % SEQ, win = 2 << g;
        for (int i = tid; i < 143 * 64; i += 512) { const int r = i >> 6, c = i & 63; const int pos = pos0 - 15 + r;
            U[i] = pos >= 0 ? bf2f(proj[(size_t)(tok0 - 15 + r) * PP + C_U + g * 64 + c]) : 0.f; }
        for (int i = tid; i < 64 * 64; i += 512) W[i] = pool_w[g * 4096 + i];
        LDS_WAIT(); __syncthreads();
        for (int i = tid; i < 128 * 64; i += 512) { const int r = i >> 6, c = i & 63; const int pos = pos0 + r; const int cntw = (pos + 1 < win) ? pos + 1 : win;
            float s = 0.f; for (int j = 0; j < cntw; ++j) s += U[(15 + r - j) * 64 + c];
            R[i] = s / (float)cntw - U[(15 + r) * 64 + c]; }
        LDS_WAIT(); __syncthreads();
        { const int co = tid & 63, tq = tid >> 6; float acc[16];
#pragma unroll
          for (int j = 0; j < 16; ++j) acc[j] = 0.f;
          for (int ci = 0; ci < 64; ++ci) { const float w = W[ci * 64 + co];
#pragma unroll
              for (int j = 0; j < 16; ++j) acc[j] += R[(tq * 16 + j) * 64 + ci] * w; }
          const float ps = pool_scale[g * 64 + co];
#pragma unroll
          for (int j = 0; j < 16; ++j) mix[(size_t)(tok0 + tq * 16 + j) * D + SBD + FXD + g * 64 + co] = (bf16)f2bf(acc[j] * ps); }
        __syncthreads();
    }
}
__device__ __forceinline__ void xa_naive(Frame& F, const bf16* xq, const bf16* xkv, bf16* xo) {
    const int gw = F.vcu * NWAVES + F.wave, NGW = F.G * NWAVES, lane = F.lane;
    LAS float* qs = (LAS float*)(F.lds + RING_OFF) + F.wave * 512;
    LAS float* ps = qs + 256;
    for (int tok = gw; tok < NTOK; tok += NGW) {
        const int b = tok / SEQ;
        for (int hd = 0; hd < XAH; ++hd) {
            { const v2u r = *(const v2u*)(xq + (size_t)tok * D + hd * XAD + 4 * lane); qs[4 * lane] = bflo(r.x); qs[4 * lane + 1] = bfhi(r.x); qs[4 * lane + 2] = bflo(r.y); qs[4 * lane + 3] = bfhi(r.y); }
            LDS_WAIT();
            float lg[4] = {0.f, 0.f, 0.f, 0.f};
            for (int d8 = 0; d8 < 32; ++d8) {
                const f32x4 qa = *(const LAS f32x4*)(qs + 8 * d8), qb = *(const LAS f32x4*)(qs + 8 * d8 + 4);
#pragma unroll
                for (int j = 0; j < 4; ++j) { const v4u r = *(const v4u*)(xkv + (size_t)(b * MEML + lane + 64 * j) * (2 * D) + hd * XAD + 8 * d8);
                    lg[j] += (qa.x * bflo(r.x) + qa.y * bfhi(r.x)) + (qa.z * bflo(r.y) + qa.w * bfhi(r.y)) + (qb.x * bflo(r.z) + qb.y * bfhi(r.z)) + (qb.z * bflo(r.w) + qb.w * bfhi(r.w)); }
            }
            float mx = -INFINITY;
#pragma unroll
            for (int j = 0; j < 4; ++j) { lg[j] *= 0.0625f; mx = fmaxf(mx, lg[j]); }
            mx = wave_max(mx);
            float sm = 0.f;
#pragma unroll
            for (int j = 0; j < 4; ++j) { lg[j] = __expf(lg[j] - mx); sm += lg[j]; }
            sm = wave_sum(sm); const float inv = 1.f / sm;
#pragma unroll
            for (int j = 0; j < 4; ++j) ps[lane + 64 * j] = lg[j] * inv;
            LDS_WAIT();
            float o0 = 0.f, o1 = 0.f, o2 = 0.f, o3 = 0.f;
            for (int key = 0; key < MEML; ++key) { const float p = ps[key]; const v2u r = *(const v2u*)(xkv + (size_t)(b * MEML + key) * (2 * D) + D + hd * XAD + 4 * lane);
                o0 += p * bflo(r.x); o1 += p * bfhi(r.x); o2 += p * bflo(r.y); o3 += p * bfhi(r.y); }
            v2u w; w.x = pk2(o0, o1); w.y = pk2(o2, o3); *(v2u*)(xo + (size_t)tok * D + hd * XAD + 4 * lane) = w;
            LDS_WAIT();
        }
    }
}

typedef short bf16x8 __attribute__((ext_vector_type(8)));
typedef float f32x16 __attribute__((ext_vector_type(16)));
__device__ __forceinline__ int kperm(int r) { const int g = (r >> 2) & 3; const int g2 = (g == 1) ? 2 : (g == 2) ? 1 : g; return (r & 16) + 4 * g2 + (r & 3); }
__device__ __forceinline__ float xhalf(float v) { return __shfl_xor(v, 32); }
__device__ __forceinline__ bf16x8 pack8(const f32x16& p, int s) {
    v4u w; w.x = pg8::cvt_pk_bf16(p[8 * s + 0], p[8 * s + 1]); w.y = pg8::cvt_pk_bf16(p[8 * s + 2], p[8 * s + 3]); w.z = pg8::cvt_pk_bf16(p[8 * s + 4], p[8 * s + 5]); w.w = pg8::cvt_pk_bf16(p[8 * s + 6], p[8 * s + 7]);
    return __builtin_bit_cast(bf16x8, w);
}
__device__ __forceinline__ void store_ot(bf16* dst, const f32x16& o, float sc, int hh) {
#pragma unroll
    for (int g = 0; g < 4; ++g) { v2u w; w.x = pg8::cvt_pk_bf16(o[4 * g] * sc, o[4 * g + 1] * sc); w.y = pg8::cvt_pk_bf16(o[4 * g + 2] * sc, o[4 * g + 3] * sc); *(v2u*)(dst + 8 * g + 4 * hh) = w; }
}

__device__ __forceinline__ void fox_knorm(Frame& F, const bf16* proj, gu32* kmax) {
    const int gw = F.vcu * NWAVES + F.wave, NGW = F.G * NWAVES, lane = F.lane;
    const int NU = NBATCH * NFX * (SEQ / 64);
    for (int u = gw; u < NU; u += NGW) {
        const int bh = u / (SEQ / 64), tb = u % (SEQ / 64), b = bh / NFX, h = bh % NFX;
        const bf16* kr = proj + ((size_t)b * SEQ + tb * 64 + lane) * PP + C_FK + h * HD;
        float ss = 0.f;
#pragma unroll
        for (int i = 0; i < 8; ++i) { const v4u r = *(const v4u*)(kr + 8 * i);
            ss += (bflo(r.x) * bflo(r.x) + bfhi(r.x) * bfhi(r.x)) + (bflo(r.y) * bflo(r.y) + bfhi(r.y) * bfhi(r.y)) + (bflo(r.z) * bflo(r.z) + bfhi(r.z) * bfhi(r.z)) + (bflo(r.w) * bflo(r.w) + bfhi(r.w) * bfhi(r.w)); }
        ss = wave_max(ss);
        if (lane == 0) __hip_atomic_fetch_max(kmax + bh, __float_as_uint(ss), RLX_AGENT);
    }
}
#ifndef FOX_THR
#define FOX_THR 104.0f
#endif
__device__ __forceinline__ void fox_mfma(Frame& F, const bf16* proj, const bf16* vt, const float* ccum, const gu32* kmax, bf16* mix) {
    const int gw = F.vcu * NWAVES + F.wave, NGW = F.G * NWAVES, lane = F.lane, r = lane & 31, hh = lane >> 5;
    const int NQT = SEQ / 32, NU = NBATCH * NFX * NQT;
    for (int u = gw; u < NU; u += NGW) {
        const int bh = u / NQT, qt = (NQT - 1) - u % NQT, b = bh / NFX, h = bh % NFX, tq = qt * 32 + r;
        const size_t tokb = (size_t)b * SEQ;
        const float* cc = ccum + (size_t)bh * SEQ;
        bf16x8 qf[4]; float qn = 0.f;
        { const bf16* qp = proj + (tokb + tq) * PP + C_FQ + h * HD + 8 * hh;
#pragma unroll
          for (int ks = 0; ks < 4; ++ks) { qf[ks] = *(const bf16x8*)(qp + 16 * ks);
#pragma unroll
              for (int j = 0; j < 8; ++j) { const float x = bf2f((bf16)qf[ks][j]); qn += x * x; } } }
        qn += xhalf(qn);
        const float zb = 0.125f * sqrtf(qn * __uint_as_float(__hip_atomic_load(kmax + bh, RLX_AGENT))) * 1.01f + 0.01f;
        const float ct = cc[tq];
        float m = -INFINITY, l = 0.f; f32x16 o[2] = {};
        const bf16* kbase = proj + tokb * PP + C_FK + h * HD + 8 * hh;
        const bf16* vbase = vt + (size_t)(SBD + h * HD + r) * NTOK + tokb + 8 * hh;
        for (int kb = qt; kb >= 0; --kb) {
            const int s0 = kb * 32;
            const bf16* kp = kbase + (size_t)(s0 + kperm(r)) * PP;
            f32x16 S = {};
#pragma unroll
            for (int ks = 0; ks < 4; ++ks) { const bf16x8 kf = *(const bf16x8*)(kp + 16 * ks); S = __builtin_amdgcn_mfma_f32_32x32x16_bf16(kf, qf[ks], S, 0, 0, 0); }
            float bm = -INFINITY;
#pragma unroll
            for (int s2 = 0; s2 < 2; ++s2) {
                const f32x4 c0 = *(const f32x4*)(cc + s0 + 16 * s2 + 8 * hh), c1 = *(const f32x4*)(cc + s0 + 16 * s2 + 8 * hh + 4);
#pragma unroll
                for (int j = 0; j < 8; ++j) { const float cs = j < 4 ? c0[j] : c1[j - 4]; const int key = s0 + 16 * s2 + 8 * hh + j;
                    float x = S[8 * s2 + j] * 0.125f + (ct - cs); if (kb == qt && key > tq) x = -INFINITY; S[8 * s2 + j] = x; bm = fmaxf(bm, x); }
            }
            bm = fmaxf(bm, xhalf(bm));
            const float mn = fmaxf(m, bm), sc = __expf(m - mn);
            float ps = 0.f;
#pragma unroll
            for (int i = 0; i < 16; ++i) { const float pv = __expf(S[i] - mn); S[i] = pv; ps += pv; }
            l = l * sc + ps; m = mn;
#pragma unroll
            for (int i = 0; i < 16; ++i) { o[0][i] *= sc; o[1][i] *= sc; }
            const bf16x8 p0 = pack8(S, 0), p1 = pack8(S, 1);
#pragma unroll
            for (int db = 0; db < 2; ++db) { const bf16* vp = vbase + (size_t)db * 32 * NTOK + s0;
                const bf16x8 v0 = *(const bf16x8*)vp, v1 = *(const bf16x8*)(vp + 16);
                o[db] = __builtin_amdgcn_mfma_f32_32x32x16_bf16(v0, p0, o[db], 0, 0, 0); o[db] = __builtin_amdgcn_mfma_f32_32x32x16_bf16(v1, p1, o[db], 0, 0, 0); }
            if (kb > 0) { const float cprev = cc[s0 - 1]; if (__all(zb + (ct - cprev) < m - FOX_THR)) break; }
        }
        l += xhalf(l);
        const float inv = 1.f / l;
        bf16* op = mix + (tokb + tq) * D + SBD + h * HD;
        store_ot(op, o[0], inv, hh); store_ot(op + 32, o[1], inv, hh);
    }
}

#ifndef SB_THR
#define SB_THR 104.0f
#endif
__device__ __forceinline__ void sb_mfma(Frame& F, const bf16* proj, const bf16* vt, bf16* mix) {
    const int gw = F.vcu * NWAVES + F.wave, NGW = F.G * NWAVES, lane = F.lane, r = lane & 31, hh = lane >> 5;
    const int NQT = SEQ / 32, NU = NBATCH * NSB * NQT;
    for (int u = gw; u < NU; u += NGW) {
        const int bh = u / NQT, qt = (NQT - 1) - u % NQT, b = bh / NSB, h = bh % NSB, tq = qt * 32 + r;
        const size_t tokb = (size_t)b * SEQ;
        bf16x8 qf[4];
        { const bf16* qp = proj + (tokb + tq) * PP + C_SQ + h * HD + 8 * hh;
#pragma unroll
          for (int ks = 0; ks < 4; ++ks) qf[ks] = *(const bf16x8*)(qp + 16 * ks); }
        float R = 0.f; f32x16 o[2] = {};
        const bf16* kbase = proj + tokb * PP + C_SK + h * HD + 8 * hh;
        const bf16* vbase = vt + (size_t)(h * HD + r) * NTOK + tokb + 8 * hh;
        for (int kb = qt; kb >= 0; --kb) {
            const int s0 = kb * 32;
            const bf16* kp = kbase + (size_t)(s0 + kperm(r)) * PP;
            f32x16 S = {};
#pragma unroll
            for (int ks = 0; ks < 4; ++ks) { const bf16x8 kf = *(const bf16x8*)(kp + 16 * ks); S = __builtin_amdgcn_mfma_f32_32x32x16_bf16(kf, qf[ks], S, 0, 0, 0); }
            float lk[16], lb[16];
#pragma unroll
            for (int i = 0; i < 16; ++i) { const float z = S[i] * 0.125f; const int key = s0 + 16 * (i >> 3) + 8 * hh + (i & 7);
                const float sp = fmaxf(z, 0.f) + __logf(1.f + __expf(-fabsf(z)));
                const bool valid = (kb < qt) || (key < tq);
                lk[i] = valid ? -sp : 0.f; lb[i] = valid ? (z - sp) : -INFINITY; }
            float sufA[8], sufB[8]; float TA = 0.f, TB = 0.f;
#pragma unroll
            for (int j = 7; j >= 0; --j) { sufA[j] = TA; TA += lk[j]; sufB[j] = TB; TB += lk[8 + j]; }
            const float PA = xhalf(TA), PB = xhalf(TB);
            const float offB = R + (hh ? 0.f : PB);
            const float offA = R + TB + PB + (hh ? 0.f : PA);
#pragma unroll
            for (int j = 0; j < 8; ++j) { S[j] = __expf(lb[j] + offA + sufA[j]); S[8 + j] = __expf(lb[8 + j] + offB + sufB[j]); }
            R += (TA + TB) + (PA + PB);
            const bf16x8 p0 = pack8(S, 0), p1 = pack8(S, 1);
#pragma unroll
            for (int db = 0; db < 2; ++db) { const bf16* vp = vbase + (size_t)db * 32 * NTOK + s0;
                const bf16x8 v0 = *(const bf16x8*)vp, v1 = *(const bf16x8*)(vp + 16);
                o[db] = __builtin_amdgcn_mfma_f32_32x32x16_bf16(v0, p0, o[db], 0, 0, 0); o[db] = __builtin_amdgcn_mfma_f32_32x32x16_bf16(v1, p1, o[db], 0, 0, 0); }
            if (__all(R < -SB_THR)) break;
        }
        bf16* op = mix + (tokb + tq) * D + h * HD;
        store_ot(op, o[0], 1.f, hh); store_ot(op + 32, o[1], 1.f, hh);
    }
}
__device__ __forceinline__ void xa_mfma(Frame& F, const bf16* xq, const bf16* xk, const bf16* xvt, bf16* xo) {
    const int gw = F.vcu * NWAVES + F.wave, NGW = F.G * NWAVES, lane = F.lane, r = lane & 31, hh = lane >> 5;
    const int NU = (NTOK / 32) * XAH;
    for (int u = gw; u < NU; u += NGW) {
        const int hd = u & 3, tb = u >> 2, tok0 = tb * 32, b = tok0 / SEQ;
        bf16x8 qf[16];
        { const bf16* qp = xq + (size_t)(tok0 + r) * D + hd * XAD + 8 * hh;
#pragma unroll
          for (int ks = 0; ks < 16; ++ks) qf[ks] = *(const bf16x8*)(qp + 16 * ks); }
        f32x16 S[8];
#pragma unroll
        for (int kb = 0; kb < 8; ++kb) {
            const bf16* kp = xk + (size_t)(b * MEML + kb * 32 + kperm(r)) * D + hd * XAD + 8 * hh;
            f32x16 acc = {};
#pragma unroll
            for (int ks = 0; ks < 16; ++ks) { const bf16x8 kf = *(const bf16x8*)(kp + 16 * ks); acc = __builtin_amdgcn_mfma_f32_32x32x16_bf16(kf, qf[ks], acc, 0, 0, 0); }
            S[kb] = acc;
        }
        float mx = -INFINITY;
#pragma unroll
        for (int kb = 0; kb < 8; ++kb)
#pragma unroll
            for (int i = 0; i < 16; ++i) mx = fmaxf(mx, S[kb][i]);
        mx = fmaxf(mx, xhalf(mx));
        float sm = 0.f;
#pragma unroll
        for (int kb = 0; kb < 8; ++kb)
#pragma unroll
            for (int i = 0; i < 16; ++i) { const float e = __expf((S[kb][i] - mx) * 0.0625f); S[kb][i] = e; sm += e; }
        sm += xhalf(sm);
        const float inv = 1.f / sm;
        bf16x8 pb[8][2];
#pragma unroll
        for (int kb = 0; kb < 8; ++kb) { pb[kb][0] = pack8(S[kb], 0); pb[kb][1] = pack8(S[kb], 1); }
#pragma unroll
        for (int half = 0; half < 2; ++half) {
            f32x16 o[4] = {};
            const bf16* vp = xvt + (size_t)(hd * XAD + half * 128 + r) * NMEM + b * MEML + 8 * hh;
#pragma unroll
            for (int kb = 0; kb < 8; ++kb)
#pragma unroll
                for (int s2 = 0; s2 < 2; ++s2)
#pragma unroll
                    for (int db = 0; db < 4; ++db) { const bf16x8 vf = *(const bf16x8*)(vp + (size_t)db * 32 * NMEM + kb * 32 + 16 * s2); o[db] = __builtin_amdgcn_mfma_f32_32x32x16_bf16(vf, pb[kb][s2], o[db], 0, 0, 0); }
#pragma unroll
            for (int db = 0; db < 4; ++db) store_ot(xo + (size_t)(tok0 + r) * D + hd * XAD + half * 128 + db * 32, o[db], inv, hh);
        }
    }
}
__device__ __forceinline__ void moe_offsets(const gu32* cnt, int (&pstart)[8], int& nblk) {
    int acc = 0;
#pragma unroll
    for (int e = 0; e < 8; ++e) { const int c = (int)__hip_atomic_load(cnt + e, RLX_AGENT); pstart[e] = acc; acc += ((c + 255) >> 8) << 8; }
    nblk = acc >> 8;
}
__device__ __forceinline__ void moe_gather(Frame& F, const bf16* hn, bf16* xs, int* tokt, int* blke) {
    int pstart[8], nblk; moe_offsets(F.ctl + CW_CNT, pstart, nblk);
    if (blockIdx.x == 0 && F.tid < MAXBLK + 1) {
        if (F.tid == MAXBLK) blke[MAXBLK] = nblk;
        else { int e = 0;
#pragma unroll
            for (int j = 1; j < 8; ++j) if (F.tid * 256 >= pstart[j]) e = j;
            blke[F.tid] = e; }
    }
    const int gw = F.vcu * NWAVES + F.wave, NGW = F.G * NWAVES, lane = F.lane;
    for (int row = gw; row < NTOK; row += NGW) {
        int* t = tokt + (size_t)row * 8; const int e0 = t[0], p0 = t[1], e1 = t[3], p1 = t[4];
        int s0 = 0, s1 = 0;
#pragma unroll
        for (int j = 0; j < 8; ++j) { s0 = (e0 == j) ? pstart[j] : s0; s1 = (e1 == j) ? pstart[j] : s1; }
        const int d0 = s0 + p0, d1 = s1 + p1;
#pragma unroll
        for (int j = 0; j < 2; ++j) { const v4u r = *(const v4u*)(hn + (size_t)row * D + 8 * lane + 512 * j);
            *(v4u*)(xs + (size_t)d0 * D + 8 * lane + 512 * j) = r; *(v4u*)(xs + (size_t)d1 * D + 8 * lane + 512 * j) = r; }
        asm volatile("" ::: "memory");
        if (lane == 0) { t[1] = d0; t[4] = d1; }
    }
}

constexpr int NPHASE = 30;
__global__ void __launch_bounds__(NWAVES * 64, 2) fwd(Args args) {
    extern __shared__ __attribute__((aligned(16))) unsigned char lds[];
    Frame F;
    F.lds = (LAS unsigned char*)lds;
    F.tid = threadIdx.x; F.lane = F.tid & 63; F.wave = __builtin_amdgcn_readfirstlane(F.tid >> 6);
    F.G = gridDim.x; { const int bx = blockIdx.x; F.vcu = (F.G % 8 == 0) ? (bx % 8) * (F.G / 8) + bx / 8 : bx; }
    F.ctl = (gu32*)(args.ws + WS_CTL);
    volatile LAS unsigned* MISC = (volatile LAS unsigned*)(F.lds + MISC_OFF);
    for (int u = F.tid; u < (LDS_BYTES - LDSCTL_OFF) / 4; u += NWAVES * 64) ((LAS unsigned*)(F.lds + LDSCTL_OFF))[u] = 0u;
    __syncthreads();
    XcdBarrier bar; bar.bar = (unsigned*)(F.ctl + CW_BAR); bar.x = 0; bar.st = nullptr;
    const int lo = args.ph_lo, hi = args.ph_hi;
    if (hi - lo > 1) bar = xcd_barrier_post((unsigned*)(F.ctl + CW_BAR), MISC + 8);
#ifndef PHASE_MASK
#define PHASE_MASK 0xffffffffffull
#endif
#define IN(k) ((((unsigned long long)(PHASE_MASK) >> (k)) & 1ull) && lo <= (k) && (k) < hi && (fresh(F), true))
#define SEAM(k) do { if (IN(k) && IN((k) + 1)) xcd_barrier(bar); } while (0)
#define ws WSB
#define scr ((LAS float*)(F.lds + RING_OFF + F.wave * 16384))
#define HN ((bf16*)(ws + R2_HN))
#define MIX ((bf16*)(ws + R2_MIX))
#define PROJ ((bf16*)(ws + R1_PROJ))
#define VT ((bf16*)(ws + R1_VT))
#define BA ((bf16*)(ws + R1_A))
#define BB ((bf16*)(ws + R1_B))
#define ACT ((bf16*)(ws + R1_ACT))
#define XS ((bf16*)(ws + R2_XS))
#define LOGF ((float*)(ws + WS_LOGF))
#define CCUM ((float*)(ws + WS_CCUM))
#define TOKT ((int*)(ws + WS_TOKT))
#define BLKE ((int*)(ws + WS_BLKE))
#define MN ((bf16*)(ws + WS_MN))
#define XKV ((bf16*)(ws + WS_XKV))
#define XK ((bf16*)(ws + WS_XKV))
#define XVT ((bf16*)(ws + WS_XKV + 2 * MiB))
    const int bx = (int)blockIdx.x;

#define GEMM_PLAIN(Aptr, Btptr, M_, N_, K_, Optr, ldc_) do { pg8::Gemm g{(const pg8::bf16_t*)(Aptr), (const pg8::bf16_t*)(Btptr), (M_), (N_), (K_)}; pg8::StaticOrder S; S.init(g, F.G, bx); \
        pg8::EpiBf16 E{(pg8::bf16_t*)(Optr), (ldc_), 0}; pg8::gemm_phase<pg8::EpiBf16, pg8::StaticOrder, true, true>(F.lds + RING_OFF, (K_), S, E); } while (0)

    if (IN(0)) {
        convert_layer_small(F, 0, (bf16*)(ws + WS_WS0), scr);
        convert_layer_small(F, 1, (bf16*)(ws + WS_WS1), scr);
        transpose_gu(F, INP(I_DG), INP(I_DU), (bf16*)(ws + WS_WGU0), scr);
        transpose_mat(F, INP(I_DD), D, 0, D, DFF, (bf16*)(ws + WS_WD0), 0, scr);
        { float* wr = (float*)(ws + WS_WR); for (int i = (F.vcu * NWAVES + F.wave) * 64 + F.lane; i < 8 * D; i += F.G * NWAVES * 64) { const int e = i / D, k = i % D; wr[e * D + k] = INP(I_RW)[(size_t)k * NE + e]; } }
        mem_norm(F, INP(I_MEM), INP(I_MEMN), MN);
    }
    SEAM(0);
    if (IN(1)) {
        thin_rows<0, false, true, 1>(F, INP(I_X), nullptr, nullptr, nullptr, INP(I_MIXPRE), HN, (const float*)(ws + WS_WF), INP(I_BF), LOGF, nullptr, nullptr);
    }
    SEAM(1);
#pragma unroll
    for (int l = 0; l < DEPTH; ++l) {
        const int p0 = (l == 0) ? 2 : 15;
        const bf16* WSL = (const bf16*)(ws + (l == 0 ? WS_WS0 : WS_WS1));
        const float* h_res = (l == 0) ? INP(I_X) : OUTP;
        if (IN(p0)) {
            scan_logf(F, LOGF, CCUM);
            GEMM_PLAIN(HN, WSL + OW_IN / 2, NTOK, PP, D, PROJ, PP);
            GEMM_PLAIN(WSL + OW_IN / 2 + (size_t)PP * D, HN, VTN, NTOK, D, VT, NTOK);
            GEMM_PLAIN(MN, WSL + OW_KV / 2, NMEM, D, D, XK, D);
            GEMM_PLAIN(WSL + OW_KV / 2 + (size_t)D * D, MN, D, NMEM, D, XVT, NMEM);
        }
        SEAM(p0);
        if (IN(p0 + 1)) {
            fox_knorm(F, PROJ, F.ctl + CW_KMAX + l * 24);
#ifdef SB_NAIVE
            sb_naive(F, PROJ, VT, MIX);
#else
            sb_mfma(F, PROJ, VT, MIX);
#endif
            pool_units(F, PROJ, INP(I_POOLW) + (size_t)l * 4 * 4096, INP(I_POOLS) + (size_t)l * POOLD, MIX);
        }
        SEAM(p0 + 1);
        if (IN(p0 + 2)) {
#ifdef FOX_NAIVE
            fox_naive(F, PROJ, VT, CCUM, MIX);
#else
            fox_mfma(F, PROJ, VT, CCUM, F.ctl + CW_KMAX + l * 24, MIX);
#endif
        }
        SEAM(p0 + 2);
        if (IN(p0 + 3)) GEMM_PLAIN(MIX, WSL + OW_OUT / 2, NTOK, D, D, BA, D);
        SEAM(p0 + 3);
        if (IN(p0 + 4)) thin_rows<1, true, true, 0>(F, h_res, BA, INP(I_MIXPOST) + l * D, OUTP, INP(I_XAPRE) + l * D, HN, nullptr, nullptr, nullptr, nullptr, nullptr);
        SEAM(p0 + 4);
        if (IN(p0 + 5)) GEMM_PLAIN(HN, WSL + OW_Q / 2, NTOK, D, D, BB, D);
        SEAM(p0 + 5);
        if (IN(p0 + 6)) xa_mfma(F, BB, XK, XVT, BA);
        SEAM(p0 + 6);
        if (IN(p0 + 7)) GEMM_PLAIN(BA, WSL + OW_O / 2, NTOK, D, D, BB, D);
        SEAM(p0 + 7);
        if (l == 0) {
            if (IN(10)) thin_rows<1, true, true, 0>(F, OUTP, BB, INP(I_XAPOST), OUTP, INP(I_FFPRE), HN, nullptr, nullptr, nullptr, nullptr, nullptr);
            SEAM(10);
            if (IN(11)) { pg8::Gemm g{(const pg8::bf16_t*)HN, (const pg8::bf16_t*)(ws + WS_WGU0), NTOK, 2 * DFF, D}; pg8::StaticOrder S; S.init(g, F.G, bx);
                pg8::EpiSwiGLU E{(pg8::bf16_t*)ACT, DFF, 0}; pg8::gemm_phase<pg8::EpiSwiGLU, pg8::StaticOrder, true, true>(F.lds + RING_OFF, D, S, E); }
            SEAM(11);
            if (IN(12)) GEMM_PLAIN(ACT, ws + WS_WD0, NTOK, D, DFF, MIX, D);
            SEAM(12);
            if (IN(13)) thin_rows<1, true, true, 1>(F, OUTP, MIX, INP(I_FFPOST), OUTP, INP(I_MIXPRE) + D, HN, (const float*)(ws + WS_WF) + 8 * D, INP(I_BF) + NFX, LOGF, nullptr, nullptr);
            SEAM(13);
            if (IN(14)) {
                for (int e = 0; e < NE; ++e) {
                    bf16* we = (bf16*)(ws + WS_WMOE + (size_t)e * MOE_E_BYTES);
                    transpose_gu(F, INP(I_MG) + (size_t)e * D * DFF, INP(I_MU) + (size_t)e * D * DFF, we, scr);
                    transpose_mat(F, INP(I_MD) + (size_t)e * DFF * D, D, 0, D, DFF, we + MOE_GU_BYTES / 2, 0, scr);
                }
                mem_norm(F, INP(I_MEM), INP(I_MEMN) + D, MN);
            }
            SEAM(14);
        } else {
            if (IN(23)) thin_rows<1, true, true, 2>(F, OUTP, BB, INP(I_XAPOST) + D, OUTP, INP(I_FFPRE) + D, BA, (const float*)(ws + WS_WR), nullptr, nullptr, TOKT, F.ctl + CW_CNT);
            SEAM(23);
            if (IN(24)) moe_gather(F, BA, XS, TOKT, BLKE);
            SEAM(24);
#pragma unroll
            for (int ch = 0; ch < 2; ++ch) {
                const int nblk = BLKE[MAXBLK]; const int c0 = ch * CHUNK_BLK, c1 = (nblk < c0 + CHUNK_BLK) ? nblk : c0 + CHUNK_BLK; const int nb = c1 > c0 ? c1 - c0 : 0;
                if (IN(25 + 2 * ch)) { pg8::MoeOrder S{nb, 2 * DFF / 256, F.G, bx, c0, 0, (const char*)XS, (const char*)(ws + WS_WMOE), (size_t)256 * D * 2, MOE_E_BYTES, BLKE};
                    pg8::EpiSwiGLU E{(pg8::bf16_t*)ACT, DFF, c0}; pg8::gemm_phase<pg8::EpiSwiGLU, pg8::MoeOrder, true, true>(F.lds + RING_OFF, D, S, E); }
                SEAM(25 + 2 * ch);
                if (IN(26 + 2 * ch)) { pg8::MoeOrder S{nb, D / 256, F.G, bx, c0, c0, (const char*)ACT, (const char*)(ws + WS_WMOE + MOE_GU_BYTES), (size_t)256 * DFF * 2, MOE_E_BYTES, BLKE};
                    pg8::EpiBf16 E{(pg8::bf16_t*)XS, D, 0}; pg8::gemm_phase<pg8::EpiBf16, pg8::MoeOrder, true, true>(F.lds + RING_OFF, DFF, S, E); }
                SEAM(26 + 2 * ch);
            }
            if (IN(29)) thin_rows<2, true, false, 0>(F, OUTP, XS, INP(I_FFPOST) + D, OUTP, nullptr, nullptr, nullptr, nullptr, nullptr, TOKT, nullptr);
        }
    }
#undef IN
#undef SEAM
#undef ws
#undef scr
#undef HN
#undef MIX
#undef PROJ
#undef VT
#undef BA
#undef BB
#undef ACT
#undef XS
#undef LOGF
#undef CCUM
#undef TOKT
#undef BLKE
#undef MN
#undef XKV
#undef XK
#undef XVT
}

extern "C" void kernel_launch(void* const* d_in, const int* in_sizes, int n_in, void* d_out, int out_size, void* d_ws, size_t ws_size, hipStream_t stream) {
    static int grid = 0;
    if (grid == 0) {
        if (n_in != 24 || in_sizes[0] != NTOK * D || out_size != NTOK * D || ws_size < WS_END) { fprintf(stderr, "kernel_launch: unexpected shapes / workspace (%d inputs, ws %zu < %zu)\n", n_in, ws_size, (size_t)WS_END); grid = -1; return; }
        int dev = 0, cus = 0, per_cu = 0;
        if (hipGetDevice(&dev) != hipSuccess || hipDeviceGetAttribute(&cus, hipDeviceAttributeMultiprocessorCount, dev) != hipSuccess) { grid = -1; return; }
        if (hipFuncSetAttribute((const void*)fwd, hipFuncAttributeMaxDynamicSharedMemorySize, LDS_BYTES) != hipSuccess) { fprintf(stderr, "kernel_launch: hipFuncSetAttribute failed\n"); grid = -1; return; }
        if (hipOccupancyMaxActiveBlocksPerMultiprocessor(&per_cu, (const void*)fwd, NWAVES * 64, LDS_BYTES) != hipSuccess || per_cu < 1) { fprintf(stderr, "kernel_launch: occupancy query reports %d\n", per_cu); }
        (void)hipGetLastError();
        grid = cus;
    }
    if (grid < 0) return;
    (void)hipMemsetAsync((char*)d_ws + WS_CTL, 0, CTL_ZERO_BYTES, stream);
    Args a{};
    for (int i = 0; i < 24; ++i) a.in[i] = (const float*)d_in[i];
    a.out = (float*)d_out; a.ws = (unsigned char*)d_ws;
#if MK_ONE_LAUNCH
    a.ph_lo = 0; a.ph_hi = NPHASE;
    hipLaunchKernelGGL(fwd, dim3(grid), dim3(NWAVES * 64), LDS_BYTES, stream, a);
#else
    for (int p = 0; p < NPHASE; ++p) {
        a.ph_lo = p; a.ph_hi = p + 1;
        hipLaunchKernelGGL(fwd, dim3(grid), dim3(NWAVES * 64), LDS_BYTES, stream, a);
    }
#endif
}
```

```cpp
#include <hip/hip_runtime.h>
#include <cstdio>
#include <cstdint>

#ifndef MK_ONE_LAUNCH
#define MK_ONE_LAUNCH 1
#endif

namespace pg8 {
#define PG8_LAS __attribute__((address_space(3)))
typedef unsigned short bf16_t;
typedef short bf16x8 __attribute__((ext_vector_type(8)));
typedef float f32x4 __attribute__((ext_vector_type(4)));
typedef unsigned u32x4 __attribute__((ext_vector_type(4)));
constexpr int BM = 256, BK = 64, HALF = 128, HTB = HALF * BK * 2  , STAGE_BYTES = 8 * HTB, NXCD = 8, WGM = 8;

__host__ __device__ __forceinline__ int lds_byte(int r, int c) { const int st = (r >> 4) * 2 + (c >> 5), rr = r & 15, cc = c & 31, ob = rr * 64 + cc * 2; return st * 1024 + (ob ^ (((ob >> 9) & 1) << 5)); }
__host__ __device__ __forceinline__ void stage_rc(int b, int& R, int& C) { const int st = b / 1024, sb = b % 1024, swz = sb ^ (((sb >> 9) & 1) << 5); R = (st >> 1) * 16 + swz / 64; C = (st & 1) * 32 + (swz % 64) / 2; }
__host__ __device__ __forceinline__ int perm32(int rho) { const int n = rho >> 4, i = rho & 15; return 8 * (i >> 2) + 4 * n + (i & 3); }

struct Unit { int pm, pn; const char* a; const char* b; };
struct Gemm { const bf16_t* A; const bf16_t* Bt; int M, N, K; };

__device__ __forceinline__ bool order_map(int i, int G, int c, int nM, int nN, int& pm, int& pn) {
    const int nwg = nM * nN; const long L = (long)i * G + c; if (L >= nwg) return false;
    int wgid = (int)L; { const int q = nwg / NXCD, r = nwg % NXCD, xcd = wgid % NXCD, off = wgid / NXCD; wgid = (xcd < r ? xcd * (q + 1) : r * (q + 1) + (xcd - r) * q) + off; }
    const int nig = WGM * nN, gid = wgid / nig, fm = gid * WGM, gsz = (nM - fm) < WGM ? (nM - fm) : WGM;
    pm = fm + ((wgid % nig) % gsz); pn = (wgid % nig) / gsz; return true;
}
struct StaticOrder {
    int nM, nN, G, c; const char* A; const char* B; size_t tstep;
    __device__ void init(const Gemm& g, int G_, int c_) { nM = g.M / BM; nN = g.N / BM; G = G_; c = c_; A = (const char*)g.A; B = (const char*)g.Bt; tstep = (size_t)BM * g.K * 2; }
    __device__ __forceinline__ bool next(int i, Unit& u) const {
        if (!order_map(i, G, c, nM, nN, u.pm, u.pn)) return false;
        u.a = A + (size_t)u.pm * tstep; u.b = B + (size_t)u.pn * tstep; return true;
    }
};
struct MoeOrder {
    int nM, nN, G, c, pb0, pbA; const char* A; const char* W; size_t tstep, wstride; const int* blk_e;
    __device__ __forceinline__ bool next(int i, Unit& u) const {
        int pm, pn; if (!order_map(i, G, c, nM, nN, pm, pn)) return false;
        u.pm = pb0 + pm; u.pn = pn; const int e = blk_e[u.pm];
        u.a = A + (size_t)(u.pm - pbA) * tstep; u.b = W + (size_t)e * wstride + (size_t)pn * tstep; return true;
    }
};

__device__ __forceinline__ unsigned cvt_pk_bf16(float lo, float hi) { unsigned r; asm volatile("v_cvt_pk_bf16_f32 %0, %1, %2" : "=v"(r) : "v"(lo), "v"(hi)); return r; }

struct EpiBf16 {
    static constexpr bool PERM = true;
    bf16_t* O; int ldc; int pm_off;
    __device__ __forceinline__ void operator()(const f32x4 (&acc)[2][2][4][2], const Unit& u, int wr, int wc, int fr, int fq) const {
        const int row0 = (u.pm - pm_off) * BM + wr * 64 + fr; const int col0 = u.pn * BM + wc * 32 + 8 * fq;
#pragma unroll
        for (int ai = 0; ai < 2; ++ai)
#pragma unroll
            for (int m = 0; m < 4; ++m) { bf16_t* rowp = O + (size_t)(row0 + ai * HALF + m * 16) * ldc + col0;
#pragma unroll
                for (int bj = 0; bj < 2; ++bj) { const f32x4 v0 = acc[ai][bj][m][0], v1 = acc[ai][bj][m][1];
                    u32x4 w; w.x = cvt_pk_bf16(v0[0], v0[1]); w.y = cvt_pk_bf16(v0[2], v0[3]); w.z = cvt_pk_bf16(v1[0], v1[1]); w.w = cvt_pk_bf16(v1[2], v1[3]);
                    *(u32x4*)(rowp + bj * HALF) = w; } }
    }
};
__device__ __forceinline__ float silu_mul(float g, float u) { return g * __builtin_amdgcn_rcpf(1.0f + __expf(-g)) * u; }
struct EpiSwiGLU {
    static constexpr bool PERM = true;
    bf16_t* O; int ldc; int pm_off;
    __device__ __forceinline__ void operator()(const f32x4 (&acc)[2][2][4][2], const Unit& u, int wr, int wc, int fr, int fq) const {
        const int row0 = (u.pm - pm_off) * BM + wr * 64 + fr; const int col0 = u.pn * HALF + wc * 32 + 8 * fq;
#pragma unroll
        for (int ai = 0; ai < 2; ++ai)
#pragma unroll
            for (int m = 0; m < 4; ++m) { bf16_t* rowp = O + (size_t)(row0 + ai * HALF + m * 16) * ldc + col0;
                const f32x4 g0 = acc[ai][0][m][0], g1 = acc[ai][0][m][1], u0 = acc[ai][1][m][0], u1 = acc[ai][1][m][1];
                u32x4 w; w.x = cvt_pk_bf16(silu_mul(g0[0], u0[0]), silu_mul(g0[1], u0[1])); w.y = cvt_pk_bf16(silu_mul(g0[2], u0[2]), silu_mul(g0[3], u0[3]));
                w.z = cvt_pk_bf16(silu_mul(g1[0], u1[0]), silu_mul(g1[1], u1[1])); w.w = cvt_pk_bf16(silu_mul(g1[2], u1[2]), silu_mul(g1[3], u1[3]));
                *(u32x4*)rowp = w; }
    }
};

template <class Epi, class Sched, bool ALIGN_EPI = false, bool SP2 = false>
__device__ __forceinline__ void gemm_phase(PG8_LAS unsigned char* lds, const int K, const Sched& S, const Epi& E) {
    int tid_ = threadIdx.x; asm volatile("" : "+v"(tid_));
    const int tid = tid_, wid = __builtin_amdgcn_readfirstlane(tid >> 6), lane = tid & 63, wr = wid >> 2, wc = wid & 3, fr = lane & 15, fq = lane >> 4;
    const int nt = K / BK;
    unsigned voffA[2], voffB[2];
#pragma unroll
    for (int i = 0; i < 2; ++i) { int R, C; stage_rc(tid * 16 + i * 8192, R, C); const int Rb = Epi::PERM ? ((R & ~31) + perm32(R & 31)) : R;
        voffA[i] = (unsigned)(R * K + C) * 2u; voffB[i] = (unsigned)(Rb * K + C) * 2u; }
    const size_t kstep = (size_t)(BK * 2);
    const size_t hstep = (size_t)HALF * K * 2;
    const unsigned ldsw = (unsigned)wid * 1024u;
    const int aoff = lds_byte(wr * 64 + fr, fq * 8), boff = lds_byte(wc * 32 + fr, fq * 8);
#define PG8_SA(b, h) (((b) * 2 + (h)) * HTB)
#define PG8_SB(b, h) ((4 + (b) * 2 + (h)) * HTB)
#define PG8_STAGE(bufoff, gbase, voff) do { _Pragma("unroll") for (int _i = 0; _i < 2; ++_i) \
        __builtin_amdgcn_global_load_lds((const unsigned*)((const char*)(gbase) + (voff)[_i]), (PG8_LAS unsigned*)(lds + (bufoff) + ldsw + _i * 8192), 16, 0, 0); } while (0)
#define PG8_LDA(dst, b, h) do { _Pragma("unroll") for (int m = 0; m < 4; ++m) _Pragma("unroll") for (int k = 0; k < 2; ++k) dst[m][k] = *(const PG8_LAS bf16x8*)(lds + PG8_SA(b, h) + aoff + m * 2048 + k * 1024); } while (0)
#define PG8_LDB(dst, b, h) do { _Pragma("unroll") for (int n = 0; n < 2; ++n) _Pragma("unroll") for (int k = 0; k < 2; ++k) dst[n][k] = *(const PG8_LAS bf16x8*)(lds + PG8_SB(b, h) + boff + n * 2048 + k * 1024); } while (0)
#define PG8_MMA(ai, bj, At, Bt) do { __builtin_amdgcn_s_setprio(1); _Pragma("unroll") for (int m = 0; m < 4; ++m) _Pragma("unroll") for (int n = 0; n < 2; ++n) _Pragma("unroll") for (int k = 0; k < 2; ++k) \
        acc[ai][bj][m][n] = __builtin_amdgcn_mfma_f32_16x16x32_bf16(Bt[n][k], At[m][k], acc[ai][bj][m][n], 0, 0, 0); __builtin_amdgcn_s_setprio(0); } while (0)
#define PG8_WAIT_V(n) asm volatile("s_waitcnt vmcnt(" #n ")" ::: "memory")
#define PG8_WAIT_L(n) asm volatile("s_waitcnt lgkmcnt(" #n ")" ::: "memory")
#define PG8_BAR __builtin_amdgcn_s_barrier()
#define PG8_SCHED __builtin_amdgcn_sched_barrier(0)
    Unit cur, nxt; int ui = 0;
    if (!S.next(0, cur)) return;
    f32x4 acc[2][2][4][2];
#pragma unroll
    for (int a = 0; a < 2; ++a)
#pragma unroll
        for (int b = 0; b < 2; ++b)
#pragma unroll
            for (int m = 0; m < 4; ++m)
#pragma unroll
                for (int n = 0; n < 2; ++n) acc[a][b][m][n] = (f32x4){0.f, 0.f, 0.f, 0.f};
    bf16x8 At[4][2], B0[2][2], B1[2][2];
    const char* cA = cur.a; const char* cB = cur.b;
    if constexpr (SP2) {
        PG8_STAGE(PG8_SB(0, 0), cB, voffB); PG8_STAGE(PG8_SB(0, 1), cB + hstep, voffB); PG8_STAGE(PG8_SA(0, 0), cA, voffA); PG8_STAGE(PG8_SA(0, 1), cA + hstep, voffA);
        if (wr == 1) PG8_BAR;
        PG8_WAIT_V(2); PG8_BAR;
        PG8_STAGE(PG8_SB(1, 0), cB + kstep, voffB); PG8_STAGE(PG8_SA(1, 0), cA + kstep, voffA); PG8_STAGE(PG8_SB(1, 1), cB + hstep + kstep, voffB);
        PG8_WAIT_V(6); PG8_BAR;
    } else {
        PG8_STAGE(PG8_SB(0, 0), cB, voffB); PG8_STAGE(PG8_SA(0, 0), cA, voffA); PG8_STAGE(PG8_SB(0, 1), cB + hstep, voffB); PG8_STAGE(PG8_SA(0, 1), cA + hstep, voffA);
        if (wr == 1) PG8_BAR;
        PG8_WAIT_V(4); PG8_BAR;
        PG8_STAGE(PG8_SB(1, 0), cB + kstep, voffB); PG8_STAGE(PG8_SA(1, 0), cA + kstep, voffA); PG8_STAGE(PG8_SB(1, 1), cB + hstep + kstep, voffB);
        PG8_WAIT_V(6); PG8_BAR;
    }
    for (;;) {
        const bool has_next = S.next(ui + 1, nxt);
        const char* nA = has_next ? nxt.a : cA; const char* nB = has_next ? nxt.b : cB;
        for (int t = 0; t < nt; t += 2) {
            const bool last = (t == nt - 2);
            const char* a1 = cA + (size_t)(t + 1) * kstep;
            const char* a2 = last ? nA : cA + (size_t)(t + 2) * kstep; const char* b2 = last ? nB : cB + (size_t)(t + 2) * kstep;
            const char* a3 = a2 + kstep; const char* b3 = b2 + kstep;
            if constexpr (SP2) {
            PG8_LDB(B0, 0, 0); PG8_LDB(B1, 0, 1); PG8_SCHED; PG8_LDA(At, 0, 0); PG8_STAGE(PG8_SA(1, 1), a1 + hstep, voffA);
            PG8_WAIT_V(8); PG8_WAIT_L(0); PG8_BAR; PG8_MMA(0, 0, At, B0); PG8_MMA(0, 1, At, B1); PG8_BAR; PG8_SCHED;
            PG8_LDA(At, 0, 1); PG8_STAGE(PG8_SB(0, 0), b2, voffB); PG8_STAGE(PG8_SB(0, 1), b2 + hstep, voffB); PG8_STAGE(PG8_SA(0, 0), a2, voffA);
            PG8_WAIT_V(8); PG8_WAIT_L(0); PG8_BAR; PG8_MMA(1, 0, At, B0); PG8_MMA(1, 1, At, B1); PG8_BAR; PG8_SCHED;
            PG8_LDB(B0, 1, 0); PG8_LDB(B1, 1, 1); PG8_SCHED; PG8_LDA(At, 1, 0); PG8_STAGE(PG8_SA(0, 1), a2 + hstep, voffA);
            PG8_WAIT_V(8); PG8_WAIT_L(0); PG8_BAR; PG8_MMA(0, 0, At, B0); PG8_MMA(0, 1, At, B1); PG8_BAR; PG8_SCHED;
            PG8_LDA(At, 1, 1); PG8_STAGE(PG8_SB(1, 0), b3, voffB); PG8_STAGE(PG8_SB(1, 1), b3 + hstep, voffB); PG8_STAGE(PG8_SA(1, 0), a3, voffA);
            PG8_WAIT_V(8); PG8_WAIT_L(0); PG8_BAR; PG8_MMA(1, 0, At, B0); PG8_MMA(1, 1, At, B1); PG8_BAR; PG8_SCHED;
            } else {
            PG8_LDB(B0, 0, 0); PG8_SCHED; PG8_LDA(At, 0, 0); PG8_STAGE(PG8_SA(1, 1), a1 + hstep, voffA);
            PG8_WAIT_L(8); PG8_BAR; PG8_WAIT_L(0); PG8_MMA(0, 0, At, B0); PG8_BAR; PG8_SCHED;
            PG8_LDB(B1, 0, 1); PG8_STAGE(PG8_SB(0, 0), b2, voffB);
            PG8_BAR; PG8_WAIT_L(0); PG8_MMA(0, 1, At, B1); PG8_BAR;
            PG8_LDA(At, 0, 1); PG8_STAGE(PG8_SA(0, 0), a2, voffA);
            PG8_BAR; PG8_WAIT_L(0); PG8_MMA(1, 0, At, B0); PG8_BAR; PG8_SCHED;
            PG8_STAGE(PG8_SB(0, 1), b2 + hstep, voffB);
            PG8_WAIT_V(6); PG8_BAR; PG8_MMA(1, 1, At, B1); PG8_BAR;
            PG8_LDB(B0, 1, 0); PG8_SCHED; PG8_LDA(At, 1, 0); PG8_STAGE(PG8_SA(0, 1), a2 + hstep, voffA);
            PG8_WAIT_L(8); PG8_BAR; PG8_WAIT_L(0); PG8_MMA(0, 0, At, B0); PG8_BAR; PG8_SCHED;
            PG8_LDB(B1, 1, 1); PG8_STAGE(PG8_SB(1, 0), b3, voffB);
            PG8_BAR; PG8_WAIT_L(0); PG8_MMA(0, 1, At, B1); PG8_BAR;
            PG8_LDA(At, 1, 1); PG8_STAGE(PG8_SA(1, 0), a3, voffA);
            PG8_BAR; PG8_WAIT_L(0); PG8_MMA(1, 0, At, B0); PG8_BAR; PG8_SCHED;
            PG8_STAGE(PG8_SB(1, 1), b3 + hstep, voffB);
            PG8_WAIT_V(6); PG8_BAR; PG8_MMA(1, 1, At, B1); PG8_BAR;
            }
        }
        if constexpr (ALIGN_EPI) { if (wr == 0) PG8_BAR; }
        E(acc, cur, wr, wc, fr, fq);
        if (!has_next) break;
#pragma unroll
        for (int a = 0; a < 2; ++a)
#pragma unroll
            for (int b = 0; b < 2; ++b)
#pragma unroll
                for (int m = 0; m < 4; ++m)
#pragma unroll
                    for (int n = 0; n < 2; ++n) acc[a][b][m][n] = (f32x4){0.f, 0.f, 0.f, 0.f};
        cur = nxt; cA = nA; cB = nB; ++ui;
        if constexpr (ALIGN_EPI) { if (wr == 1) PG8_BAR; }
    }
    PG8_WAIT_V(0);
    if constexpr (!ALIGN_EPI) { if (wr == 0) PG8_BAR; }
    PG8_BAR;
#undef PG8_SA
#undef PG8_SB
#undef PG8_STAGE
#undef PG8_LDA
#undef PG8_LDB
#undef PG8_MMA
#undef PG8_WAIT_V
#undef PG8_WAIT_L
#undef PG8_BAR
#undef PG8_SCHED
}
}

constexpr int NBATCH = 4, SEQ = 8192, D = 1024, NTOK = NBATCH * SEQ, DEPTH = 2;
constexpr int HD = 64, NSB = 6, NFX = 6, SBD = 384, FXD = 384, POOLD = 256, CIN = 2566;
constexpr int MEML = 256, NMEM = NBATCH * MEML, XAH = 4, XAD = 256;
constexpr int DFF = 2816, NE = 8;
constexpr float EPS = 1e-6f;
constexpr int PP = 1792, C_SQ = 0, C_SK = 384, C_FQ = 768, C_FK = 1152, C_U = 1536;
constexpr int VTN = 768, VTP = NTOK + 2112;
constexpr int MAXBLK = 264, CHUNK_BLK = 132;

constexpr size_t MiB = 1u << 20;
constexpr size_t WS_CTL = 0, CTL_ZERO_BYTES = 1 * MiB;
constexpr size_t WS_WF   = 1 * MiB;
constexpr size_t WS_WR   = WS_WF + 65536;
constexpr size_t WS_BLKE = WS_WR + 32768;
constexpr size_t WS_LOGF = 2 * MiB;
constexpr size_t WS_CCUM = 3 * MiB;
constexpr size_t WS_TOKT = 4 * MiB;
constexpr size_t WS_MN   = 5 * MiB;
constexpr size_t WS_XKV  = 7 * MiB;
constexpr size_t WS_WS1  = 16 * MiB;
constexpr size_t WS_WMOE = 31 * MiB;
constexpr size_t WS_R2   = 163 * MiB;
constexpr size_t WS_R1   = 295 * MiB;
constexpr size_t WS_END  = 295 * MiB + 190316544;
constexpr size_t OW_IN = 0, OW_OUT = 5 * MiB, OW_Q = 7 * MiB, OW_KV = 9 * MiB, OW_O = 13 * MiB, OW_LAYER = 15 * MiB;
constexpr size_t WS_WS0 = WS_WMOE;
constexpr size_t WS_WGU0 = WS_WS0 + OW_LAYER;
constexpr size_t WS_WD0 = WS_WGU0 + 11 * MiB;
constexpr size_t MOE_GU_BYTES = (size_t)2 * DFF * D * 2, MOE_D_BYTES = (size_t)D * DFF * 2, MOE_E_BYTES = MOE_GU_BYTES + MOE_D_BYTES;
static_assert(WS_WD0 + MOE_D_BYTES <= WS_WMOE + 132 * MiB && 8 * MOE_E_BYTES <= 132 * MiB, "weights map");
constexpr size_t R2_HN = WS_R2, R2_MIX = WS_R2 + 64 * MiB;
constexpr size_t R1_PROJ = WS_R1;
constexpr size_t R1_VT = WS_R1 + 112 * MiB;
constexpr size_t R1_A = WS_R1, R1_B = WS_R1 + 64 * MiB;
constexpr size_t R1_ACT = WS_R1;
constexpr size_t R2_XS = WS_R2;
static_assert((size_t)NTOK * DFF * 2 <= 190316544 && (size_t)CHUNK_BLK * 256 * DFF * 2 <= 190316544 && (size_t)MAXBLK * 256 * D * 2 <= 132 * MiB, "arena map");
constexpr int CW_CNT = 64;
constexpr int CW_KMAX = 128;
constexpr int CW_BAR = 4096;

constexpr int RING_OFF = 0, RING_BYTES = 131072;
constexpr int LDSCTL_OFF = RING_BYTES, MISC_OFF = LDSCTL_OFF + 320;
constexpr int LDS_BYTES = 147456;
constexpr int NWAVES = 8;

#define GAS __attribute__((address_space(1)))
#define LAS __attribute__((address_space(3)))
typedef unsigned short bf16;
typedef unsigned v4u __attribute__((ext_vector_type(4)));
typedef unsigned v2u __attribute__((ext_vector_type(2)));
typedef float f32x4 __attribute__((ext_vector_type(4)));
typedef GAS unsigned gu32;
#define RLX_AGENT __ATOMIC_RELAXED, __HIP_MEMORY_SCOPE_AGENT
#define LDS_WAIT() asm volatile("s_waitcnt lgkmcnt(0)" ::: "memory")
#define VM_WAIT() asm volatile("s_waitcnt vmcnt(0)" ::: "memory")
__device__ __forceinline__ unsigned f2bf(float f) { unsigned u = __builtin_bit_cast(unsigned, f); return (u + 0x7fffu + ((u >> 16) & 1u)) >> 16; }
__device__ __forceinline__ unsigned pk2(float lo, float hi) { return f2bf(lo) | (f2bf(hi) << 16); }
__device__ __forceinline__ float bflo(unsigned u) { return __uint_as_float(u << 16); }
__device__ __forceinline__ float bfhi(unsigned u) { return __uint_as_float(u & 0xffff0000u); }
__device__ __forceinline__ float bf2f(bf16 b) { return __uint_as_float(((unsigned)b) << 16); }

#define XB_TMO      128
#define XB_XCNT(j)  (256  + 64 * (j))
#define XB_XSUB(j)  (1280 + 64 * (j))
#define XB_XGEN(j)  (2304 + 64 * (j))
#define XB_TOP      3328
#define XB_TOPGEN   3392
#define XCD_BAR_WORDS 3456
#define XB_SPIN_CAP (1u << 22)

__device__ __forceinline__ unsigned xb_ld(unsigned* p)              { return __hip_atomic_load(p, __ATOMIC_RELAXED, __HIP_MEMORY_SCOPE_AGENT); }
__device__ __forceinline__ unsigned xb_add(unsigned* p, unsigned v) { return __hip_atomic_fetch_add(p, v, __ATOMIC_RELAXED, __HIP_MEMORY_SCOPE_AGENT); }
__device__ __forceinline__ unsigned xb_xcc_id() { return (unsigned)__builtin_amdgcn_s_getreg((3 << 11) | 20) & 0xFu; }
#define XB_SPIN(cond, bar) do { unsigned _sp = 0; while (cond) { __builtin_amdgcn_s_sleep(1); \
    if ((++_sp & 255u) == 0u) { if (xb_ld(&(bar)[XB_TMO])) break; if (_sp > XB_SPIN_CAP) { atomicAdd(&(bar)[XB_TMO], 1u); break; } } } } while (0)

struct XcdBarrier { unsigned* bar; unsigned x; volatile LAS unsigned* st; };

__device__ __forceinline__ XcdBarrier xcd_barrier_post(unsigned* bar, volatile LAS unsigned* st) {
    XcdBarrier b; b.bar = bar; b.x = xb_xcc_id(); b.st = st;
    if (threadIdx.x == 0) (void)xb_add(&bar[XB_XCNT(b.x)], 1u);
    return b;
}
__device__ __forceinline__ void xcd_barrier_complete(unsigned* bar, unsigned x, unsigned& nloc, unsigned& nx) {
    const unsigned G = gridDim.x * gridDim.y * gridDim.z;
    unsigned sum, cnt, mine, sp = 0u;
    for (;;) {
        sum = 0u; cnt = 0u; mine = 0u;
#pragma unroll
        for (unsigned j = 0; j < 16; ++j) { const unsigned c = xb_ld(&bar[XB_XCNT(j)]); sum += c; cnt += (c > 0u) ? 1u : 0u; mine = (j == x) ? c : mine; }
        if (sum == G) break;
        __builtin_amdgcn_s_sleep(1);
        if ((++sp & 255u) == 0u) { if (xb_ld(&bar[XB_TMO])) break; if (sp > XB_SPIN_CAP) { atomicAdd(&bar[XB_TMO], 1u); break; } }
    }
    nloc = mine > 0u ? mine : 1u; nx = cnt > 0u ? cnt : 1u;
}
__device__ __forceinline__ void xcd_barrier(const XcdBarrier& b) {
    asm volatile("s_waitcnt vmcnt(0)" ::: "memory");
    __syncthreads();
    if (threadIdx.x == 0) {
        unsigned* bar = b.bar;
        __builtin_amdgcn_s_waitcnt(0);
        unsigned nloc = b.st[0], nx = b.st[1];
        if (nloc == 0u) { xcd_barrier_complete(bar, b.x, nloc, nx); b.st[0] = nloc; b.st[1] = nx; }
        const unsigned old = xb_add(&bar[XB_XSUB(b.x)], 1u);
        const unsigned gen = old / nloc;
        if (old + 1u == (gen + 1u) * nloc) {
            __builtin_amdgcn_fence(__ATOMIC_RELEASE, "agent");
            asm volatile("s_waitcnt vmcnt(0)" ::: "memory");
            const unsigned og = xb_add(&bar[XB_TOP], 1u);
            const unsigned tg = og / nx;
            if (og + 1u == (tg + 1u) * nx) xb_add(&bar[XB_TOPGEN], 1u);
            else XB_SPIN(xb_ld(&bar[XB_TOPGEN]) == tg, bar);
            __builtin_amdgcn_fence(__ATOMIC_ACQUIRE, "agent");
            xb_add(&bar[XB_XGEN(b.x)], 1u);
            asm volatile("s_waitcnt vmcnt(0)" ::: "memory");
        } else {
            XB_SPIN(xb_ld(&bar[XB_XGEN(b.x)]) == gen, bar);
            __builtin_amdgcn_fence(__ATOMIC_ACQUIRE, "agent");
            asm volatile("s_waitcnt vmcnt(0)" ::: "memory");
        }
    }
    __syncthreads();
}

enum In { I_X = 0, I_MEM, I_MIXPRE, I_MIXPOST, I_WIN, I_BF, I_POOLW, I_POOLS, I_WOUT, I_XAPRE, I_XAPOST, I_MEMN, I_XQ, I_XKV, I_XO, I_FFPRE, I_FFPOST,
          I_DG, I_DU, I_DD, I_RW, I_MG, I_MU, I_MD };

struct Args { const float* in[24]; float* out; unsigned char* ws; int ph_lo, ph_hi; };
__device__ __forceinline__ const __attribute__((address_space(4))) Args* kargs() { const __attribute__((address_space(4))) Args* p = (const __attribute__((address_space(4))) Args*)__builtin_amdgcn_kernarg_segment_ptr(); asm volatile("" : "+s"(p)); return p; }
#define WSB (kargs()->ws)
#define INP(i) (kargs()->in[i])
#define OUTP (kargs()->out)
struct Frame {
    LAS unsigned char* lds;
    gu32* ctl;
    int tid, lane, wave;
    int vcu, G;
};


__device__ __forceinline__ void fresh(Frame& F) { int t = threadIdx.x; asm volatile("" : "+v"(t)); F.tid = t; F.lane = t & 63; F.wave = __builtin_amdgcn_readfirstlane(t >> 6); }
__device__ __forceinline__ float wave_sum(float v) {
#pragma unroll
    for (int o = 1; o < 64; o <<= 1) v += __shfl_xor(v, o);
    return v;
}
__device__ __forceinline__ float wave_max(float v) {
#pragma unroll
    for (int o = 1; o < 64; o <<= 1) v = fmaxf(v, __shfl_xor(v, o));
    return v;
}
__device__ __forceinline__ float log_sigmoid(float x) { return x < 0.f ? x - log1pf(__expf(x)) : -log1pf(__expf(-x)); }

__device__ __forceinline__ void transpose_item(const float* W, int ldw, int col0, int k0, bf16* WT, int ldwt, int row0, LAS float* scr, int lane) {
#pragma unroll 8
    for (int i = 0; i < 32; ++i) { const int kk = 2 * i + (lane >> 5); scr[kk * 33 + (lane & 31)] = W[(size_t)(k0 + kk) * ldw + col0 + (lane & 31)]; }
    LDS_WAIT(); asm volatile("" ::: "memory");
    const int c = lane & 7;
#pragma unroll
    for (int j = 0; j < 4; ++j) { const int n = (lane >> 3) + 8 * j; const LAS float* s = scr + (8 * c) * 33 + n;
        v4u o; o.x = pk2(s[0 * 33], s[1 * 33]); o.y = pk2(s[2 * 33], s[3 * 33]); o.z = pk2(s[4 * 33], s[5 * 33]); o.w = pk2(s[6 * 33], s[7 * 33]);
        *(GAS v4u*)(WT + (size_t)(row0 + n) * ldwt + k0 + 8 * c) = o; }
    LDS_WAIT(); asm volatile("" ::: "memory");
}
__device__ __forceinline__ void transpose_mat(Frame& F, const float* W, int ldw, int col0, int ncols, int K, bf16* WT, int row0, LAS float* scr) {
    const int gw = F.vcu * NWAVES + F.wave, NGW = F.G * NWAVES; const int nkb = K / 64, nitems = nkb * (ncols / 32);
    for (int it = gw; it < nitems; it += NGW) { const int kb = it % nkb, nb = it / nkb; transpose_item(W, ldw, col0 + 32 * nb, 64 * kb, WT, K, row0 + 32 * nb, scr, F.lane); }
}
__device__ __forceinline__ void transpose_gu(Frame& F, const float* Wg, const float* Wu, bf16* WT, LAS float* scr) {
    const int gw = F.vcu * NWAVES + F.wave, NGW = F.G * NWAVES; const int nkb = D / 64, ncb = DFF / 32, nitems = 2 * nkb * ncb;
    for (int it = gw; it < nitems; it += NGW) { const int kb = it % nkb, r = it / nkb, nb = r % ncb, which = r / ncb; const int n0 = 32 * nb;
        transpose_item(which ? Wu : Wg, DFF, n0, 64 * kb, WT, D, 256 * (n0 / 128) + 128 * which + (n0 % 128), scr, F.lane); }
}
__device__ __forceinline__ void convert_layer_small(Frame& F, int l, bf16* base, LAS float* scr) {
    const float* win = INP(I_WIN) + (size_t)l * D * CIN;
    bf16* wt = base + OW_IN / 2;
    transpose_mat(F, win, CIN, 0, 768, D, wt, 0, scr);
    transpose_mat(F, win, CIN, 1152, 768, D, wt, 768, scr);
    { const float* pw = INP(I_POOLW) + (size_t)l * 4 * 4096; const float* psc = INP(I_POOLS) + (size_t)l * POOLD;
      for (int i = (F.vcu * NWAVES + F.wave) * 64 + F.lane; i < POOLD * D; i += F.G * NWAVES * 64) { const int n = i / D, k = i % D, g = n >> 6, co = n & 63;
          const float* wr = win + (size_t)k * CIN + 2310 + g * 64; const float* pc = pw + g * 4096 + co; float acc = 0.f;
#pragma unroll 8
          for (int ci = 0; ci < 64; ++ci) acc += wr[ci] * pc[ci * 64];
          wt[(size_t)(1536 + n) * D + k] = (bf16)f2bf(acc * psc[n]); } }
    transpose_mat(F, win, CIN, 768, 384, D, wt, 1792, scr);
    transpose_mat(F, win, CIN, 1920, 384, D, wt, 2176, scr);
    transpose_mat(F, INP(I_WOUT) + (size_t)l * D * D, D, 0, D, D, base + OW_OUT / 2, 0, scr);
    transpose_mat(F, INP(I_XQ) + (size_t)l * D * D, D, 0, D, D, base + OW_Q / 2, 0, scr);
    transpose_mat(F, INP(I_XKV) + (size_t)l * D * 2 * D, 2 * D, 0, 2 * D, D, base + OW_KV / 2, 0, scr);
    transpose_mat(F, INP(I_XO) + (size_t)l * D * D, D, 0, D, D, base + OW_O / 2, 0, scr);
    float* wf = (float*)(WSB + WS_WF) + (size_t)l * 8 * D;
    for (int i = (F.vcu * NWAVES + F.wave) * 64 + F.lane; i < 6 * D; i += F.G * NWAVES * 64) { const int j = i / D, k = i % D; wf[j * D + k] = win[(size_t)k * CIN + 2304 + j]; }
}

template <int DELTA, bool WRITE_H, bool WRITE_HN, int EXTRA>
__device__ __forceinline__ void thin_rows(Frame& F, const float* h_in, const bf16* delta, const float* g_post, float* h_out, const float* g_pre, bf16* hn_out,
                                          const float* wx, const float* bfo, float* logf, int* tokt, gu32* cnt) {
    const int gw = F.vcu * NWAVES + F.wave, NGW = F.G * NWAVES, lane = F.lane;
    for (int row = gw; row < NTOK; row += NGW) {
        f32x4 v[4];
#pragma unroll
        for (int j = 0; j < 4; ++j) v[j] = *(const f32x4*)(h_in + (size_t)row * D + 4 * lane + 256 * j);
        if constexpr (DELTA != 0) {
            f32x4 d[4];
            if constexpr (DELTA == 1) {
#pragma unroll
                for (int j = 0; j < 4; ++j) { const v2u r = *(const v2u*)(delta + (size_t)row * D + 4 * lane + 256 * j); d[j] = (f32x4){bflo(r.x), bfhi(r.x), bflo(r.y), bfhi(r.y)}; }
            } else {
                const int d0 = tokt[row * 8 + 1], d1 = tokt[row * 8 + 4]; const float g0 = __int_as_float(tokt[row * 8 + 2]), g1 = __int_as_float(tokt[row * 8 + 5]);
#pragma unroll
                for (int j = 0; j < 4; ++j) { const v2u r0 = *(const v2u*)(delta + (size_t)d0 * D + 4 * lane + 256 * j), r1 = *(const v2u*)(delta + (size_t)d1 * D + 4 * lane + 256 * j);
                    d[j] = (f32x4){g0 * bflo(r0.x) + g1 * bflo(r1.x), g0 * bfhi(r0.x) + g1 * bfhi(r1.x), g0 * bflo(r0.y) + g1 * bflo(r1.y), g0 * bfhi(r0.y) + g1 * bfhi(r1.y)}; }
            }
            float ss = 0.f;
#pragma unroll
            for (int j = 0; j < 4; ++j) ss += (d[j].x * d[j].x + d[j].y * d[j].y) + (d[j].z * d[j].z + d[j].w * d[j].w);
            const float rs = rsqrtf(wave_sum(ss) * (1.f / D) + EPS);
#pragma unroll
            for (int j = 0; j < 4; ++j) { const f32x4 g = *(const f32x4*)(g_post + 4 * lane + 256 * j); v[j] = v[j] + d[j] * rs * g; }
        }
        if constexpr (WRITE_H) {
#pragma unroll
            for (int j = 0; j < 4; ++j) *(f32x4*)(h_out + (size_t)row * D + 4 * lane + 256 * j) = v[j];
        }
        if constexpr (WRITE_HN) {
            float ss = 0.f;
#pragma unroll
            for (int j = 0; j < 4; ++j) ss += (v[j].x * v[j].x + v[j].y * v[j].y) + (v[j].z * v[j].z + v[j].w * v[j].w);
            const float rs = rsqrtf(wave_sum(ss) * (1.f / D) + EPS);
#pragma unroll
            for (int j = 0; j < 4; ++j) { const f32x4 g = *(const f32x4*)(g_pre + 4 * lane + 256 * j); v[j] = v[j] * rs * g;
                v2u o; o.x = pk2(v[j].x, v[j].y); o.y = pk2(v[j].z, v[j].w); *(v2u*)(hn_out + (size_t)row * D + 4 * lane + 256 * j) = o; }
            if constexpr (EXTRA == 1) {
                float lg[6];
#pragma unroll
                for (int e = 0; e < 6; ++e) { float s = 0.f;
#pragma unroll
                    for (int j = 0; j < 4; ++j) { const f32x4 w = *(const f32x4*)(wx + e * D + 4 * lane + 256 * j); s += (v[j].x * w.x + v[j].y * w.y) + (v[j].z * w.z + v[j].w * w.w); }
                    lg[e] = wave_sum(s); }
                if (lane < 6) { float x = lg[0];
#pragma unroll
                    for (int e = 1; e < 6; ++e) x = (lane == e) ? lg[e] : x;
                    logf[(size_t)row * 8 + lane] = log_sigmoid(x + bfo[lane]); }
            }
            if constexpr (EXTRA == 2) {
                float lg[8];
#pragma unroll
                for (int e = 0; e < 8; ++e) { float s = 0.f;
#pragma unroll
                    for (int j = 0; j < 4; ++j) { const f32x4 w = *(const f32x4*)(wx + e * D + 4 * lane + 256 * j); s += (v[j].x * w.x + v[j].y * w.y) + (v[j].z * w.z + v[j].w * w.w); }
                    lg[e] = wave_sum(s); }
                int e0 = 0; float v0 = lg[0];
#pragma unroll
                for (int e = 1; e < 8; ++e) if (lg[e] > v0) { v0 = lg[e]; e0 = e; }
                int e1 = -1; float v1 = -INFINITY;
#pragma unroll
                for (int e = 0; e < 8; ++e) if (e != e0 && lg[e] > v1) { v1 = lg[e]; e1 = e; }
                if (lane == 0) {
                    const float g0 = 1.f / (1.f + __expf(v1 - v0)), g1 = 1.f - g0;
                    const unsigned p0 = __hip_atomic_fetch_add(cnt + e0, 1u, RLX_AGENT), p1 = __hip_atomic_fetch_add(cnt + e1, 1u, RLX_AGENT);
                    int* t = tokt + (size_t)row * 8; t[0] = e0; t[1] = (int)p0; t[2] = __float_as_int(g0); t[3] = e1; t[4] = (int)p1; t[5] = __float_as_int(g1);
                }
            }
        }
    }
}
__device__ __forceinline__ void mem_norm(Frame& F, const float* mem, const float* g, bf16* mn) {
    const int gw = F.vcu * NWAVES + F.wave, NGW = F.G * NWAVES, lane = F.lane;
    for (int row = gw; row < NMEM; row += NGW) {
        f32x4 v[4]; float ss = 0.f;
#pragma unroll
        for (int j = 0; j < 4; ++j) { v[j] = *(const f32x4*)(mem + (size_t)row * D + 4 * lane + 256 * j); ss += (v[j].x * v[j].x + v[j].y * v[j].y) + (v[j].z * v[j].z + v[j].w * v[j].w); }
        const float rs = rsqrtf(wave_sum(ss) * (1.f / D) + EPS);
#pragma unroll
        for (int j = 0; j < 4; ++j) { const f32x4 gg = *(const f32x4*)(g + 4 * lane + 256 * j); v[j] = v[j] * rs * gg;
            v2u o; o.x = pk2(v[j].x, v[j].y); o.y = pk2(v[j].z, v[j].w); *(v2u*)(mn + (size_t)row * D + 4 * lane + 256 * j) = o; }
    }
}
__device__ __forceinline__ void scan_logf(Frame& F, const float* logf, float* ccum) {
    if (blockIdx.x >= NBATCH * NFX) return;
    const int b = blockIdx.x / NFX, h = blockIdx.x % NFX, tid = F.tid;
    LAS float* wsum = (LAS float*)(F.lds + RING_OFF);
    float x[16]; float run = 0.f;
#pragma unroll
    for (int i = 0; i < 16; ++i) { run += logf[((size_t)b * SEQ + tid * 16 + i) * 8 + h]; x[i] = run; }
    float incl = run;
#pragma unroll
    for (int o = 1; o < 64; o <<= 1) { const float t = __shfl_up(incl, o); if (F.lane >= o) incl += t; }
    if (F.lane == 63) wsum[F.wave] = incl;
    LDS_WAIT(); __syncthreads();
    float base = incl - run;
    for (int w = 0; w < F.wave; ++w) base += wsum[w];
    float* o = ccum + ((size_t)b * NFX + h) * SEQ + tid * 16;
#pragma unroll
    for (int i = 0; i < 16; ++i) o[i] = (base + x[i]) * 1.4426950408889634f;
    __syncthreads();
}

__device__ __forceinline__ void pool_window(Frame& F, const bf16* proj, bf16* mix) {
    const int g0 = (F.vcu * NWAVES + F.wave) * 64 + F.lane, GS = F.G * NWAVES * 64;
    for (int it = g0; it < NTOK * 32; it += GS) {
        const int tok = it >> 5, ch = it & 31, pos = tok % SEQ, win = 2 << (ch >> 3), cnt = (pos + 1 < win) ? pos + 1 : win;
        const bf16* yp = proj + (size_t)tok * PP + C_U + 8 * ch;
        float a[8], y0[8];
        { const v4u q = *(const v4u*)yp; y0[0] = bflo(q.x); y0[1] = bfhi(q.x); y0[2] = bflo(q.y); y0[3] = bfhi(q.y); y0[4] = bflo(q.z); y0[5] = bfhi(q.z); y0[6] = bflo(q.w); y0[7] = bfhi(q.w); }
#pragma unroll
        for (int i = 0; i < 8; ++i) a[i] = y0[i];
        for (int j = 1; j < cnt; ++j) { const v4u q = *(const v4u*)(yp - (size_t)j * PP);
            a[0] += bflo(q.x); a[1] += bfhi(q.x); a[2] += bflo(q.y); a[3] += bfhi(q.y); a[4] += bflo(q.z); a[5] += bfhi(q.z); a[6] += bflo(q.w); a[7] += bfhi(q.w); }
        const float ic = 1.f / (float)cnt;
        v4u w; w.x = pk2(a[0] * ic - y0[0], a[1] * ic - y0[1]); w.y = pk2(a[2] * ic - y0[2], a[3] * ic - y0[3]); w.z = pk2(a[4] * ic - y0[4], a[5] * ic - y0[5]); w.w = pk2(a[6] * ic - y0[6], a[7] * ic - y0[7]);
        *(v4u*)(mix + (size_t)tok * D + SBD + FXD + 8 * ch) = w;
    }
}

typedef short bf16x8 __attribute__((ext_vector_type(8)));
typedef float f32x16 __attribute__((ext_vector_type(16)));
__device__ __forceinline__ int kperm(int r) { const int g = (r >> 2) & 3; const int g2 = (g == 1) ? 2 : (g == 2) ? 1 : g; return (r & 16) + 4 * g2 + (r & 3); }
__device__ __forceinline__ float xhalf(float v) { return __shfl_xor(v, 32); }
__device__ __forceinline__ bf16x8 pack8(const f32x16& p, int s) {
    v4u w; w.x = pg8::cvt_pk_bf16(p[8 * s + 0], p[8 * s + 1]); w.y = pg8::cvt_pk_bf16(p[8 * s + 2], p[8 * s + 3]); w.z = pg8::cvt_pk_bf16(p[8 * s + 4], p[8 * s + 5]); w.w = pg8::cvt_pk_bf16(p[8 * s + 6], p[8 * s + 7]);
    return __builtin_bit_cast(bf16x8, w);
}
__device__ __forceinline__ void store_ot(bf16* dst, const f32x16& o, float sc, int hh) {
#pragma unroll
    for (int g = 0; g < 4; ++g) { v2u w; w.x = pg8::cvt_pk_bf16(o[4 * g] * sc, o[4 * g + 1] * sc); w.y = pg8::cvt_pk_bf16(o[4 * g + 2] * sc, o[4 * g + 3] * sc); *(v2u*)(dst + 8 * g + 4 * hh) = w; }
}

__device__ __forceinline__ void fox_knorm(Frame& F, const bf16* proj, gu32* kmax) {
    const int gw = F.vcu * NWAVES + F.wave, NGW = F.G * NWAVES, lane = F.lane;
    const int NU = NBATCH * NFX * (SEQ / 64);
    for (int u = gw; u < NU; u += NGW) {
        const int bh = u / (SEQ / 64), tb = u % (SEQ / 64), b = bh / NFX, h = bh % NFX;
        const bf16* kr = proj + ((size_t)b * SEQ + tb * 64 + lane) * PP + C_FK + h * HD;
        float ss = 0.f;
#pragma unroll
        for (int i = 0; i < 8; ++i) { const v4u r = *(const v4u*)(kr + 8 * i);
            ss += (bflo(r.x) * bflo(r.x) + bfhi(r.x) * bfhi(r.x)) + (bflo(r.y) * bflo(r.y) + bfhi(r.y) * bfhi(r.y)) + (bflo(r.z) * bflo(r.z) + bfhi(r.z) * bfhi(r.z)) + (bflo(r.w) * bflo(r.w) + bfhi(r.w) * bfhi(r.w)); }
        ss = wave_max(ss);
        if (lane == 0) __hip_atomic_fetch_max(kmax + bh, __float_as_uint(ss), RLX_AGENT);
    }
}
#ifndef FOX_THR
#define FOX_THR 104.0f
#endif
constexpr int AT_STB = 8192 + 8192 + 256;
template <int FOX>
__device__ __forceinline__ void attn_wg(Frame& F, const bf16* proj, const bf16* vt, const float* ccum, const gu32* kmax, bf16* mix) {
    constexpr int NH = FOX ? NFX : NSB, COLQ = FOX ? C_FQ : C_SQ, COLK = FOX ? C_FK : C_SK, VROW0 = FOX ? SBD : 0, OCOL = FOX ? SBD : 0;
    constexpr float L2E = 1.4426950408889634f, SC = 0.125f * L2E;
    LAS unsigned char* L = F.lds + RING_OFF;
    LAS unsigned* flags = (LAS unsigned*)(L + 2 * AT_STB);
    const int tid = F.tid, lane = F.lane, wave = F.wave, r = lane & 31, hh = lane >> 5;
    const int srow = tid >> 3, sch = tid & 7, swr = srow * 128 + 16 * (sch ^ ((srow >> 1) & 7));
    const int krow = kperm(r), ksw = (krow >> 1) & 7, vsw = (r >> 1) & 7;
    const int NT = SEQ / 256, NU = NBATCH * NH * NT;
    for (int u = F.vcu; u < NU; u += F.G) {
        const int bh = u / NT, tile = (NT - 1) - u % NT, b = bh / NH, h = bh % NH, T0 = tile * 256, tq = T0 + 32 * wave + r, myblk = tile * 8 + wave;
        const size_t tokb = (size_t)b * SEQ;
        const float* cc = ccum + (size_t)bh * SEQ;
        const bf16* kg = proj + (tokb + srow) * PP + COLK + h * HD + 8 * sch;
        const bf16* vg = vt + (size_t)(VROW0 + h * HD + srow) * VTP + tokb + 8 * sch;
        bf16x8 qf[4]; float qn = 0.f;
        { const bf16* qp = proj + (tokb + tq) * PP + COLQ + h * HD + 8 * hh;
#pragma unroll
          for (int ks = 0; ks < 4; ++ks) { qf[ks] = *(const bf16x8*)(qp + 16 * ks);
              if (FOX) {
#pragma unroll
                  for (int j = 0; j < 8; ++j) { const float x = bf2f((bf16)qf[ks][j]); qn += x * x; } } } }
        float zb2 = 0.f, ct2 = 0.f;
        if (FOX) { qn += xhalf(qn); zb2 = (0.125f * sqrtf(qn * __uint_as_float(__hip_atomic_load(kmax + bh, RLX_AGENT))) * 1.01f + 0.01f) * L2E; ct2 = cc[tq]; }
        float l = 0.f, cb = 0.f, Rp = 1.f; f32x16 o[2] = {};
        bool mydone = false;
        const int nst = tile * 4 + 4;
        v4u gk, gv; float gc = 0.f;
        { const int k0 = T0 + 192; gk = *(const v4u*)(kg + (size_t)k0 * PP); gv = *(const v4u*)(vg + k0); if (FOX && tid < 64) gc = cc[k0 + tid]; }
        *(LAS v4u*)(L + swr) = gk; *(LAS v4u*)(L + 8192 + swr) = gv; if (FOX && tid < 64) *(LAS float*)(L + 16384 + 4 * tid) = gc;
        LDS_WAIT(); __syncthreads();
        for (int j = 0; j < nst; ++j) {
            const int k0 = T0 + 192 - 64 * j;
            LAS unsigned char* B = L + (j & 1) * AT_STB;
            if (j + 1 < nst) { const int k1 = k0 - 64; gk = *(const v4u*)(kg + (size_t)k1 * PP); gv = *(const v4u*)(vg + k1); if (FOX && tid < 64) gc = cc[k1 + tid]; }
#pragma unroll
            for (int sbi = 0; sbi < 2; ++sbi) {
                const int sb = 1 - sbi, blk = (k0 >> 5) + sb, s0 = k0 + 32 * sb;
                if (blk > myblk || mydone) continue;
                const bool diag = (blk == myblk);
                f32x16 S = {};
#pragma unroll
                for (int ks = 0; ks < 4; ++ks) { const bf16x8 kf = *(const LAS bf16x8*)(B + (32 * sb + krow) * 128 + 16 * ((2 * ks + hh) ^ ksw)); S = __builtin_amdgcn_mfma_f32_32x32x16_bf16(kf, qf[ks], S, 0, 0, 0); }
                if (FOX) {
                    f32x4 c4[4];
#pragma unroll
                    for (int s2 = 0; s2 < 2; ++s2) { c4[2 * s2] = *(const LAS f32x4*)(B + 16384 + 4 * (32 * sb + 16 * s2 + 8 * hh)); c4[2 * s2 + 1] = *(const LAS f32x4*)(B + 16384 + 4 * (32 * sb + 16 * s2 + 8 * hh + 4)); }
                    if (diag) {
                        float bm = -INFINITY;
#pragma unroll
                        for (int i = 0; i < 16; ++i) { const int key = s0 + 16 * (i >> 3) + 8 * hh + (i & 7); float x = S[i] * SC + (ct2 - c4[i >> 2][i & 3]); if (key > tq) x = -INFINITY; S[i] = x; bm = fmaxf(bm, x); }
                        bm = fmaxf(bm, xhalf(bm));
                        const float mref = fmaxf(bm, zb2 - 60.f * L2E); cb = ct2 - mref;
#pragma unroll
                        for (int i = 0; i < 16; ++i) { const float pv = __builtin_amdgcn_exp2f(S[i] - mref); S[i] = pv; l += pv; }
                    } else {
#pragma unroll
                        for (int i = 0; i < 16; ++i) { const float pv = __builtin_amdgcn_exp2f(S[i] * SC + (cb - c4[i >> 2][i & 3])); S[i] = pv; l += pv; }
                    }
                    mydone = __all(zb2 + (cb - c4[0][0]) + 13.f <= __log2f(l) - FOX_THR * L2E);
                } else {
                    float om[16];
#pragma unroll
                    for (int i = 0; i < 16; ++i) { const float e = __builtin_amdgcn_exp2f(fabsf(S[i]) * -SC);
                        const float sg = __builtin_amdgcn_rcpf(1.f + e), es = e * sg; const bool pos = S[i] >= 0.f; float bb = pos ? sg : es; float omb = pos ? es : sg;
                        if (diag) { const int key = s0 + 16 * (i >> 3) + 8 * hh + (i & 7); if (key >= tq) { bb = 0.f; omb = 1.f; } }
                        S[i] = bb; om[i] = omb; }
                    float TA = 1.f, TB = 1.f;
#pragma unroll
                    for (int jj = 7; jj >= 0; --jj) { const float a = om[jj], c2 = om[8 + jj]; S[jj] *= TA; S[8 + jj] *= TB; TA *= a; TB *= c2; }
                    const float PA = xhalf(TA), PB = xhalf(TB);
                    const float offB = Rp * (hh ? 1.f : PB), offA = Rp * TB * PB * (hh ? 1.f : PA);
#pragma unroll
                    for (int jj = 0; jj < 8; ++jj) { S[jj] *= offA; S[8 + jj] *= offB; }
                    Rp *= (TA * TB) * (PA * PB);
                    mydone = __all(Rp == 0.f);
                }
                const bf16x8 p0 = pack8(S, 0), p1 = pack8(S, 1);
#pragma unroll
                for (int db = 0; db < 2; ++db) {
                    const bf16x8 v0 = *(const LAS bf16x8*)(B + 8192 + (32 * db + r) * 128 + 16 * ((4 * sb + hh) ^ vsw)), v1 = *(const LAS bf16x8*)(B + 8192 + (32 * db + r) * 128 + 16 * ((4 * sb + 2 + hh) ^ vsw));
                    o[db] = __builtin_amdgcn_mfma_f32_32x32x16_bf16(v0, p0, o[db], 0, 0, 0); o[db] = __builtin_amdgcn_mfma_f32_32x32x16_bf16(v1, p1, o[db], 0, 0, 0); }
            }
            if (lane == 0) flags[(j & 1) * 8 + wave] = mydone ? 1u : 0u;
            if (j + 1 < nst) { LAS unsigned char* Bn = L + ((j + 1) & 1) * AT_STB; *(LAS v4u*)(Bn + swr) = gk; *(LAS v4u*)(Bn + 8192 + swr) = gv; if (FOX && tid < 64) *(LAS float*)(Bn + 16384 + 4 * tid) = gc; }
            LDS_WAIT(); __syncthreads();
            const v4u f0 = *(const LAS v4u*)(flags + (j & 1) * 8), f1 = *(const LAS v4u*)(flags + (j & 1) * 8 + 4);
            if ((f0.x & f0.y & f0.z & f0.w & f1.x & f1.y & f1.z & f1.w) != 0u) break;
        }
        float inv = 1.f;
        if (FOX) { l += xhalf(l); inv = 1.f / l; }
        bf16* op = mix + (tokb + tq) * D + OCOL + h * HD;
        store_ot(op, o[0], inv, hh); store_ot(op + 32, o[1], inv, hh);
        __syncthreads();
    }
}

__device__ __forceinline__ void xa_mfma(Frame& F, const bf16* xq, const bf16* xk, const bf16* xvt, bf16* xo) {
    const int gw = F.vcu * NWAVES + F.wave, NGW = F.G * NWAVES, lane = F.lane, r = lane & 31, hh = lane >> 5;
    const int NU = (NTOK / 32) * XAH;
    for (int u = gw; u < NU; u += NGW) {
        const int hd = u & 3, tb = u >> 2, tok0 = tb * 32, b = tok0 / SEQ;
        bf16x8 qf[16];
        { const bf16* qp = xq + (size_t)(tok0 + r) * D + hd * XAD + 8 * hh;
#pragma unroll
          for (int ks = 0; ks < 16; ++ks) qf[ks] = *(const bf16x8*)(qp + 16 * ks); }
        f32x16 S[8];
#pragma unroll
        for (int kb = 0; kb < 8; ++kb) {
            const bf16* kp = xk + (size_t)(b * MEML + kb * 32 + kperm(r)) * D + hd * XAD + 8 * hh;
            f32x16 acc = {};
#pragma unroll
            for (int ks = 0; ks < 16; ++ks) { const bf16x8 kf = *(const bf16x8*)(kp + 16 * ks); acc = __builtin_amdgcn_mfma_f32_32x32x16_bf16(kf, qf[ks], acc, 0, 0, 0); }
            S[kb] = acc;
        }
        float mx = -INFINITY;
#pragma unroll
        for (int kb = 0; kb < 8; ++kb)
#pragma unroll
            for (int i = 0; i < 16; ++i) mx = fmaxf(mx, S[kb][i]);
        mx = fmaxf(mx, xhalf(mx));
        float sm = 0.f;
#pragma unroll
        for (int kb = 0; kb < 8; ++kb)
#pragma unroll
            for (int i = 0; i < 16; ++i) { const float e = __expf((S[kb][i] - mx) * 0.0625f); S[kb][i] = e; sm += e; }
        sm += xhalf(sm);
        const float inv = 1.f / sm;
        bf16x8 pb[8][2];
#pragma unroll
        for (int kb = 0; kb < 8; ++kb) { pb[kb][0] = pack8(S[kb], 0); pb[kb][1] = pack8(S[kb], 1); }
#pragma unroll
        for (int half = 0; half < 2; ++half) {
            f32x16 o[4] = {};
            const bf16* vp = xvt + (size_t)(hd * XAD + half * 128 + r) * NMEM + b * MEML + 8 * hh;
#pragma unroll
            for (int kb = 0; kb < 8; ++kb)
#pragma unroll
                for (int s2 = 0; s2 < 2; ++s2)
#pragma unroll
                    for (int db = 0; db < 4; ++db) { const bf16x8 vf = *(const bf16x8*)(vp + (size_t)db * 32 * NMEM + kb * 32 + 16 * s2); o[db] = __builtin_amdgcn_mfma_f32_32x32x16_bf16(vf, pb[kb][s2], o[db], 0, 0, 0); }
#pragma unroll
            for (int db = 0; db < 4; ++db) store_ot(xo + (size_t)(tok0 + r) * D + hd * XAD + half * 128 + db * 32, o[db], inv, hh);
        }
    }
}
__device__ __forceinline__ void moe_offsets(const gu32* cnt, int (&pstart)[8], int& nblk) {
    int acc = 0;
#pragma unroll
    for (int e = 0; e < 8; ++e) { const int c = (int)__hip_atomic_load(cnt + e, RLX_AGENT); pstart[e] = acc; acc += ((c + 255) >> 8) << 8; }
    nblk = acc >> 8;
}
__device__ __forceinline__ void moe_gather(Frame& F, const bf16* hn, bf16* xs, int* tokt, int* blke) {
    int pstart[8], nblk; moe_offsets(F.ctl + CW_CNT, pstart, nblk);
    if (blockIdx.x == 0 && F.tid < MAXBLK + 1) {
        if (F.tid == MAXBLK) blke[MAXBLK] = nblk;
        else { int e = 0;
#pragma unroll
            for (int j = 1; j < 8; ++j) if (F.tid * 256 >= pstart[j]) e = j;
            blke[F.tid] = e; }
    }
    const int gw = F.vcu * NWAVES + F.wave, NGW = F.G * NWAVES, lane = F.lane;
    for (int row = gw; row < NTOK; row += NGW) {
        int* t = tokt + (size_t)row * 8; const int e0 = t[0], p0 = t[1], e1 = t[3], p1 = t[4];
        int s0 = 0, s1 = 0;
#pragma unroll
        for (int j = 0; j < 8; ++j) { s0 = (e0 == j) ? pstart[j] : s0; s1 = (e1 == j) ? pstart[j] : s1; }
        const int d0 = s0 + p0, d1 = s1 + p1;
#pragma unroll
        for (int j = 0; j < 2; ++j) { const v4u r = *(const v4u*)(hn + (size_t)row * D + 8 * lane + 512 * j);
            *(v4u*)(xs + (size_t)d0 * D + 8 * lane + 512 * j) = r; *(v4u*)(xs + (size_t)d1 * D + 8 * lane + 512 * j) = r; }
        asm volatile("" ::: "memory");
        if (lane == 0) { t[1] = d0; t[4] = d1; }
    }
}

constexpr int NPHASE = 30;
__global__ void __launch_bounds__(NWAVES * 64, 2) fwd(Args args) {
    extern __shared__ __attribute__((aligned(16))) unsigned char lds[];
    Frame F;
    F.lds = (LAS unsigned char*)lds;
    F.tid = threadIdx.x; F.lane = F.tid & 63; F.wave = __builtin_amdgcn_readfirstlane(F.tid >> 6);
    F.G = gridDim.x; { const int bx = blockIdx.x; F.vcu = (F.G % 8 == 0) ? (bx % 8) * (F.G / 8) + bx / 8 : bx; }
    F.ctl = (gu32*)(args.ws + WS_CTL);
    volatile LAS unsigned* MISC = (volatile LAS unsigned*)(F.lds + MISC_OFF);
    for (int u = F.tid; u < (LDS_BYTES - LDSCTL_OFF) / 4; u += NWAVES * 64) ((LAS unsigned*)(F.lds + LDSCTL_OFF))[u] = 0u;
    __syncthreads();
    XcdBarrier bar; bar.bar = (unsigned*)(F.ctl + CW_BAR); bar.x = 0; bar.st = nullptr;
    const int lo = args.ph_lo, hi = args.ph_hi;
    if (hi - lo > 1) bar = xcd_barrier_post((unsigned*)(F.ctl + CW_BAR), MISC + 8);
#ifndef PHASE_MASK
#define PHASE_MASK 0xffffffffffull
#endif
#define IN(k) ((((unsigned long long)(PHASE_MASK) >> (k)) & 1ull) && lo <= (k) && (k) < hi && (fresh(F), true))
#define SEAM(k) do { if (IN(k) && IN((k) + 1)) xcd_barrier(bar); } while (0)
#ifndef PROBE_MASK
#define PROBE_MASK 0ull
#endif
#ifndef PROBE2_MASK
#define PROBE2_MASK 0
#endif
#define TWICE(bit, stmt) do { stmt; if ((PROBE2_MASK >> (bit)) & 1) { xcd_barrier(bar); stmt; } } while (0)
#define REP(k) for (int rep_ = 0; rep_ < (int)(1 + (((unsigned long long)(PROBE_MASK) >> (k)) & 1ull)); ++rep_, (rep_ < (int)(1 + (((unsigned long long)(PROBE_MASK) >> (k)) & 1ull)) ? xcd_barrier(bar) : (void)0))
#define ws WSB
#define scr ((LAS float*)(F.lds + RING_OFF + F.wave * 16384))
#define HN ((bf16*)(ws + R2_HN))
#define MIX ((bf16*)(ws + R2_MIX))
#define PROJ ((bf16*)(ws + R1_PROJ))
#define VT ((bf16*)(ws + R1_VT))
#define BA ((bf16*)(ws + R1_A))
#define BB ((bf16*)(ws + R1_B))
#define ACT ((bf16*)(ws + R1_ACT))
#define XS ((bf16*)(ws + R2_XS))
#define LOGF ((float*)(ws + WS_LOGF))
#define CCUM ((float*)(ws + WS_CCUM))
#define TOKT ((int*)(ws + WS_TOKT))
#define BLKE ((int*)(ws + WS_BLKE))
#define MN ((bf16*)(ws + WS_MN))
#define XKV ((bf16*)(ws + WS_XKV))
#define XK ((bf16*)(ws + WS_XKV))
#define XVT ((bf16*)(ws + WS_XKV + 2 * MiB))
    const int bx = (int)blockIdx.x;

#define GEMM_PLAIN(Aptr, Btptr, M_, N_, K_, Optr, ldc_) do { pg8::Gemm g{(const pg8::bf16_t*)(Aptr), (const pg8::bf16_t*)(Btptr), (M_), (N_), (K_)}; pg8::StaticOrder S; S.init(g, F.G, bx); \
        pg8::EpiBf16 E{(pg8::bf16_t*)(Optr), (ldc_), 0}; pg8::gemm_phase<pg8::EpiBf16, pg8::StaticOrder, true, true>(F.lds + RING_OFF, (K_), S, E); } while (0)

    if (IN(0)) REP(0) {
        convert_layer_small(F, 0, (bf16*)(ws + WS_WS0), scr);
        convert_layer_small(F, 1, (bf16*)(ws + WS_WS1), scr);
        transpose_gu(F, INP(I_DG), INP(I_DU), (bf16*)(ws + WS_WGU0), scr);
        transpose_mat(F, INP(I_DD), D, 0, D, DFF, (bf16*)(ws + WS_WD0), 0, scr);
        { float* wr = (float*)(ws + WS_WR); for (int i = (F.vcu * NWAVES + F.wave) * 64 + F.lane; i < 8 * D; i += F.G * NWAVES * 64) { const int e = i / D, k = i % D; wr[e * D + k] = INP(I_RW)[(size_t)k * NE + e]; } }
        mem_norm(F, INP(I_MEM), INP(I_MEMN), MN);
    }
    SEAM(0);
    if (IN(1)) REP(1) {
        thin_rows<0, false, true, 1>(F, INP(I_X), nullptr, nullptr, nullptr, INP(I_MIXPRE), HN, (const float*)(ws + WS_WF), INP(I_BF), LOGF, nullptr, nullptr);
    }
    SEAM(1);
#pragma unroll
    for (int l = 0; l < DEPTH; ++l) {
        const int p0 = (l == 0) ? 2 : 15;
        const bf16* WSL = (const bf16*)(ws + (l == 0 ? WS_WS0 : WS_WS1));
        const float* h_res = (l == 0) ? INP(I_X) : OUTP;
        if (IN(p0)) REP(p0) {
            scan_logf(F, LOGF, CCUM);
            GEMM_PLAIN(HN, WSL + OW_IN / 2, NTOK, PP, D, PROJ, PP);
            GEMM_PLAIN(WSL + OW_IN / 2 + (size_t)PP * D, HN, VTN, NTOK, D, VT, VTP);
            GEMM_PLAIN(MN, WSL + OW_KV / 2, NMEM, D, D, XK, D);
            GEMM_PLAIN(WSL + OW_KV / 2 + (size_t)D * D, MN, D, NMEM, D, XVT, NMEM);
        }
        SEAM(p0);
        if (IN(p0 + 1)) REP(p0 + 1) {
            TWICE(0, fox_knorm(F, PROJ, F.ctl + CW_KMAX + l * 24));
            TWICE(1, attn_wg<0>(F, PROJ, VT, nullptr, nullptr, MIX));
            TWICE(2, pool_window(F, PROJ, MIX));
        }
        SEAM(p0 + 1);
        if (IN(p0 + 2)) REP(p0 + 2) {
            attn_wg<1>(F, PROJ, VT, CCUM, F.ctl + CW_KMAX + l * 24, MIX);
        }
        SEAM(p0 + 2);
        if (IN(p0 + 3)) REP(p0 + 3) GEMM_PLAIN(MIX, WSL + OW_OUT / 2, NTOK, D, D, BA, D);
        SEAM(p0 + 3);
        if (IN(p0 + 4)) REP(p0 + 4) thin_rows<1, true, true, 0>(F, h_res, BA, INP(I_MIXPOST) + l * D, OUTP, INP(I_XAPRE) + l * D, HN, nullptr, nullptr, nullptr, nullptr, nullptr);
        SEAM(p0 + 4);
        if (IN(p0 + 5)) REP(p0 + 5) GEMM_PLAIN(HN, WSL + OW_Q / 2, NTOK, D, D, BB, D);
        SEAM(p0 + 5);
        if (IN(p0 + 6)) REP(p0 + 6) xa_mfma(F, BB, XK, XVT, BA);
        SEAM(p0 + 6);
        if (IN(p0 + 7)) REP(p0 + 7) GEMM_PLAIN(BA, WSL + OW_O / 2, NTOK, D, D, BB, D);
        SEAM(p0 + 7);
        if (l == 0) {
            if (IN(10)) REP(10) thin_rows<1, true, true, 0>(F, OUTP, BB, INP(I_XAPOST), OUTP, INP(I_FFPRE), HN, nullptr, nullptr, nullptr, nullptr, nullptr);
            SEAM(10);
            if (IN(11)) REP(11) { pg8::Gemm g{(const pg8::bf16_t*)HN, (const pg8::bf16_t*)(ws + WS_WGU0), NTOK, 2 * DFF, D}; pg8::StaticOrder S; S.init(g, F.G, bx);
                pg8::EpiSwiGLU E{(pg8::bf16_t*)ACT, DFF, 0}; pg8::gemm_phase<pg8::EpiSwiGLU, pg8::StaticOrder, true, true>(F.lds + RING_OFF, D, S, E); }
            SEAM(11);
            if (IN(12)) REP(12) GEMM_PLAIN(ACT, ws + WS_WD0, NTOK, D, DFF, MIX, D);
            SEAM(12);
            if (IN(13)) REP(13) thin_rows<1, true, true, 1>(F, OUTP, MIX, INP(I_FFPOST), OUTP, INP(I_MIXPRE) + D, HN, (const float*)(ws + WS_WF) + 8 * D, INP(I_BF) + NFX, LOGF, nullptr, nullptr);
            SEAM(13);
            if (IN(14)) REP(14) {
                for (int e = 0; e < NE; ++e) {
                    bf16* we = (bf16*)(ws + WS_WMOE + (size_t)e * MOE_E_BYTES);
                    transpose_gu(F, INP(I_MG) + (size_t)e * D * DFF, INP(I_MU) + (size_t)e * D * DFF, we, scr);
                    transpose_mat(F, INP(I_MD) + (size_t)e * DFF * D, D, 0, D, DFF, we + MOE_GU_BYTES / 2, 0, scr);
                }
                mem_norm(F, INP(I_MEM), INP(I_MEMN) + D, MN);
            }
            SEAM(14);
        } else {
            if (IN(23)) REP(23) thin_rows<1, true, true, 2>(F, OUTP, BB, INP(I_XAPOST) + D, OUTP, INP(I_FFPRE) + D, BA, (const float*)(ws + WS_WR), nullptr, nullptr, TOKT, F.ctl + CW_CNT);
            SEAM(23);
            if (IN(24)) REP(24) moe_gather(F, BA, XS, TOKT, BLKE);
            SEAM(24);
#pragma unroll
            for (int ch = 0; ch < 2; ++ch) {
                const int nblk = BLKE[MAXBLK]; const int c0 = ch * CHUNK_BLK, c1 = (nblk < c0 + CHUNK_BLK) ? nblk : c0 + CHUNK_BLK; const int nb = c1 > c0 ? c1 - c0 : 0;
                if (IN(25 + 2 * ch)) REP(25 + 2 * ch) { pg8::MoeOrder S{nb, 2 * DFF / 256, F.G, bx, c0, 0, (const char*)XS, (const char*)(ws + WS_WMOE), (size_t)256 * D * 2, MOE_E_BYTES, BLKE};
                    pg8::EpiSwiGLU E{(pg8::bf16_t*)ACT, DFF, c0}; pg8::gemm_phase<pg8::EpiSwiGLU, pg8::MoeOrder, true, true>(F.lds + RING_OFF, D, S, E); }
                SEAM(25 + 2 * ch);
                if (IN(26 + 2 * ch)) REP(26 + 2 * ch) { pg8::MoeOrder S{nb, D / 256, F.G, bx, c0, c0, (const char*)ACT, (const char*)(ws + WS_WMOE + MOE_GU_BYTES), (size_t)256 * DFF * 2, MOE_E_BYTES, BLKE};
                    pg8::EpiBf16 E{(pg8::bf16_t*)XS, D, 0}; pg8::gemm_phase<pg8::EpiBf16, pg8::MoeOrder, true, true>(F.lds + RING_OFF, DFF, S, E); }
                SEAM(26 + 2 * ch);
            }
            if (IN(29)) REP(29) thin_rows<2, true, false, 0>(F, OUTP, XS, INP(I_FFPOST) + D, OUTP, nullptr, nullptr, nullptr, nullptr, nullptr, TOKT, nullptr);
        }
    }
#undef IN
#undef SEAM
#undef ws
#undef scr
#undef HN
#undef MIX
#undef PROJ
#undef VT
#undef BA
#undef BB
#undef ACT
#undef XS
#undef LOGF
#undef CCUM
#undef TOKT
#undef BLKE
#undef MN
#undef XKV
#undef XK
#undef XVT
}

extern "C" void kernel_launch(void* const* d_in, const int* in_sizes, int n_in, void* d_out, int out_size, void* d_ws, size_t ws_size, hipStream_t stream) {
    static int grid = 0;
    if (grid == 0) {
        if (n_in != 24 || in_sizes[0] != NTOK * D || out_size != NTOK * D || ws_size < WS_END) { fprintf(stderr, "kernel_launch: unexpected shapes / workspace (%d inputs, ws %zu < %zu)\n", n_in, ws_size, (size_t)WS_END); grid = -1; return; }
        int dev = 0, cus = 0, per_cu = 0;
        if (hipGetDevice(&dev) != hipSuccess || hipDeviceGetAttribute(&cus, hipDeviceAttributeMultiprocessorCount, dev) != hipSuccess) { grid = -1; return; }
        if (hipFuncSetAttribute((const void*)fwd, hipFuncAttributeMaxDynamicSharedMemorySize, LDS_BYTES) != hipSuccess) { fprintf(stderr, "kernel_launch: hipFuncSetAttribute failed\n"); grid = -1; return; }
        if (hipOccupancyMaxActiveBlocksPerMultiprocessor(&per_cu, (const void*)fwd, NWAVES * 64, LDS_BYTES) != hipSuccess || per_cu < 1) { fprintf(stderr, "kernel_launch: occupancy query reports %d\n", per_cu); }
        (void)hipGetLastError();
        grid = cus;
    }
    if (grid < 0) return;
    (void)hipMemsetAsync((char*)d_ws + WS_CTL, 0, CTL_ZERO_BYTES, stream);
    Args a{};
    for (int i = 0; i < 24; ++i) a.in[i] = (const float*)d_in[i];
    a.out = (float*)d_out; a.ws = (unsigned char*)d_ws;
#if MK_ONE_LAUNCH
    a.ph_lo = 0; a.ph_hi = NPHASE;
    hipLaunchKernelGGL(fwd, dim3(grid), dim3(NWAVES * 64), LDS_BYTES, stream, a);
#else
    for (int p = 0; p < NPHASE; ++p) {
        a.ph_lo = p; a.ph_hi = p + 1;
        hipLaunchKernelGGL(fwd, dim3(grid), dim3(NWAVES * 64), LDS_BYTES, stream, a);
    }
#endif
}
```

```cpp
#include <hip/hip_runtime.h>
#include <cstdio>
#include <cstdint>

#ifndef MK_ONE_LAUNCH
#define MK_ONE_LAUNCH 1
#endif

namespace pg8 {
#define PG8_LAS __attribute__((address_space(3)))
typedef unsigned short bf16_t;
typedef short bf16x8 __attribute__((ext_vector_type(8)));
typedef float f32x4 __attribute__((ext_vector_type(4)));
typedef unsigned u32x4 __attribute__((ext_vector_type(4)));
constexpr int BM = 256, BK = 64, HALF = 128, HTB = HALF * BK * 2  , STAGE_BYTES = 8 * HTB, NXCD = 8, WGM = 8;

__host__ __device__ __forceinline__ int lds_byte(int r, int c) { const int st = (r >> 4) * 2 + (c >> 5), rr = r & 15, cc = c & 31, ob = rr * 64 + cc * 2; return st * 1024 + (ob ^ (((ob >> 9) & 1) << 5)); }
__host__ __device__ __forceinline__ void stage_rc(int b, int& R, int& C) { const int st = b / 1024, sb = b % 1024, swz = sb ^ (((sb >> 9) & 1) << 5); R = (st >> 1) * 16 + swz / 64; C = (st & 1) * 32 + (swz % 64) / 2; }
__host__ __device__ __forceinline__ int perm32(int rho) { const int n = rho >> 4, i = rho & 15; return 8 * (i >> 2) + 4 * n + (i & 3); }

struct Unit { int pm, pn; const char* a; const char* b; };
struct Gemm { const bf16_t* A; const bf16_t* Bt; int M, N, K; };

__device__ __forceinline__ bool order_map(int i, int G, int c, int nM, int nN, int& pm, int& pn) {
    const int nwg = nM * nN; const long L = (long)i * G + c; if (L >= nwg) return false;
    int wgid = (int)L; { const int q = nwg / NXCD, r = nwg % NXCD, xcd = wgid % NXCD, off = wgid / NXCD; wgid = (xcd < r ? xcd * (q + 1) : r * (q + 1) + (xcd - r) * q) + off; }
    const int nig = WGM * nN, gid = wgid / nig, fm = gid * WGM, gsz = (nM - fm) < WGM ? (nM - fm) : WGM;
    pm = fm + ((wgid % nig) % gsz); pn = (wgid % nig) / gsz; return true;
}
struct StaticOrder {
    int nM, nN, G, c; const char* A; const char* B; size_t tstep;
    __device__ void init(const Gemm& g, int G_, int c_) { nM = g.M / BM; nN = g.N / BM; G = G_; c = c_; A = (const char*)g.A; B = (const char*)g.Bt; tstep = (size_t)BM * g.K * 2; }
    __device__ __forceinline__ bool next(int i, Unit& u) const {
        if (!order_map(i, G, c, nM, nN, u.pm, u.pn)) return false;
        u.a = A + (size_t)u.pm * tstep; u.b = B + (size_t)u.pn * tstep; return true;
    }
};
struct MoeOrder {
    int nM, nN, G, c, pb0, pbA; const char* A; const char* W; size_t tstep, wstride; const int* blk_e;
    __device__ __forceinline__ bool next(int i, Unit& u) const {
        int pm, pn; if (!order_map(i, G, c, nM, nN, pm, pn)) return false;
        u.pm = pb0 + pm; u.pn = pn; const int e = blk_e[u.pm];
        u.a = A + (size_t)(u.pm - pbA) * tstep; u.b = W + (size_t)e * wstride + (size_t)pn * tstep; return true;
    }
};

__device__ __forceinline__ unsigned cvt_pk_bf16(float lo, float hi) { unsigned r; asm volatile("v_cvt_pk_bf16_f32 %0, %1, %2" : "=v"(r) : "v"(lo), "v"(hi)); return r; }

struct EpiBf16 {
    static constexpr bool PERM = true;
    bf16_t* O; int ldc; int pm_off;
    __device__ __forceinline__ void operator()(const f32x4 (&acc)[2][2][4][2], const Unit& u, int wr, int wc, int fr, int fq) const {
        const int row0 = (u.pm - pm_off) * BM + wr * 64 + fr; const int col0 = u.pn * BM + wc * 32 + 8 * fq;
#pragma unroll
        for (int ai = 0; ai < 2; ++ai)
#pragma unroll
            for (int m = 0; m < 4; ++m) { bf16_t* rowp = O + (size_t)(row0 + ai * HALF + m * 16) * ldc + col0;
#pragma unroll
                for (int bj = 0; bj < 2; ++bj) { const f32x4 v0 = acc[ai][bj][m][0], v1 = acc[ai][bj][m][1];
                    u32x4 w; w.x = cvt_pk_bf16(v0[0], v0[1]); w.y = cvt_pk_bf16(v0[2], v0[3]); w.z = cvt_pk_bf16(v1[0], v1[1]); w.w = cvt_pk_bf16(v1[2], v1[3]);
                    *(u32x4*)(rowp + bj * HALF) = w; } }
    }
};
__device__ __forceinline__ float silu_mul(float g, float u) { return g * __builtin_amdgcn_rcpf(1.0f + __expf(-g)) * u; }
struct EpiSwiGLU {
    static constexpr bool PERM = true;
    bf16_t* O; int ldc; int pm_off;
    __device__ __forceinline__ void operator()(const f32x4 (&acc)[2][2][4][2], const Unit& u, int wr, int wc, int fr, int fq) const {
        const int row0 = (u.pm - pm_off) * BM + wr * 64 + fr; const int col0 = u.pn * HALF + wc * 32 + 8 * fq;
#pragma unroll
        for (int ai = 0; ai < 2; ++ai)
#pragma unroll
            for (int m = 0; m < 4; ++m) { bf16_t* rowp = O + (size_t)(row0 + ai * HALF + m * 16) * ldc + col0;
                const f32x4 g0 = acc[ai][0][m][0], g1 = acc[ai][0][m][1], u0 = acc[ai][1][m][0], u1 = acc[ai][1][m][1];
                u32x4 w; w.x = cvt_pk_bf16(silu_mul(g0[0], u0[0]), silu_mul(g0[1], u0[1])); w.y = cvt_pk_bf16(silu_mul(g0[2], u0[2]), silu_mul(g0[3], u0[3]));
                w.z = cvt_pk_bf16(silu_mul(g1[0], u1[0]), silu_mul(g1[1], u1[1])); w.w = cvt_pk_bf16(silu_mul(g1[2], u1[2]), silu_mul(g1[3], u1[3]));
                *(u32x4*)rowp = w; }
    }
};

template <class Epi, class Sched, bool ALIGN_EPI = false, bool SP2 = false>
__device__ __forceinline__ void gemm_phase(PG8_LAS unsigned char* lds, const int K, const Sched& S, const Epi& E) {
    int tid_ = threadIdx.x; asm volatile("" : "+v"(tid_));
    const int tid = tid_, wid = __builtin_amdgcn_readfirstlane(tid >> 6), lane = tid & 63, wr = wid >> 2, wc = wid & 3, fr = lane & 15, fq = lane >> 4;
    const int nt = K / BK;
    unsigned voffA[2], voffB[2];
#pragma unroll
    for (int i = 0; i < 2; ++i) { int R, C; stage_rc(tid * 16 + i * 8192, R, C); const int Rb = Epi::PERM ? ((R & ~31) + perm32(R & 31)) : R;
        voffA[i] = (unsigned)(R * K + C) * 2u; voffB[i] = (unsigned)(Rb * K + C) * 2u; }
    const size_t kstep = (size_t)(BK * 2);
    const size_t hstep = (size_t)HALF * K * 2;
    const unsigned ldsw = (unsigned)wid * 1024u;
    const int aoff = lds_byte(wr * 64 + fr, fq * 8), boff = lds_byte(wc * 32 + fr, fq * 8);
#define PG8_SA(b, h) (((b) * 2 + (h)) * HTB)
#define PG8_SB(b, h) ((4 + (b) * 2 + (h)) * HTB)
#define PG8_STAGE(bufoff, gbase, voff) do { _Pragma("unroll") for (int _i = 0; _i < 2; ++_i) \
        __builtin_amdgcn_global_load_lds((const unsigned*)((const char*)(gbase) + (voff)[_i]), (PG8_LAS unsigned*)(lds + (bufoff) + ldsw + _i * 8192), 16, 0, 0); } while (0)
#define PG8_LDA(dst, b, h) do { _Pragma("unroll") for (int m = 0; m < 4; ++m) _Pragma("unroll") for (int k = 0; k < 2; ++k) dst[m][k] = *(const PG8_LAS bf16x8*)(lds + PG8_SA(b, h) + aoff + m * 2048 + k * 1024); } while (0)
#define PG8_LDB(dst, b, h) do { _Pragma("unroll") for (int n = 0; n < 2; ++n) _Pragma("unroll") for (int k = 0; k < 2; ++k) dst[n][k] = *(const PG8_LAS bf16x8*)(lds + PG8_SB(b, h) + boff + n * 2048 + k * 1024); } while (0)
#define PG8_MMA(ai, bj, At, Bt) do { __builtin_amdgcn_s_setprio(1); _Pragma("unroll") for (int m = 0; m < 4; ++m) _Pragma("unroll") for (int n = 0; n < 2; ++n) _Pragma("unroll") for (int k = 0; k < 2; ++k) \
        acc[ai][bj][m][n] = __builtin_amdgcn_mfma_f32_16x16x32_bf16(Bt[n][k], At[m][k], acc[ai][bj][m][n], 0, 0, 0); __builtin_amdgcn_s_setprio(0); } while (0)
#define PG8_WAIT_V(n) asm volatile("s_waitcnt vmcnt(" #n ")" ::: "memory")
#define PG8_WAIT_L(n) asm volatile("s_waitcnt lgkmcnt(" #n ")" ::: "memory")
#define PG8_BAR __builtin_amdgcn_s_barrier()
#define PG8_SCHED __builtin_amdgcn_sched_barrier(0)
    Unit cur, nxt; int ui = 0;
    if (!S.next(0, cur)) return;
    f32x4 acc[2][2][4][2];
#pragma unroll
    for (int a = 0; a < 2; ++a)
#pragma unroll
        for (int b = 0; b < 2; ++b)
#pragma unroll
            for (int m = 0; m < 4; ++m)
#pragma unroll
                for (int n = 0; n < 2; ++n) acc[a][b][m][n] = (f32x4){0.f, 0.f, 0.f, 0.f};
    bf16x8 At[4][2], B0[2][2], B1[2][2];
    const char* cA = cur.a; const char* cB = cur.b;
    if constexpr (SP2) {
        PG8_STAGE(PG8_SB(0, 0), cB, voffB); PG8_STAGE(PG8_SB(0, 1), cB + hstep, voffB); PG8_STAGE(PG8_SA(0, 0), cA, voffA); PG8_STAGE(PG8_SA(0, 1), cA + hstep, voffA);
        if (wr == 1) PG8_BAR;
        PG8_WAIT_V(2); PG8_BAR;
        PG8_STAGE(PG8_SB(1, 0), cB + kstep, voffB); PG8_STAGE(PG8_SA(1, 0), cA + kstep, voffA); PG8_STAGE(PG8_SB(1, 1), cB + hstep + kstep, voffB);
        PG8_WAIT_V(6); PG8_BAR;
    } else {
        PG8_STAGE(PG8_SB(0, 0), cB, voffB); PG8_STAGE(PG8_SA(0, 0), cA, voffA); PG8_STAGE(PG8_SB(0, 1), cB + hstep, voffB); PG8_STAGE(PG8_SA(0, 1), cA + hstep, voffA);
        if (wr == 1) PG8_BAR;
        PG8_WAIT_V(4); PG8_BAR;
        PG8_STAGE(PG8_SB(1, 0), cB + kstep, voffB); PG8_STAGE(PG8_SA(1, 0), cA + kstep, voffA); PG8_STAGE(PG8_SB(1, 1), cB + hstep + kstep, voffB);
        PG8_WAIT_V(6); PG8_BAR;
    }
    for (;;) {
        const bool has_next = S.next(ui + 1, nxt);
        const char* nA = has_next ? nxt.a : cA; const char* nB = has_next ? nxt.b : cB;
        for (int t = 0; t < nt; t += 2) {
            const bool last = (t == nt - 2);
            const char* a1 = cA + (size_t)(t + 1) * kstep;
            const char* a2 = last ? nA : cA + (size_t)(t + 2) * kstep; const char* b2 = last ? nB : cB + (size_t)(t + 2) * kstep;
            const char* a3 = a2 + kstep; const char* b3 = b2 + kstep;
            if constexpr (SP2) {
            PG8_LDB(B0, 0, 0); PG8_LDB(B1, 0, 1); PG8_SCHED; PG8_LDA(At, 0, 0); PG8_STAGE(PG8_SA(1, 1), a1 + hstep, voffA);
            PG8_WAIT_V(8); PG8_WAIT_L(0); PG8_BAR; PG8_MMA(0, 0, At, B0); PG8_MMA(0, 1, At, B1); PG8_BAR; PG8_SCHED;
            PG8_LDA(At, 0, 1); PG8_STAGE(PG8_SB(0, 0), b2, voffB); PG8_STAGE(PG8_SB(0, 1), b2 + hstep, voffB); PG8_STAGE(PG8_SA(0, 0), a2, voffA);
            PG8_WAIT_V(8); PG8_WAIT_L(0); PG8_BAR; PG8_MMA(1, 0, At, B0); PG8_MMA(1, 1, At, B1); PG8_BAR; PG8_SCHED;
            PG8_LDB(B0, 1, 0); PG8_LDB(B1, 1, 1); PG8_SCHED; PG8_LDA(At, 1, 0); PG8_STAGE(PG8_SA(0, 1), a2 + hstep, voffA);
            PG8_WAIT_V(8); PG8_WAIT_L(0); PG8_BAR; PG8_MMA(0, 0, At, B0); PG8_MMA(0, 1, At, B1); PG8_BAR; PG8_SCHED;
            PG8_LDA(At, 1, 1); PG8_STAGE(PG8_SB(1, 0), b3, voffB); PG8_STAGE(PG8_SB(1, 1), b3 + hstep, voffB); PG8_STAGE(PG8_SA(1, 0), a3, voffA);
            PG8_WAIT_V(8); PG8_WAIT_L(0); PG8_BAR; PG8_MMA(1, 0, At, B0); PG8_MMA(1, 1, At, B1); PG8_BAR; PG8_SCHED;
            } else {
            PG8_LDB(B0, 0, 0); PG8_SCHED; PG8_LDA(At, 0, 0); PG8_STAGE(PG8_SA(1, 1), a1 + hstep, voffA);
            PG8_WAIT_L(8); PG8_BAR; PG8_WAIT_L(0); PG8_MMA(0, 0, At, B0); PG8_BAR; PG8_SCHED;
            PG8_LDB(B1, 0, 1); PG8_STAGE(PG8_SB(0, 0), b2, voffB);
            PG8_BAR; PG8_WAIT_L(0); PG8_MMA(0, 1, At, B1); PG8_BAR;
            PG8_LDA(At, 0, 1); PG8_STAGE(PG8_SA(0, 0), a2, voffA);
            PG8_BAR; PG8_WAIT_L(0); PG8_MMA(1, 0, At, B0); PG8_BAR; PG8_SCHED;
            PG8_STAGE(PG8_SB(0, 1), b2 + hstep, voffB);
            PG8_WAIT_V(6); PG8_BAR; PG8_MMA(1, 1, At, B1); PG8_BAR;
            PG8_LDB(B0, 1, 0); PG8_SCHED; PG8_LDA(At, 1, 0); PG8_STAGE(PG8_SA(0, 1), a2 + hstep, voffA);
            PG8_WAIT_L(8); PG8_BAR; PG8_WAIT_L(0); PG8_MMA(0, 0, At, B0); PG8_BAR; PG8_SCHED;
            PG8_LDB(B1, 1, 1); PG8_STAGE(PG8_SB(1, 0), b3, voffB);
            PG8_BAR; PG8_WAIT_L(0); PG8_MMA(0, 1, At, B1); PG8_BAR;
            PG8_LDA(At, 1, 1); PG8_STAGE(PG8_SA(1, 0), a3, voffA);
            PG8_BAR; PG8_WAIT_L(0); PG8_MMA(1, 0, At, B0); PG8_BAR; PG8_SCHED;
            PG8_STAGE(PG8_SB(1, 1), b3 + hstep, voffB);
            PG8_WAIT_V(6); PG8_BAR; PG8_MMA(1, 1, At, B1); PG8_BAR;
            }
        }
        if constexpr (ALIGN_EPI) { if (wr == 0) PG8_BAR; }
        E(acc, cur, wr, wc, fr, fq);
        if (!has_next) break;
#pragma unroll
        for (int a = 0; a < 2; ++a)
#pragma unroll
            for (int b = 0; b < 2; ++b)
#pragma unroll
                for (int m = 0; m < 4; ++m)
#pragma unroll
                    for (int n = 0; n < 2; ++n) acc[a][b][m][n] = (f32x4){0.f, 0.f, 0.f, 0.f};
        cur = nxt; cA = nA; cB = nB; ++ui;
        if constexpr (ALIGN_EPI) { if (wr == 1) PG8_BAR; }
    }
    PG8_WAIT_V(0);
    if constexpr (!ALIGN_EPI) { if (wr == 0) PG8_BAR; }
    PG8_BAR;
#undef PG8_SA
#undef PG8_SB
#undef PG8_STAGE
#undef PG8_LDA
#undef PG8_LDB
#undef PG8_MMA
#undef PG8_WAIT_V
#undef PG8_WAIT_L
#undef PG8_BAR
#undef PG8_SCHED
}
}

constexpr int NBATCH = 4, SEQ = 8192, D = 1024, NTOK = NBATCH * SEQ, DEPTH = 2;
constexpr int HD = 64, NSB = 6, NFX = 6, SBD = 384, FXD = 384, POOLD = 256, CIN = 2566;
constexpr int MEML = 256, NMEM = NBATCH * MEML, XAH = 4, XAD = 256;
constexpr int DFF = 2816, NE = 8;
constexpr float EPS = 1e-6f;
constexpr int PP = 1792, C_SQ = 0, C_SK = 384, C_FQ = 768, C_FK = 1152, C_U = 1536;
constexpr int VTN = 768, VTP = NTOK + 2112;
constexpr int MAXBLK = 264, CHUNK_BLK = 132;

constexpr size_t MiB = 1u << 20;
constexpr size_t WS_CTL = 0, CTL_ZERO_BYTES = 1 * MiB;
constexpr size_t WS_WF   = 1 * MiB;
constexpr size_t WS_WR   = WS_WF + 65536;
constexpr size_t WS_BLKE = WS_WR + 32768;
constexpr size_t WS_LOGF = 2 * MiB;
constexpr size_t WS_CCUM = 3 * MiB;
constexpr size_t WS_TOKT = 4 * MiB;
constexpr size_t WS_MN   = 5 * MiB;
constexpr size_t WS_XKV  = 7 * MiB;
constexpr size_t WS_WS1  = 16 * MiB;
constexpr size_t WS_WMOE = 31 * MiB;
constexpr size_t WS_R2   = 163 * MiB;
constexpr size_t WS_R1   = 295 * MiB;
constexpr size_t WS_END  = 295 * MiB + 190316544;
constexpr size_t OW_IN = 0, OW_OUT = 5 * MiB, OW_Q = 7 * MiB, OW_KV = 9 * MiB, OW_O = 13 * MiB, OW_LAYER = 15 * MiB;
constexpr size_t WS_WS0 = WS_WMOE;
constexpr size_t WS_WGU0 = WS_WS0 + OW_LAYER;
constexpr size_t WS_WD0 = WS_WGU0 + 11 * MiB;
constexpr size_t MOE_GU_BYTES = (size_t)2 * DFF * D * 2, MOE_D_BYTES = (size_t)D * DFF * 2, MOE_E_BYTES = MOE_GU_BYTES + MOE_D_BYTES;
static_assert(WS_WD0 + MOE_D_BYTES <= WS_WMOE + 132 * MiB && 8 * MOE_E_BYTES <= 132 * MiB, "weights map");
constexpr size_t R2_HN = WS_R2, R2_MIX = WS_R2 + 64 * MiB;
constexpr size_t R1_PROJ = WS_R1;
constexpr size_t R1_VT = WS_R1 + 112 * MiB;
constexpr size_t R1_A = WS_R1, R1_B = WS_R1 + 64 * MiB;
constexpr size_t R1_ACT = WS_R1;
constexpr size_t R2_XS = WS_R2;
static_assert((size_t)NTOK * DFF * 2 <= 190316544 && (size_t)CHUNK_BLK * 256 * DFF * 2 <= 190316544 && (size_t)MAXBLK * 256 * D * 2 <= 132 * MiB, "arena map");
constexpr int CW_CNT = 64;
constexpr int CW_KMAX = 128;
constexpr int CW_BAR = 4096;

constexpr int RING_OFF = 0, RING_BYTES = 131072;
constexpr int LDSCTL_OFF = RING_BYTES, MISC_OFF = LDSCTL_OFF + 320;
constexpr int LDS_BYTES = 147456;
constexpr int NWAVES = 8;

#define GAS __attribute__((address_space(1)))
#define LAS __attribute__((address_space(3)))
typedef unsigned short bf16;
typedef unsigned v4u __attribute__((ext_vector_type(4)));
typedef unsigned v2u __attribute__((ext_vector_type(2)));
typedef float f32x4 __attribute__((ext_vector_type(4)));
typedef GAS unsigned gu32;
#define RLX_AGENT __ATOMIC_RELAXED, __HIP_MEMORY_SCOPE_AGENT
#define LDS_WAIT() asm volatile("s_waitcnt lgkmcnt(0)" ::: "memory")
#define VM_WAIT() asm volatile("s_waitcnt vmcnt(0)" ::: "memory")
__device__ __forceinline__ unsigned f2bf(float f) { unsigned u = __builtin_bit_cast(unsigned, f); return (u + 0x7fffu + ((u >> 16) & 1u)) >> 16; }
__device__ __forceinline__ unsigned pk2(float lo, float hi) { return f2bf(lo) | (f2bf(hi) << 16); }
__device__ __forceinline__ float bflo(unsigned u) { return __uint_as_float(u << 16); }
__device__ __forceinline__ float bfhi(unsigned u) { return __uint_as_float(u & 0xffff0000u); }
__device__ __forceinline__ float bf2f(bf16 b) { return __uint_as_float(((unsigned)b) << 16); }

#define XB_TMO      128
#define XB_XCNT(j)  (256  + 64 * (j))
#define XB_XSUB(j)  (1280 + 64 * (j))
#define XB_XGEN(j)  (2304 + 64 * (j))
#define XB_TOP      3328
#define XB_TOPGEN   3392
#define XCD_BAR_WORDS 3456
#define XB_SPIN_CAP (1u << 22)

__device__ __forceinline__ unsigned xb_ld(unsigned* p)              { return __hip_atomic_load(p, __ATOMIC_RELAXED, __HIP_MEMORY_SCOPE_AGENT); }
__device__ __forceinline__ unsigned xb_add(unsigned* p, unsigned v) { return __hip_atomic_fetch_add(p, v, __ATOMIC_RELAXED, __HIP_MEMORY_SCOPE_AGENT); }
__device__ __forceinline__ unsigned xb_xcc_id() { return (unsigned)__builtin_amdgcn_s_getreg((3 << 11) | 20) & 0xFu; }
#define XB_SPIN(cond, bar) do { unsigned _sp = 0; while (cond) { __builtin_amdgcn_s_sleep(1); \
    if ((++_sp & 255u) == 0u) { if (xb_ld(&(bar)[XB_TMO])) break; if (_sp > XB_SPIN_CAP) { atomicAdd(&(bar)[XB_TMO], 1u); break; } } } } while (0)

struct XcdBarrier { unsigned* bar; unsigned x; volatile LAS unsigned* st; };

__device__ __forceinline__ XcdBarrier xcd_barrier_post(unsigned* bar, volatile LAS unsigned* st) {
    XcdBarrier b; b.bar = bar; b.x = xb_xcc_id(); b.st = st;
    if (threadIdx.x == 0) (void)xb_add(&bar[XB_XCNT(b.x)], 1u);
    return b;
}
__device__ __forceinline__ void xcd_barrier_complete(unsigned* bar, unsigned x, unsigned& nloc, unsigned& nx) {
    const unsigned G = gridDim.x * gridDim.y * gridDim.z;
    unsigned sum, cnt, mine, sp = 0u;
    for (;;) {
        sum = 0u; cnt = 0u; mine = 0u;
#pragma unroll
        for (unsigned j = 0; j < 16; ++j) { const unsigned c = xb_ld(&bar[XB_XCNT(j)]); sum += c; cnt += (c > 0u) ? 1u : 0u; mine = (j == x) ? c : mine; }
        if (sum == G) break;
        __builtin_amdgcn_s_sleep(1);
        if ((++sp & 255u) == 0u) { if (xb_ld(&bar[XB_TMO])) break; if (sp > XB_SPIN_CAP) { atomicAdd(&bar[XB_TMO], 1u); break; } }
    }
    nloc = mine > 0u ? mine : 1u; nx = cnt > 0u ? cnt : 1u;
}
__device__ __forceinline__ void xcd_barrier(const XcdBarrier& b) {
    asm volatile("s_waitcnt vmcnt(0)" ::: "memory");
    __syncthreads();
    if (threadIdx.x == 0) {
        unsigned* bar = b.bar;
        __builtin_amdgcn_s_waitcnt(0);
        unsigned nloc = b.st[0], nx = b.st[1];
        if (nloc == 0u) { xcd_barrier_complete(bar, b.x, nloc, nx); b.st[0] = nloc; b.st[1] = nx; }
        const unsigned old = xb_add(&bar[XB_XSUB(b.x)], 1u);
        const unsigned gen = old / nloc;
        if (old + 1u == (gen + 1u) * nloc) {
            __builtin_amdgcn_fence(__ATOMIC_RELEASE, "agent");
            asm volatile("s_waitcnt vmcnt(0)" ::: "memory");
            const unsigned og = xb_add(&bar[XB_TOP], 1u);
            const unsigned tg = og / nx;
            if (og + 1u == (tg + 1u) * nx) xb_add(&bar[XB_TOPGEN], 1u);
            else XB_SPIN(xb_ld(&bar[XB_TOPGEN]) == tg, bar);
            __builtin_amdgcn_fence(__ATOMIC_ACQUIRE, "agent");
            xb_add(&bar[XB_XGEN(b.x)], 1u);
            asm volatile("s_waitcnt vmcnt(0)" ::: "memory");
        } else {
            XB_SPIN(xb_ld(&bar[XB_XGEN(b.x)]) == gen, bar);
            __builtin_amdgcn_fence(__ATOMIC_ACQUIRE, "agent");
            asm volatile("s_waitcnt vmcnt(0)" ::: "memory");
        }
    }
    __syncthreads();
}

enum In { I_X = 0, I_MEM, I_MIXPRE, I_MIXPOST, I_WIN, I_BF, I_POOLW, I_POOLS, I_WOUT, I_XAPRE, I_XAPOST, I_MEMN, I_XQ, I_XKV, I_XO, I_FFPRE, I_FFPOST,
          I_DG, I_DU, I_DD, I_RW, I_MG, I_MU, I_MD };

struct Args { const float* in[24]; float* out; unsigned char* ws; int ph_lo, ph_hi; };
__device__ __forceinline__ const __attribute__((address_space(4))) Args* kargs() { const __attribute__((address_space(4))) Args* p = (const __attribute__((address_space(4))) Args*)__builtin_amdgcn_kernarg_segment_ptr(); asm volatile("" : "+s"(p)); return p; }
#define WSB (kargs()->ws)
#define INP(i) (kargs()->in[i])
#define OUTP (kargs()->out)
struct Frame {
    LAS unsigned char* lds;
    gu32* ctl;
    int tid, lane, wave;
    int vcu, G;
};


__device__ __forceinline__ void fresh(Frame& F) { int t = threadIdx.x; asm volatile("" : "+v"(t)); F.tid = t; F.lane = t & 63; F.wave = __builtin_amdgcn_readfirstlane(t >> 6); }
__device__ __forceinline__ float wave_sum(float v) {
#pragma unroll
    for (int o = 1; o < 64; o <<= 1) v += __shfl_xor(v, o);
    return v;
}
__device__ __forceinline__ float wave_max(float v) {
#pragma unroll
    for (int o = 1; o < 64; o <<= 1) v = fmaxf(v, __shfl_xor(v, o));
    return v;
}
__device__ __forceinline__ float log_sigmoid(float x) { return x < 0.f ? x - log1pf(__expf(x)) : -log1pf(__expf(-x)); }

__device__ __forceinline__ void transpose_item(const float* W, int ldw, int col0, int k0, bf16* WT, int ldwt, int row0, LAS float* scr, int lane) {
#pragma unroll 8
    for (int i = 0; i < 32; ++i) { const int kk = 2 * i + (lane >> 5); scr[kk * 33 + (lane & 31)] = W[(size_t)(k0 + kk) * ldw + col0 + (lane & 31)]; }
    LDS_WAIT(); asm volatile("" ::: "memory");
    const int c = lane & 7;
#pragma unroll
    for (int j = 0; j < 4; ++j) { const int n = (lane >> 3) + 8 * j; const LAS float* s = scr + (8 * c) * 33 + n;
        v4u o; o.x = pk2(s[0 * 33], s[1 * 33]); o.y = pk2(s[2 * 33], s[3 * 33]); o.z = pk2(s[4 * 33], s[5 * 33]); o.w = pk2(s[6 * 33], s[7 * 33]);
        *(GAS v4u*)(WT + (size_t)(row0 + n) * ldwt + k0 + 8 * c) = o; }
    LDS_WAIT(); asm volatile("" ::: "memory");
}
__device__ __forceinline__ void transpose_mat(Frame& F, const float* W, int ldw, int col0, int ncols, int K, bf16* WT, int row0, LAS float* scr) {
    const int gw = F.vcu * NWAVES + F.wave, NGW = F.G * NWAVES; const int nkb = K / 64, nitems = nkb * (ncols / 32);
    for (int it = gw; it < nitems; it += NGW) { const int kb = it % nkb, nb = it / nkb; transpose_item(W, ldw, col0 + 32 * nb, 64 * kb, WT, K, row0 + 32 * nb, scr, F.lane); }
}
__device__ __forceinline__ void transpose_gu(Frame& F, const float* Wg, const float* Wu, bf16* WT, LAS float* scr) {
    const int gw = F.vcu * NWAVES + F.wave, NGW = F.G * NWAVES; const int nkb = D / 64, ncb = DFF / 32, nitems = 2 * nkb * ncb;
    for (int it = gw; it < nitems; it += NGW) { const int kb = it % nkb, r = it / nkb, nb = r % ncb, which = r / ncb; const int n0 = 32 * nb;
        transpose_item(which ? Wu : Wg, DFF, n0, 64 * kb, WT, D, 256 * (n0 / 128) + 128 * which + (n0 % 128), scr, F.lane); }
}
__device__ __forceinline__ void convert_layer_small(Frame& F, int l, bf16* base, LAS float* scr) {
    const float* win = INP(I_WIN) + (size_t)l * D * CIN;
    bf16* wt = base + OW_IN / 2;
    transpose_mat(F, win, CIN, 0, 768, D, wt, 0, scr);
    transpose_mat(F, win, CIN, 1152, 768, D, wt, 768, scr);
    { const float* pw = INP(I_POOLW) + (size_t)l * 4 * 4096; const float* psc = INP(I_POOLS) + (size_t)l * POOLD;
      for (int i = (F.vcu * NWAVES + F.wave) * 64 + F.lane; i < POOLD * D; i += F.G * NWAVES * 64) { const int n = i / D, k = i % D, g = n >> 6, co = n & 63;
          const float* wr = win + (size_t)k * CIN + 2310 + g * 64; const float* pc = pw + g * 4096 + co; float acc = 0.f;
#pragma unroll 8
          for (int ci = 0; ci < 64; ++ci) acc += wr[ci] * pc[ci * 64];
          wt[(size_t)(1536 + n) * D + k] = (bf16)f2bf(acc * psc[n]); } }
    transpose_mat(F, win, CIN, 768, 384, D, wt, 1792, scr);
    transpose_mat(F, win, CIN, 1920, 384, D, wt, 2176, scr);
    transpose_mat(F, INP(I_WOUT) + (size_t)l * D * D, D, 0, D, D, base + OW_OUT / 2, 0, scr);
    transpose_mat(F, INP(I_XQ) + (size_t)l * D * D, D, 0, D, D, base + OW_Q / 2, 0, scr);
    transpose_mat(F, INP(I_XKV) + (size_t)l * D * 2 * D, 2 * D, 0, 2 * D, D, base + OW_KV / 2, 0, scr);
    transpose_mat(F, INP(I_XO) + (size_t)l * D * D, D, 0, D, D, base + OW_O / 2, 0, scr);
    float* wf = (float*)(WSB + WS_WF) + (size_t)l * 8 * D;
    for (int i = (F.vcu * NWAVES + F.wave) * 64 + F.lane; i < 6 * D; i += F.G * NWAVES * 64) { const int j = i / D, k = i % D; wf[j * D + k] = win[(size_t)k * CIN + 2304 + j]; }
}

#define DPP_ADD(v, ctrl) ((v) + __int_as_float(__builtin_amdgcn_update_dpp(0, __float_as_int(v), (ctrl), 0xf, 0xf, false)))
__device__ __forceinline__ float wave_sum_fast(float v) {
    v = DPP_ADD(v, 0xB1); v = DPP_ADD(v, 0x4E); v = DPP_ADD(v, 0x141); v = DPP_ADD(v, 0x140);
    const int iv = __float_as_int(v);
    return (__int_as_float(__builtin_amdgcn_readlane(iv, 0)) + __int_as_float(__builtin_amdgcn_readlane(iv, 16))) + (__int_as_float(__builtin_amdgcn_readlane(iv, 32)) + __int_as_float(__builtin_amdgcn_readlane(iv, 48)));
}
struct ThinIn { f32x4 v[4]; v2u d0[4]; v2u d1[4]; float g0, g1; };
template <int DELTA>
__device__ __forceinline__ void thin_load(ThinIn& t, int row, int lane, const float* h_in, const bf16* delta, const int* tokt) {
#pragma unroll
    for (int j = 0; j < 4; ++j) t.v[j] = *(const f32x4*)(h_in + (size_t)row * D + 4 * lane + 256 * j);
    if constexpr (DELTA == 1) {
#pragma unroll
        for (int j = 0; j < 4; ++j) t.d0[j] = *(const v2u*)(delta + (size_t)row * D + 4 * lane + 256 * j);
    }
    if constexpr (DELTA == 2) {
        const int r0 = tokt[row * 8 + 1], r1 = tokt[row * 8 + 4]; t.g0 = __int_as_float(tokt[row * 8 + 2]); t.g1 = __int_as_float(tokt[row * 8 + 5]);
#pragma unroll
        for (int j = 0; j < 4; ++j) { t.d0[j] = *(const v2u*)(delta + (size_t)r0 * D + 4 * lane + 256 * j); t.d1[j] = *(const v2u*)(delta + (size_t)r1 * D + 4 * lane + 256 * j); }
    }
}
template <int DELTA, bool WRITE_H, bool WRITE_HN, int EXTRA>
__device__ __forceinline__ void thin_rows(Frame& F, const float* h_in, const bf16* delta, const float* g_post, float* h_out, const float* g_pre, bf16* hn_out,
                                          const float* wx, const float* bfo, float* logf, int* tokt, gu32* cnt) {
    const int gw = F.vcu * NWAVES + F.wave, NGW = F.G * NWAVES, lane = F.lane;
    constexpr int NX = EXTRA == 1 ? 6 : (EXTRA == 2 ? 8 : 0);
    f32x4 gp[4], gq[4], wv[NX > 0 ? NX : 1][4];
#pragma unroll
    for (int j = 0; j < 4; ++j) { if constexpr (DELTA != 0) gp[j] = *(const f32x4*)(g_post + 4 * lane + 256 * j); if constexpr (WRITE_HN) gq[j] = *(const f32x4*)(g_pre + 4 * lane + 256 * j); }
#pragma unroll
    for (int e = 0; e < NX; ++e)
#pragma unroll
        for (int j = 0; j < 4; ++j) wv[e][j] = *(const f32x4*)(wx + e * D + 4 * lane + 256 * j);
    float bfl = 0.f; if constexpr (EXTRA == 1) { if (lane < 6) bfl = bfo[lane]; }
    ThinIn cur, nxt;
    if (gw < NTOK) thin_load<DELTA>(cur, gw, lane, h_in, delta, tokt);
    for (int row = gw; row < NTOK; row += NGW) {
        if (row + NGW < NTOK) thin_load<DELTA>(nxt, row + NGW, lane, h_in, delta, tokt);
        f32x4 v[4];
#pragma unroll
        for (int j = 0; j < 4; ++j) v[j] = cur.v[j];
        if constexpr (DELTA != 0) {
            f32x4 d[4];
            if constexpr (DELTA == 1) {
#pragma unroll
                for (int j = 0; j < 4; ++j) { const v2u r = cur.d0[j]; d[j] = (f32x4){bflo(r.x), bfhi(r.x), bflo(r.y), bfhi(r.y)}; }
            } else {
                const float g0 = cur.g0, g1 = cur.g1;
#pragma unroll
                for (int j = 0; j < 4; ++j) { const v2u r0 = cur.d0[j], r1 = cur.d1[j];
                    d[j] = (f32x4){g0 * bflo(r0.x) + g1 * bflo(r1.x), g0 * bfhi(r0.x) + g1 * bfhi(r1.x), g0 * bflo(r0.y) + g1 * bflo(r1.y), g0 * bfhi(r0.y) + g1 * bfhi(r1.y)}; }
            }
            float ss = 0.f;
#pragma unroll
            for (int j = 0; j < 4; ++j) ss += (d[j].x * d[j].x + d[j].y * d[j].y) + (d[j].z * d[j].z + d[j].w * d[j].w);
            const float rs = rsqrtf(wave_sum_fast(ss) * (1.f / D) + EPS);
#pragma unroll
            for (int j = 0; j < 4; ++j) v[j] = v[j] + d[j] * rs * gp[j];
        }
        if constexpr (WRITE_H) {
#pragma unroll
            for (int j = 0; j < 4; ++j) *(f32x4*)(h_out + (size_t)row * D + 4 * lane + 256 * j) = v[j];
        }
        if constexpr (WRITE_HN) {
            float ss = 0.f;
#pragma unroll
            for (int j = 0; j < 4; ++j) ss += (v[j].x * v[j].x + v[j].y * v[j].y) + (v[j].z * v[j].z + v[j].w * v[j].w);
            const float rs = rsqrtf(wave_sum_fast(ss) * (1.f / D) + EPS);
#pragma unroll
            for (int j = 0; j < 4; ++j) { v[j] = v[j] * rs * gq[j];
                v2u o; o.x = pk2(v[j].x, v[j].y); o.y = pk2(v[j].z, v[j].w); *(v2u*)(hn_out + (size_t)row * D + 4 * lane + 256 * j) = o; }
            if constexpr (NX > 0) {
                float lg[NX];
#pragma unroll
                for (int e = 0; e < NX; ++e) { float s2 = 0.f;
#pragma unroll
                    for (int j = 0; j < 4; ++j) { const f32x4 w = wv[e][j]; s2 += (v[j].x * w.x + v[j].y * w.y) + (v[j].z * w.z + v[j].w * w.w); }
                    lg[e] = wave_sum_fast(s2); }
                if constexpr (EXTRA == 1) {
                    if (lane < 6) { float x = lg[0];
#pragma unroll
                        for (int e = 1; e < 6; ++e) x = (lane == e) ? lg[e] : x;
                        logf[(size_t)row * 8 + lane] = log_sigmoid(x + bfl); }
                } else {
                    int e0 = 0; float v0 = lg[0];
#pragma unroll
                    for (int e = 1; e < 8; ++e) if (lg[e] > v0) { v0 = lg[e]; e0 = e; }
                    int e1 = -1; float v1 = -INFINITY;
#pragma unroll
                    for (int e = 0; e < 8; ++e) if (e != e0 && lg[e] > v1) { v1 = lg[e]; e1 = e; }
                    if (lane == 0) {
                        const float g0 = 1.f / (1.f + __expf(v1 - v0)), g1 = 1.f - g0;
                        const unsigned p0 = __hip_atomic_fetch_add(cnt + e0, 1u, RLX_AGENT), p1 = __hip_atomic_fetch_add(cnt + e1, 1u, RLX_AGENT);
                        int* t = tokt + (size_t)row * 8; t[0] = e0; t[1] = (int)p0; t[2] = __float_as_int(g0); t[3] = e1; t[4] = (int)p1; t[5] = __float_as_int(g1);
                    }
                }
            }
        }
        cur = nxt;
    }
}
__device__ __forceinline__ void mem_norm(Frame& F, const float* mem, const float* g, bf16* mn) {
    const int gw = F.vcu * NWAVES + F.wave, NGW = F.G * NWAVES, lane = F.lane;
    for (int row = gw; row < NMEM; row += NGW) {
        f32x4 v[4]; float ss = 0.f;
#pragma unroll
        for (int j = 0; j < 4; ++j) { v[j] = *(const f32x4*)(mem + (size_t)row * D + 4 * lane + 256 * j); ss += (v[j].x * v[j].x + v[j].y * v[j].y) + (v[j].z * v[j].z + v[j].w * v[j].w); }
        const float rs = rsqrtf(wave_sum(ss) * (1.f / D) + EPS);
#pragma unroll
        for (int j = 0; j < 4; ++j) { const f32x4 gg = *(const f32x4*)(g + 4 * lane + 256 * j); v[j] = v[j] * rs * gg;
            v2u o; o.x = pk2(v[j].x, v[j].y); o.y = pk2(v[j].z, v[j].w); *(v2u*)(mn + (size_t)row * D + 4 * lane + 256 * j) = o; }
    }
}
__device__ __forceinline__ void scan_logf(Frame& F, const float* logf, float* ccum) {
    if (blockIdx.x >= NBATCH * NFX) return;
    const int b = blockIdx.x / NFX, h = blockIdx.x % NFX, tid = F.tid;
    LAS float* wsum = (LAS float*)(F.lds + RING_OFF);
    float x[16]; float run = 0.f;
#pragma unroll
    for (int i = 0; i < 16; ++i) { run += logf[((size_t)b * SEQ + tid * 16 + i) * 8 + h]; x[i] = run; }
    float incl = run;
#pragma unroll
    for (int o = 1; o < 64; o <<= 1) { const float t = __shfl_up(incl, o); if (F.lane >= o) incl += t; }
    if (F.lane == 63) wsum[F.wave] = incl;
    LDS_WAIT(); __syncthreads();
    float base = incl - run;
    for (int w = 0; w < F.wave; ++w) base += wsum[w];
    float* o = ccum + ((size_t)b * NFX + h) * SEQ + tid * 16;
#pragma unroll
    for (int i = 0; i < 16; ++i) o[i] = (base + x[i]) * 1.4426950408889634f;
    __syncthreads();
}

__device__ __forceinline__ void pool_window(Frame& F, const bf16* proj, bf16* mix) {
    const int g0 = (F.vcu * NWAVES + F.wave) * 64 + F.lane, GS = F.G * NWAVES * 64;
    for (int it = g0; it < NTOK * 32; it += GS) {
        const int tok = it >> 5, ch = it & 31, pos = tok % SEQ, win = 2 << (ch >> 3), cnt = (pos + 1 < win) ? pos + 1 : win;
        const bf16* yp = proj + (size_t)tok * PP + C_U + 8 * ch;
        float a[8], y0[8];
        { const v4u q = *(const v4u*)yp; y0[0] = bflo(q.x); y0[1] = bfhi(q.x); y0[2] = bflo(q.y); y0[3] = bfhi(q.y); y0[4] = bflo(q.z); y0[5] = bfhi(q.z); y0[6] = bflo(q.w); y0[7] = bfhi(q.w); }
#pragma unroll
        for (int i = 0; i < 8; ++i) a[i] = y0[i];
        for (int j = 1; j < cnt; ++j) { const v4u q = *(const v4u*)(yp - (size_t)j * PP);
            a[0] += bflo(q.x); a[1] += bfhi(q.x); a[2] += bflo(q.y); a[3] += bfhi(q.y); a[4] += bflo(q.z); a[5] += bfhi(q.z); a[6] += bflo(q.w); a[7] += bfhi(q.w); }
        const float ic = 1.f / (float)cnt;
        v4u w; w.x = pk2(a[0] * ic - y0[0], a[1] * ic - y0[1]); w.y = pk2(a[2] * ic - y0[2], a[3] * ic - y0[3]); w.z = pk2(a[4] * ic - y0[4], a[5] * ic - y0[5]); w.w = pk2(a[6] * ic - y0[6], a[7] * ic - y0[7]);
        *(v4u*)(mix + (size_t)tok * D + SBD + FXD + 8 * ch) = w;
    }
}

typedef short bf16x8 __attribute__((ext_vector_type(8)));
typedef float f32x16 __attribute__((ext_vector_type(16)));
__device__ __forceinline__ int kperm(int r) { const int g = (r >> 2) & 3; const int g2 = (g == 1) ? 2 : (g == 2) ? 1 : g; return (r & 16) + 4 * g2 + (r & 3); }
__device__ __forceinline__ float xhalf(float v) { return __shfl_xor(v, 32); }
__device__ __forceinline__ bf16x8 pack8(const f32x16& p, int s) {
    v4u w; w.x = pg8::cvt_pk_bf16(p[8 * s + 0], p[8 * s + 1]); w.y = pg8::cvt_pk_bf16(p[8 * s + 2], p[8 * s + 3]); w.z = pg8::cvt_pk_bf16(p[8 * s + 4], p[8 * s + 5]); w.w = pg8::cvt_pk_bf16(p[8 * s + 6], p[8 * s + 7]);
    return __builtin_bit_cast(bf16x8, w);
}
__device__ __forceinline__ void store_ot(bf16* dst, const f32x16& o, float sc, int hh) {
#pragma unroll
    for (int g = 0; g < 4; ++g) { v2u w; w.x = pg8::cvt_pk_bf16(o[4 * g] * sc, o[4 * g + 1] * sc); w.y = pg8::cvt_pk_bf16(o[4 * g + 2] * sc, o[4 * g + 3] * sc); *(v2u*)(dst + 8 * g + 4 * hh) = w; }
}

__device__ __forceinline__ void fox_knorm(Frame& F, const bf16* proj, gu32* kmax) {
    const int gw = F.vcu * NWAVES + F.wave, NGW = F.G * NWAVES, lane = F.lane;
    const int NU = NBATCH * NFX * (SEQ / 64);
    for (int u = gw; u < NU; u += NGW) {
        const int bh = u / (SEQ / 64), tb = u % (SEQ / 64), b = bh / NFX, h = bh % NFX;
        const bf16* kr = proj + ((size_t)b * SEQ + tb * 64 + lane) * PP + C_FK + h * HD;
        float ss = 0.f;
#pragma unroll
        for (int i = 0; i < 8; ++i) { const v4u r = *(const v4u*)(kr + 8 * i);
            ss += (bflo(r.x) * bflo(r.x) + bfhi(r.x) * bfhi(r.x)) + (bflo(r.y) * bflo(r.y) + bfhi(r.y) * bfhi(r.y)) + (bflo(r.z) * bflo(r.z) + bfhi(r.z) * bfhi(r.z)) + (bflo(r.w) * bflo(r.w) + bfhi(r.w) * bfhi(r.w)); }
        ss = wave_max(ss);
        if (lane == 0) __hip_atomic_fetch_max(kmax + bh, __float_as_uint(ss), RLX_AGENT);
    }
}
#ifndef FOX_THR
#define FOX_THR 104.0f
#endif
constexpr int AT_STB = 8192 + 8192 + 256;
template <int FOX>
__device__ __forceinline__ void attn_wg(Frame& F, const bf16* proj, const bf16* vt, const float* ccum, const gu32* kmax, bf16* mix) {
    constexpr int NH = FOX ? NFX : NSB, COLQ = FOX ? C_FQ : C_SQ, COLK = FOX ? C_FK : C_SK, VROW0 = FOX ? SBD : 0, OCOL = FOX ? SBD : 0;
    constexpr float L2E = 1.4426950408889634f, SC = 0.125f * L2E;
    LAS unsigned char* L = F.lds + RING_OFF;
    LAS unsigned* flags = (LAS unsigned*)(L + 2 * AT_STB);
    const int tid = F.tid, lane = F.lane, wave = F.wave, r = lane & 31, hh = lane >> 5;
    const int srow = tid >> 3, sch = tid & 7, swr = srow * 128 + 16 * (sch ^ ((srow >> 1) & 7));
    const int krow = kperm(r), ksw = (krow >> 1) & 7, vsw = (r >> 1) & 7;
    const int NT = SEQ / 256, NU = NBATCH * NH * NT;
    for (int u = F.vcu; u < NU; u += F.G) {
        const int bh = u / NT, tile = (NT - 1) - u % NT, b = bh / NH, h = bh % NH, T0 = tile * 256, tq = T0 + 32 * wave + r, myblk = tile * 8 + wave;
        const size_t tokb = (size_t)b * SEQ;
        const float* cc = ccum + (size_t)bh * SEQ;
        const bf16* kg = proj + (tokb + srow) * PP + COLK + h * HD + 8 * sch;
        const bf16* vg = vt + (size_t)(VROW0 + h * HD + srow) * VTP + tokb + 8 * sch;
        bf16x8 qf[4]; float qn = 0.f;
        { const bf16* qp = proj + (tokb + tq) * PP + COLQ + h * HD + 8 * hh;
#pragma unroll
          for (int ks = 0; ks < 4; ++ks) { qf[ks] = *(const bf16x8*)(qp + 16 * ks);
              if (FOX) {
#pragma unroll
                  for (int j = 0; j < 8; ++j) { const float x = bf2f((bf16)qf[ks][j]); qn += x * x; } } } }
        float zb2 = 0.f, ct2 = 0.f;
        if (FOX) { qn += xhalf(qn); zb2 = (0.125f * sqrtf(qn * __uint_as_float(__hip_atomic_load(kmax + bh, RLX_AGENT))) * 1.01f + 0.01f) * L2E; ct2 = cc[tq]; }
        float l = 0.f, cb = 0.f, Rp = 1.f; f32x16 o[2] = {};
        bool mydone = false;
        const int nst = tile * 4 + 4;
        v4u gk, gv; float gc = 0.f;
        { const int k0 = T0 + 192; gk = *(const v4u*)(kg + (size_t)k0 * PP); gv = *(const v4u*)(vg + k0); if (FOX && tid < 64) gc = cc[k0 + tid]; }
        *(LAS v4u*)(L + swr) = gk; *(LAS v4u*)(L + 8192 + swr) = gv; if (FOX && tid < 64) *(LAS float*)(L + 16384 + 4 * tid) = gc;
        LDS_WAIT(); __syncthreads();
        for (int j = 0; j < nst; ++j) {
            const int k0 = T0 + 192 - 64 * j;
            LAS unsigned char* B = L + (j & 1) * AT_STB;
            if (j + 1 < nst) { const int k1 = k0 - 64; gk = *(const v4u*)(kg + (size_t)k1 * PP); gv = *(const v4u*)(vg + k1); if (FOX && tid < 64) gc = cc[k1 + tid]; }
#pragma unroll
            for (int sbi = 0; sbi < 2; ++sbi) {
                const int sb = 1 - sbi, blk = (k0 >> 5) + sb, s0 = k0 + 32 * sb;
                if (blk > myblk || mydone) continue;
                const bool diag = (blk == myblk);
                f32x16 S = {};
#pragma unroll
                for (int ks = 0; ks < 4; ++ks) { const bf16x8 kf = *(const LAS bf16x8*)(B + (32 * sb + krow) * 128 + 16 * ((2 * ks + hh) ^ ksw)); S = __builtin_amdgcn_mfma_f32_32x32x16_bf16(kf, qf[ks], S, 0, 0, 0); }
                if (FOX) {
                    f32x4 c4[4];
#pragma unroll
                    for (int s2 = 0; s2 < 2; ++s2) { c4[2 * s2] = *(const LAS f32x4*)(B + 16384 + 4 * (32 * sb + 16 * s2 + 8 * hh)); c4[2 * s2 + 1] = *(const LAS f32x4*)(B + 16384 + 4 * (32 * sb + 16 * s2 + 8 * hh + 4)); }
                    if (diag) {
                        float bm = -INFINITY;
#pragma unroll
                        for (int i = 0; i < 16; ++i) { const int key = s0 + 16 * (i >> 3) + 8 * hh + (i & 7); float x = S[i] * SC + (ct2 - c4[i >> 2][i & 3]); if (key > tq) x = -INFINITY; S[i] = x; bm = fmaxf(bm, x); }
                        bm = fmaxf(bm, xhalf(bm));
                        const float mref = fmaxf(bm, zb2 - 60.f * L2E); cb = ct2 - mref;
#pragma unroll
                        for (int i = 0; i < 16; ++i) { const float pv = __builtin_amdgcn_exp2f(S[i] - mref); S[i] = pv; l += pv; }
                    } else {
#pragma unroll
                        for (int i = 0; i < 16; ++i) { const float pv = __builtin_amdgcn_exp2f(S[i] * SC + (cb - c4[i >> 2][i & 3])); S[i] = pv; l += pv; }
                    }
                    mydone = __all(zb2 + (cb - c4[0][0]) + 13.f <= __log2f(l) - FOX_THR * L2E);
                } else {
                    float om[16];
#pragma unroll
                    for (int i = 0; i < 16; ++i) { const float e = __builtin_amdgcn_exp2f(fabsf(S[i]) * -SC);
                        const float sg = __builtin_amdgcn_rcpf(1.f + e), es = e * sg; const bool pos = S[i] >= 0.f; float bb = pos ? sg : es; float omb = pos ? es : sg;
                        if (diag) { const int key = s0 + 16 * (i >> 3) + 8 * hh + (i & 7); if (key >= tq) { bb = 0.f; omb = 1.f; } }
                        S[i] = bb; om[i] = omb; }
                    float TA = 1.f, TB = 1.f;
#pragma unroll
                    for (int jj = 7; jj >= 0; --jj) { const float a = om[jj], c2 = om[8 + jj]; S[jj] *= TA; S[8 + jj] *= TB; TA *= a; TB *= c2; }
                    const float PA = xhalf(TA), PB = xhalf(TB);
                    const float offB = Rp * (hh ? 1.f : PB), offA = Rp * TB * PB * (hh ? 1.f : PA);
#pragma unroll
                    for (int jj = 0; jj < 8; ++jj) { S[jj] *= offA; S[8 + jj] *= offB; }
                    Rp *= (TA * TB) * (PA * PB);
                    mydone = __all(Rp == 0.f);
                }
                const bf16x8 p0 = pack8(S, 0), p1 = pack8(S, 1);
#pragma unroll
                for (int db = 0; db < 2; ++db) {
                    const bf16x8 v0 = *(const LAS bf16x8*)(B + 8192 + (32 * db + r) * 128 + 16 * ((4 * sb + hh) ^ vsw)), v1 = *(const LAS bf16x8*)(B + 8192 + (32 * db + r) * 128 + 16 * ((4 * sb + 2 + hh) ^ vsw));
                    o[db] = __builtin_amdgcn_mfma_f32_32x32x16_bf16(v0, p0, o[db], 0, 0, 0); o[db] = __builtin_amdgcn_mfma_f32_32x32x16_bf16(v1, p1, o[db], 0, 0, 0); }
            }
            if (lane == 0) flags[(j & 1) * 8 + wave] = mydone ? 1u : 0u;
            if (j + 1 < nst) { LAS unsigned char* Bn = L + ((j + 1) & 1) * AT_STB; *(LAS v4u*)(Bn + swr) = gk; *(LAS v4u*)(Bn + 8192 + swr) = gv; if (FOX && tid < 64) *(LAS float*)(Bn + 16384 + 4 * tid) = gc; }
            LDS_WAIT(); __syncthreads();
            const v4u f0 = *(const LAS v4u*)(flags + (j & 1) * 8), f1 = *(const LAS v4u*)(flags + (j & 1) * 8 + 4);
            if ((f0.x & f0.y & f0.z & f0.w & f1.x & f1.y & f1.z & f1.w) != 0u) break;
        }
        float inv = 1.f;
        if (FOX) { l += xhalf(l); inv = 1.f / l; }
        bf16* op = mix + (tokb + tq) * D + OCOL + h * HD;
        store_ot(op, o[0], inv, hh); store_ot(op + 32, o[1], inv, hh);
        __syncthreads();
    }
}

__device__ __forceinline__ void xa_mfma(Frame& F, const bf16* xq, const bf16* xk, const bf16* xvt, bf16* xo) {
    const int gw = F.vcu * NWAVES + F.wave, NGW = F.G * NWAVES, lane = F.lane, r = lane & 31, hh = lane >> 5;
    const int NU = (NTOK / 32) * XAH;
    for (int u = gw; u < NU; u += NGW) {
        const int hd = u & 3, tb = u >> 2, tok0 = tb * 32, b = tok0 / SEQ;
        bf16x8 qf[16];
        { const bf16* qp = xq + (size_t)(tok0 + r) * D + hd * XAD + 8 * hh;
#pragma unroll
          for (int ks = 0; ks < 16; ++ks) qf[ks] = *(const bf16x8*)(qp + 16 * ks); }
        f32x16 S[8];
#pragma unroll
        for (int kb = 0; kb < 8; ++kb) {
            const bf16* kp = xk + (size_t)(b * MEML + kb * 32 + kperm(r)) * D + hd * XAD + 8 * hh;
            f32x16 acc = {};
#pragma unroll
            for (int ks = 0; ks < 16; ++ks) { const bf16x8 kf = *(const bf16x8*)(kp + 16 * ks); acc = __builtin_amdgcn_mfma_f32_32x32x16_bf16(kf, qf[ks], acc, 0, 0, 0); }
            S[kb] = acc;
        }
        float mx = -INFINITY;
#pragma unroll
        for (int kb = 0; kb < 8; ++kb)
#pragma unroll
            for (int i = 0; i < 16; ++i) mx = fmaxf(mx, S[kb][i]);
        mx = fmaxf(mx, xhalf(mx));
        float sm = 0.f;
#pragma unroll
        for (int kb = 0; kb < 8; ++kb)
#pragma unroll
            for (int i = 0; i < 16; ++i) { const float e = __expf((S[kb][i] - mx) * 0.0625f); S[kb][i] = e; sm += e; }
        sm += xhalf(sm);
        const float inv = 1.f / sm;
        bf16x8 pb[8][2];
#pragma unroll
        for (int kb = 0; kb < 8; ++kb) { pb[kb][0] = pack8(S[kb], 0); pb[kb][1] = pack8(S[kb], 1); }
#pragma unroll
        for (int half = 0; half < 2; ++half) {
            f32x16 o[4] = {};
            const bf16* vp = xvt + (size_t)(hd * XAD + half * 128 + r) * NMEM + b * MEML + 8 * hh;
#pragma unroll
            for (int kb = 0; kb < 8; ++kb)
#pragma unroll
                for (int s2 = 0; s2 < 2; ++s2)
#pragma unroll
                    for (int db = 0; db < 4; ++db) { const bf16x8 vf = *(const bf16x8*)(vp + (size_t)db * 32 * NMEM + kb * 32 + 16 * s2); o[db] = __builtin_amdgcn_mfma_f32_32x32x16_bf16(vf, pb[kb][s2], o[db], 0, 0, 0); }
#pragma unroll
            for (int db = 0; db < 4; ++db) store_ot(xo + (size_t)(tok0 + r) * D + hd * XAD + half * 128 + db * 32, o[db], inv, hh);
        }
    }
}
__device__ __forceinline__ void moe_offsets(const gu32* cnt, int (&pstart)[8], int& nblk) {
    int acc = 0;
#pragma unroll
    for (int e = 0; e < 8; ++e) { const int c = (int)__hip_atomic_load(cnt + e, RLX_AGENT); pstart[e] = acc; acc += ((c + 255) >> 8) << 8; }
    nblk = acc >> 8;
}
__device__ __forceinline__ void moe_gather(Frame& F, const bf16* hn, bf16* xs, int* tokt, int* blke) {
    int pstart[8], nblk; moe_offsets(F.ctl + CW_CNT, pstart, nblk);
    if (blockIdx.x == 0 && F.tid < MAXBLK + 1) {
        if (F.tid == MAXBLK) blke[MAXBLK] = nblk;
        else { int e = 0;
#pragma unroll
            for (int j = 1; j < 8; ++j) if (F.tid * 256 >= pstart[j]) e = j;
            blke[F.tid] = e; }
    }
    const int gw = F.vcu * NWAVES + F.wave, NGW = F.G * NWAVES, lane = F.lane;
    for (int row = gw; row < NTOK; row += NGW) {
        int* t = tokt + (size_t)row * 8; const int e0 = t[0], p0 = t[1], e1 = t[3], p1 = t[4];
        int s0 = 0, s1 = 0;
#pragma unroll
        for (int j = 0; j < 8; ++j) { s0 = (e0 == j) ? pstart[j] : s0; s1 = (e1 == j) ? pstart[j] : s1; }
        const int d0 = s0 + p0, d1 = s1 + p1;
#pragma unroll
        for (int j = 0; j < 2; ++j) { const v4u r = *(const v4u*)(hn + (size_t)row * D + 8 * lane + 512 * j);
            *(v4u*)(xs + (size_t)d0 * D + 8 * lane + 512 * j) = r; *(v4u*)(xs + (size_t)d1 * D + 8 * lane + 512 * j) = r; }
        asm volatile("" ::: "memory");
        if (lane == 0) { t[1] = d0; t[4] = d1; }
    }
}

constexpr int NPHASE = 30;
__global__ void __launch_bounds__(NWAVES * 64, 2) fwd(Args args) {
    extern __shared__ __attribute__((aligned(16))) unsigned char lds[];
    Frame F;
    F.lds = (LAS unsigned char*)lds;
    F.tid = threadIdx.x; F.lane = F.tid & 63; F.wave = __builtin_amdgcn_readfirstlane(F.tid >> 6);
    F.G = gridDim.x; { const int bx = blockIdx.x; F.vcu = (F.G % 8 == 0) ? (bx % 8) * (F.G / 8) + bx / 8 : bx; }
    F.ctl = (gu32*)(args.ws + WS_CTL);
    volatile LAS unsigned* MISC = (volatile LAS unsigned*)(F.lds + MISC_OFF);
    for (int u = F.tid; u < (LDS_BYTES - LDSCTL_OFF) / 4; u += NWAVES * 64) ((LAS unsigned*)(F.lds + LDSCTL_OFF))[u] = 0u;
    __syncthreads();
    XcdBarrier bar; bar.bar = (unsigned*)(F.ctl + CW_BAR); bar.x = 0; bar.st = nullptr;
    const int lo = args.ph_lo, hi = args.ph_hi;
    if (hi - lo > 1) bar = xcd_barrier_post((unsigned*)(F.ctl + CW_BAR), MISC + 8);
#ifndef PHASE_MASK
#define PHASE_MASK 0xffffffffffull
#endif
#define IN(k) ((((unsigned long long)(PHASE_MASK) >> (k)) & 1ull) && lo <= (k) && (k) < hi && (fresh(F), true))
#define SEAM(k) do { if (IN(k) && IN((k) + 1)) xcd_barrier(bar); } while (0)
#ifndef PROBE_MASK
#define PROBE_MASK 0ull
#endif
#ifndef PROBE2_MASK
#define PROBE2_MASK 0
#endif
#define TWICE(bit, stmt) do { stmt; if ((PROBE2_MASK >> (bit)) & 1) { xcd_barrier(bar); stmt; } } while (0)
#define REP(k) for (int rep_ = 0; rep_ < (int)(1 + (((unsigned long long)(PROBE_MASK) >> (k)) & 1ull)); ++rep_, (rep_ < (int)(1 + (((unsigned long long)(PROBE_MASK) >> (k)) & 1ull)) ? xcd_barrier(bar) : (void)0))
#define ws WSB
#define scr ((LAS float*)(F.lds + RING_OFF + F.wave * 16384))
#define HN ((bf16*)(ws + R2_HN))
#define MIX ((bf16*)(ws + R2_MIX))
#define PROJ ((bf16*)(ws + R1_PROJ))
#define VT ((bf16*)(ws + R1_VT))
#define BA ((bf16*)(ws + R1_A))
#define BB ((bf16*)(ws + R1_B))
#define ACT ((bf16*)(ws + R1_ACT))
#define XS ((bf16*)(ws + R2_XS))
#define LOGF ((float*)(ws + WS_LOGF))
#define CCUM ((float*)(ws + WS_CCUM))
#define TOKT ((int*)(ws + WS_TOKT))
#define BLKE ((int*)(ws + WS_BLKE))
#define MN ((bf16*)(ws + WS_MN))
#define XKV ((bf16*)(ws + WS_XKV))
#define XK ((bf16*)(ws + WS_XKV))
#define XVT ((bf16*)(ws + WS_XKV + 2 * MiB))
    const int bx = (int)blockIdx.x;

#define GEMM_PLAIN(Aptr, Btptr, M_, N_, K_, Optr, ldc_) do { pg8::Gemm g{(const pg8::bf16_t*)(Aptr), (const pg8::bf16_t*)(Btptr), (M_), (N_), (K_)}; pg8::StaticOrder S; S.init(g, F.G, bx); \
        pg8::EpiBf16 E{(pg8::bf16_t*)(Optr), (ldc_), 0}; pg8::gemm_phase<pg8::EpiBf16, pg8::StaticOrder, true, true>(F.lds + RING_OFF, (K_), S, E); } while (0)

    if (IN(0)) REP(0) {
        convert_layer_small(F, 0, (bf16*)(ws + WS_WS0), scr);
        convert_layer_small(F, 1, (bf16*)(ws + WS_WS1), scr);
        transpose_gu(F, INP(I_DG), INP(I_DU), (bf16*)(ws + WS_WGU0), scr);
        transpose_mat(F, INP(I_DD), D, 0, D, DFF, (bf16*)(ws + WS_WD0), 0, scr);
        { float* wr = (float*)(ws + WS_WR); for (int i = (F.vcu * NWAVES + F.wave) * 64 + F.lane; i < 8 * D; i += F.G * NWAVES * 64) { const int e = i / D, k = i % D; wr[e * D + k] = INP(I_RW)[(size_t)k * NE + e]; } }
        mem_norm(F, INP(I_MEM), INP(I_MEMN), MN);
    }
    SEAM(0);
    if (IN(1)) REP(1) {
        thin_rows<0, false, true, 1>(F, INP(I_X), nullptr, nullptr, nullptr, INP(I_MIXPRE), HN, (const float*)(ws + WS_WF), INP(I_BF), LOGF, nullptr, nullptr);
    }
    SEAM(1);
#pragma unroll
    for (int l = 0; l < DEPTH; ++l) {
        const int p0 = (l == 0) ? 2 : 15;
        const bf16* WSL = (const bf16*)(ws + (l == 0 ? WS_WS0 : WS_WS1));
        const float* h_res = (l == 0) ? INP(I_X) : OUTP;
        if (IN(p0)) REP(p0) {
            scan_logf(F, LOGF, CCUM);
            GEMM_PLAIN(HN, WSL + OW_IN / 2, NTOK, PP, D, PROJ, PP);
            GEMM_PLAIN(WSL + OW_IN / 2 + (size_t)PP * D, HN, VTN, NTOK, D, VT, VTP);
            GEMM_PLAIN(MN, WSL + OW_KV / 2, NMEM, D, D, XK, D);
            GEMM_PLAIN(WSL + OW_KV / 2 + (size_t)D * D, MN, D, NMEM, D, XVT, NMEM);
        }
        SEAM(p0);
        if (IN(p0 + 1)) REP(p0 + 1) {
            TWICE(0, fox_knorm(F, PROJ, F.ctl + CW_KMAX + l * 24));
            TWICE(1, attn_wg<0>(F, PROJ, VT, nullptr, nullptr, MIX));
            TWICE(2, pool_window(F, PROJ, MIX));
        }
        SEAM(p0 + 1);
        if (IN(p0 + 2)) REP(p0 + 2) {
            attn_wg<1>(F, PROJ, VT, CCUM, F.ctl + CW_KMAX + l * 24, MIX);
        }
        SEAM(p0 + 2);
        if (IN(p0 + 3)) REP(p0 + 3) GEMM_PLAIN(MIX, WSL + OW_OUT / 2, NTOK, D, D, BA, D);
        SEAM(p0 + 3);
        if (IN(p0 + 4)) REP(p0 + 4) thin_rows<1, true, true, 0>(F, h_res, BA, INP(I_MIXPOST) + l * D, OUTP, INP(I_XAPRE) + l * D, HN, nullptr, nullptr, nullptr, nullptr, nullptr);
        SEAM(p0 + 4);
        if (IN(p0 + 5)) REP(p0 + 5) GEMM_PLAIN(HN, WSL + OW_Q / 2, NTOK, D, D, BB, D);
        SEAM(p0 + 5);
        if (IN(p0 + 6)) REP(p0 + 6) xa_mfma(F, BB, XK, XVT, BA);
        SEAM(p0 + 6);
        if (IN(p0 + 7)) REP(p0 + 7) GEMM_PLAIN(BA, WSL + OW_O / 2, NTOK, D, D, BB, D);
        SEAM(p0 + 7);
        if (l == 0) {
            if (IN(10)) REP(10) thin_rows<1, true, true, 0>(F, OUTP, BB, INP(I_XAPOST), OUTP, INP(I_FFPRE), HN, nullptr, nullptr, nullptr, nullptr, nullptr);
            SEAM(10);
            if (IN(11)) REP(11) { pg8::Gemm g{(const pg8::bf16_t*)HN, (const pg8::bf16_t*)(ws + WS_WGU0), NTOK, 2 * DFF, D}; pg8::StaticOrder S; S.init(g, F.G, bx);
                pg8::EpiSwiGLU E{(pg8::bf16_t*)ACT, DFF, 0}; pg8::gemm_phase<pg8::EpiSwiGLU, pg8::StaticOrder, true, true>(F.lds + RING_OFF, D, S, E); }
            SEAM(11);
            if (IN(12)) REP(12) GEMM_PLAIN(ACT, ws + WS_WD0, NTOK, D, DFF, MIX, D);
            SEAM(12);
            if (IN(13)) REP(13) thin_rows<1, true, true, 1>(F, OUTP, MIX, INP(I_FFPOST), OUTP, INP(I_MIXPRE) + D, HN, (const float*)(ws + WS_WF) + 8 * D, INP(I_BF) + NFX, LOGF, nullptr, nullptr);
            SEAM(13);
            if (IN(14)) REP(14) {
                for (int e = 0; e < NE; ++e) {
                    bf16* we = (bf16*)(ws + WS_WMOE + (size_t)e * MOE_E_BYTES);
                    transpose_gu(F, INP(I_MG) + (size_t)e * D * DFF, INP(I_MU) + (size_t)e * D * DFF, we, scr);
                    transpose_mat(F, INP(I_MD) + (size_t)e * DFF * D, D, 0, D, DFF, we + MOE_GU_BYTES / 2, 0, scr);
                }
                mem_norm(F, INP(I_MEM), INP(I_MEMN) + D, MN);
            }
            SEAM(14);
        } else {
            if (IN(23)) REP(23) thin_rows<1, true, true, 2>(F, OUTP, BB, INP(I_XAPOST) + D, OUTP, INP(I_FFPRE) + D, BA, (const float*)(ws + WS_WR), nullptr, nullptr, TOKT, F.ctl + CW_CNT);
            SEAM(23);
            if (IN(24)) REP(24) moe_gather(F, BA, XS, TOKT, BLKE);
            SEAM(24);
#pragma unroll
            for (int ch = 0; ch < 2; ++ch) {
                const int nblk = BLKE[MAXBLK]; const int c0 = ch * CHUNK_BLK, c1 = (nblk < c0 + CHUNK_BLK) ? nblk : c0 + CHUNK_BLK; const int nb = c1 > c0 ? c1 - c0 : 0;
                if (IN(25 + 2 * ch)) REP(25 + 2 * ch) { pg8::MoeOrder S{nb, 2 * DFF / 256, F.G, bx, c0, 0, (const char*)XS, (const char*)(ws + WS_WMOE), (size_t)256 * D * 2, MOE_E_BYTES, BLKE};
                    pg8::EpiSwiGLU E{(pg8::bf16_t*)ACT, DFF, c0}; pg8::gemm_phase<pg8::EpiSwiGLU, pg8::MoeOrder, true, true>(F.lds + RING_OFF, D, S, E); }
                SEAM(25 + 2 * ch);
                if (IN(26 + 2 * ch)) REP(26 + 2 * ch) { pg8::MoeOrder S{nb, D / 256, F.G, bx, c0, c0, (const char*)ACT, (const char*)(ws + WS_WMOE + MOE_GU_BYTES), (size_t)256 * DFF * 2, MOE_E_BYTES, BLKE};
                    pg8::EpiBf16 E{(pg8::bf16_t*)XS, D, 0}; pg8::gemm_phase<pg8::EpiBf16, pg8::MoeOrder, true, true>(F.lds + RING_OFF, DFF, S, E); }
                SEAM(26 + 2 * ch);
            }
            if (IN(29)) REP(29) thin_rows<2, true, false, 0>(F, OUTP, XS, INP(I_FFPOST) + D, OUTP, nullptr, nullptr, nullptr, nullptr, nullptr, TOKT, nullptr);
        }
    }
#undef IN
#undef SEAM
#undef ws
#undef scr
#undef HN
#undef MIX
#undef PROJ
#undef VT
#undef BA
#undef BB
#undef ACT
#undef XS
#undef LOGF
#undef CCUM
#undef TOKT
#undef BLKE
#undef MN
#undef XKV
#undef XK
#undef XVT
}

extern "C" void kernel_launch(void* const* d_in, const int* in_sizes, int n_in, void* d_out, int out_size, void* d_ws, size_t ws_size, hipStream_t stream) {
    static int grid = 0;
    if (grid == 0) {
        if (n_in != 24 || in_sizes[0] != NTOK * D || out_size != NTOK * D || ws_size < WS_END) { fprintf(stderr, "kernel_launch: unexpected shapes / workspace (%d inputs, ws %zu < %zu)\n", n_in, ws_size, (size_t)WS_END); grid = -1; return; }
        int dev = 0, cus = 0, per_cu = 0;
        if (hipGetDevice(&dev) != hipSuccess || hipDeviceGetAttribute(&cus, hipDeviceAttributeMultiprocessorCount, dev) != hipSuccess) { grid = -1; return; }
        if (hipFuncSetAttribute((const void*)fwd, hipFuncAttributeMaxDynamicSharedMemorySize, LDS_BYTES) != hipSuccess) { fprintf(stderr, "kernel_launch: hipFuncSetAttribute failed\n"); grid = -1; return; }
        if (hipOccupancyMaxActiveBlocksPerMultiprocessor(&per_cu, (const void*)fwd, NWAVES * 64, LDS_BYTES) != hipSuccess || per_cu < 1) { fprintf(stderr, "kernel_launch: occupancy query reports %d\n", per_cu); }
        (void)hipGetLastError();
        grid = cus;
    }
    if (grid < 0) return;
    (void)hipMemsetAsync((char*)d_ws + WS_CTL, 0, CTL_ZERO_BYTES, stream);
    Args a{};
    for (int i = 0; i < 24; ++i) a.in[i] = (const float*)d_in[i];
    a.out = (float*)d_out; a.ws = (unsigned char*)d_ws;
#if MK_ONE_LAUNCH
    a.ph_lo = 0; a.ph_hi = NPHASE;
    hipLaunchKernelGGL(fwd, dim3(grid), dim3(NWAVES * 64), LDS_BYTES, stream, a);
#else
    for (int p = 0; p < NPHASE; ++p) {
        a.ph_lo = p; a.ph_hi = p + 1;
        hipLaunchKernelGGL(fwd, dim3(grid), dim3(NWAVES * 64), LDS_BYTES, stream, a);
    }
#endif
}
```

```cpp
#include <hip/hip_runtime.h>
#include <cstdio>
#include <cstdint>

#ifndef MK_ONE_LAUNCH
#define MK_ONE_LAUNCH 1
#endif

namespace pg8 {
#define PG8_LAS __attribute__((address_space(3)))
typedef unsigned short bf16_t;
typedef short bf16x8 __attribute__((ext_vector_type(8)));
typedef float f32x4 __attribute__((ext_vector_type(4)));
typedef unsigned u32x4 __attribute__((ext_vector_type(4)));
constexpr int BM = 256, BK = 64, HALF = 128, HTB = HALF * BK * 2  , STAGE_BYTES = 8 * HTB, NXCD = 8, WGM = 8;

__host__ __device__ __forceinline__ int lds_byte(int r, int c) { const int st = (r >> 4) * 2 + (c >> 5), rr = r & 15, cc = c & 31, ob = rr * 64 + cc * 2; return st * 1024 + (ob ^ (((ob >> 9) & 1) << 5)); }
__host__ __device__ __forceinline__ void stage_rc(int b, int& R, int& C) { const int st = b / 1024, sb = b % 1024, swz = sb ^ (((sb >> 9) & 1) << 5); R = (st >> 1) * 16 + swz / 64; C = (st & 1) * 32 + (swz % 64) / 2; }
__host__ __device__ __forceinline__ int perm32(int rho) { const int n = rho >> 4, i = rho & 15; return 8 * (i >> 2) + 4 * n + (i & 3); }

struct Unit { int pm, pn; const char* a; const char* b; };
struct Gemm { const bf16_t* A; const bf16_t* Bt; int M, N, K; };

__device__ __forceinline__ bool order_map(int i, int G, int c, int nM, int nN, int& pm, int& pn) {
    const int nwg = nM * nN; const long L = (long)i * G + c; if (L >= nwg) return false;
    int wgid = (int)L; { const int q = nwg / NXCD, r = nwg % NXCD, xcd = wgid % NXCD, off = wgid / NXCD; wgid = (xcd < r ? xcd * (q + 1) : r * (q + 1) + (xcd - r) * q) + off; }
    const int nig = WGM * nN, gid = wgid / nig, fm = gid * WGM, gsz = (nM - fm) < WGM ? (nM - fm) : WGM;
    pm = fm + ((wgid % nig) % gsz); pn = (wgid % nig) / gsz; return true;
}
struct StaticOrder {
    int nM, nN, G, c; const char* A; const char* B; size_t tstep;
    __device__ void init(const Gemm& g, int G_, int c_) { nM = g.M / BM; nN = g.N / BM; G = G_; c = c_; A = (const char*)g.A; B = (const char*)g.Bt; tstep = (size_t)BM * g.K * 2; }
    __device__ __forceinline__ bool next(int i, Unit& u) const {
        if (!order_map(i, G, c, nM, nN, u.pm, u.pn)) return false;
        u.a = A + (size_t)u.pm * tstep; u.b = B + (size_t)u.pn * tstep; return true;
    }
};
struct MoeOrder {
    int nM, nN, G, c, pb0, pbA; const char* A; const char* W; size_t tstep, wstride; const int* blk_e;
    __device__ __forceinline__ bool next(int i, Unit& u) const {
        int pm, pn; if (!order_map(i, G, c, nM, nN, pm, pn)) return false;
        u.pm = pb0 + pm; u.pn = pn; const int e = blk_e[u.pm];
        u.a = A + (size_t)(u.pm - pbA) * tstep; u.b = W + (size_t)e * wstride + (size_t)pn * tstep; return true;
    }
};

__device__ __forceinline__ unsigned cvt_pk_bf16(float lo, float hi) { unsigned r; asm volatile("v_cvt_pk_bf16_f32 %0, %1, %2" : "=v"(r) : "v"(lo), "v"(hi)); return r; }

struct EpiBf16 {
    static constexpr bool PERM = true;
    bf16_t* O; int ldc; int pm_off;
    __device__ __forceinline__ void operator()(const f32x4 (&acc)[2][2][4][2], const Unit& u, int wr, int wc, int fr, int fq) const {
        const int row0 = (u.pm - pm_off) * BM + wr * 64 + fr; const int col0 = u.pn * BM + wc * 32 + 8 * fq;
#pragma unroll
        for (int ai = 0; ai < 2; ++ai)
#pragma unroll
            for (int m = 0; m < 4; ++m) { bf16_t* rowp = O + (size_t)(row0 + ai * HALF + m * 16) * ldc + col0;
#pragma unroll
                for (int bj = 0; bj < 2; ++bj) { const f32x4 v0 = acc[ai][bj][m][0], v1 = acc[ai][bj][m][1];
                    u32x4 w; w.x = cvt_pk_bf16(v0[0], v0[1]); w.y = cvt_pk_bf16(v0[2], v0[3]); w.z = cvt_pk_bf16(v1[0], v1[1]); w.w = cvt_pk_bf16(v1[2], v1[3]);
                    *(u32x4*)(rowp + bj * HALF) = w; } }
    }
};
__device__ __forceinline__ float silu_mul(float g, float u) { return g * __builtin_amdgcn_rcpf(1.0f + __expf(-g)) * u; }
struct EpiSwiGLU {
    static constexpr bool PERM = true;
    bf16_t* O; int ldc; int pm_off;
    __device__ __forceinline__ void operator()(const f32x4 (&acc)[2][2][4][2], const Unit& u, int wr, int wc, int fr, int fq) const {
        const int row0 = (u.pm - pm_off) * BM + wr * 64 + fr; const int col0 = u.pn * HALF + wc * 32 + 8 * fq;
#pragma unroll
        for (int ai = 0; ai < 2; ++ai)
#pragma unroll
            for (int m = 0; m < 4; ++m) { bf16_t* rowp = O + (size_t)(row0 + ai * HALF + m * 16) * ldc + col0;
                const f32x4 g0 = acc[ai][0][m][0], g1 = acc[ai][0][m][1], u0 = acc[ai][1][m][0], u1 = acc[ai][1][m][1];
                u32x4 w; w.x = cvt_pk_bf16(silu_mul(g0[0], u0[0]), silu_mul(g0[1], u0[1])); w.y = cvt_pk_bf16(silu_mul(g0[2], u0[2]), silu_mul(g0[3], u0[3]));
                w.z = cvt_pk_bf16(silu_mul(g1[0], u1[0]), silu_mul(g1[1], u1[1])); w.w = cvt_pk_bf16(silu_mul(g1[2], u1[2]), silu_mul(g1[3], u1[3]));
                *(u32x4*)rowp = w; }
    }
};

template <class Epi, class Sched, bool ALIGN_EPI = false, bool SP2 = false>
__device__ __forceinline__ void gemm_phase(PG8_LAS unsigned char* lds, const int K, const Sched& S, const Epi& E) {
    int tid_ = threadIdx.x; asm volatile("" : "+v"(tid_));
    const int tid = tid_, wid = __builtin_amdgcn_readfirstlane(tid >> 6), lane = tid & 63, wr = wid >> 2, wc = wid & 3, fr = lane & 15, fq = lane >> 4;
    const int nt = K / BK;
    unsigned voffA[2], voffB[2];
#pragma unroll
    for (int i = 0; i < 2; ++i) { int R, C; stage_rc(tid * 16 + i * 8192, R, C); const int Rb = Epi::PERM ? ((R & ~31) + perm32(R & 31)) : R;
        voffA[i] = (unsigned)(R * K + C) * 2u; voffB[i] = (unsigned)(Rb * K + C) * 2u; }
    const size_t kstep = (size_t)(BK * 2);
    const size_t hstep = (size_t)HALF * K * 2;
    const unsigned ldsw = (unsigned)wid * 1024u;
    const int aoff = lds_byte(wr * 64 + fr, fq * 8), boff = lds_byte(wc * 32 + fr, fq * 8);
#define PG8_SA(b, h) (((b) * 2 + (h)) * HTB)
#define PG8_SB(b, h) ((4 + (b) * 2 + (h)) * HTB)
#define PG8_STAGE(bufoff, gbase, voff) do { _Pragma("unroll") for (int _i = 0; _i < 2; ++_i) \
        __builtin_amdgcn_global_load_lds((const unsigned*)((const char*)(gbase) + (voff)[_i]), (PG8_LAS unsigned*)(lds + (bufoff) + ldsw + _i * 8192), 16, 0, 0); } while (0)
#define PG8_LDA(dst, b, h) do { _Pragma("unroll") for (int m = 0; m < 4; ++m) _Pragma("unroll") for (int k = 0; k < 2; ++k) dst[m][k] = *(const PG8_LAS bf16x8*)(lds + PG8_SA(b, h) + aoff + m * 2048 + k * 1024); } while (0)
#define PG8_LDB(dst, b, h) do { _Pragma("unroll") for (int n = 0; n < 2; ++n) _Pragma("unroll") for (int k = 0; k < 2; ++k) dst[n][k] = *(const PG8_LAS bf16x8*)(lds + PG8_SB(b, h) + boff + n * 2048 + k * 1024); } while (0)
#define PG8_MMA(ai, bj, At, Bt) do { __builtin_amdgcn_s_setprio(1); _Pragma("unroll") for (int m = 0; m < 4; ++m) _Pragma("unroll") for (int n = 0; n < 2; ++n) _Pragma("unroll") for (int k = 0; k < 2; ++k) \
        acc[ai][bj][m][n] = __builtin_amdgcn_mfma_f32_16x16x32_bf16(Bt[n][k], At[m][k], acc[ai][bj][m][n], 0, 0, 0); __builtin_amdgcn_s_setprio(0); } while (0)
#define PG8_WAIT_V(n) asm volatile("s_waitcnt vmcnt(" #n ")" ::: "memory")
#define PG8_WAIT_L(n) asm volatile("s_waitcnt lgkmcnt(" #n ")" ::: "memory")
#define PG8_BAR __builtin_amdgcn_s_barrier()
#define PG8_SCHED __builtin_amdgcn_sched_barrier(0)
    Unit cur, nxt; int ui = 0;
    if (!S.next(0, cur)) return;
    f32x4 acc[2][2][4][2];
#pragma unroll
    for (int a = 0; a < 2; ++a)
#pragma unroll
        for (int b = 0; b < 2; ++b)
#pragma unroll
            for (int m = 0; m < 4; ++m)
#pragma unroll
                for (int n = 0; n < 2; ++n) acc[a][b][m][n] = (f32x4){0.f, 0.f, 0.f, 0.f};
    bf16x8 At[4][2], B0[2][2], B1[2][2];
    const char* cA = cur.a; const char* cB = cur.b;
    if constexpr (SP2) {
        PG8_STAGE(PG8_SB(0, 0), cB, voffB); PG8_STAGE(PG8_SB(0, 1), cB + hstep, voffB); PG8_STAGE(PG8_SA(0, 0), cA, voffA); PG8_STAGE(PG8_SA(0, 1), cA + hstep, voffA);
        if (wr == 1) PG8_BAR;
        PG8_WAIT_V(2); PG8_BAR;
        PG8_STAGE(PG8_SB(1, 0), cB + kstep, voffB); PG8_STAGE(PG8_SA(1, 0), cA + kstep, voffA); PG8_STAGE(PG8_SB(1, 1), cB + hstep + kstep, voffB);
        PG8_WAIT_V(6); PG8_BAR;
    } else {
        PG8_STAGE(PG8_SB(0, 0), cB, voffB); PG8_STAGE(PG8_SA(0, 0), cA, voffA); PG8_STAGE(PG8_SB(0, 1), cB + hstep, voffB); PG8_STAGE(PG8_SA(0, 1), cA + hstep, voffA);
        if (wr == 1) PG8_BAR;
        PG8_WAIT_V(4); PG8_BAR;
        PG8_STAGE(PG8_SB(1, 0), cB + kstep, voffB); PG8_STAGE(PG8_SA(1, 0), cA + kstep, voffA); PG8_STAGE(PG8_SB(1, 1), cB + hstep + kstep, voffB);
        PG8_WAIT_V(6); PG8_BAR;
    }
    for (;;) {
        const bool has_next = S.next(ui + 1, nxt);
        const char* nA = has_next ? nxt.a : cA; const char* nB = has_next ? nxt.b : cB;
        for (int t = 0; t < nt; t += 2) {
            const bool last = (t == nt - 2);
            const char* a1 = cA + (size_t)(t + 1) * kstep;
            const char* a2 = last ? nA : cA + (size_t)(t + 2) * kstep; const char* b2 = last ? nB : cB + (size_t)(t + 2) * kstep;
            const char* a3 = a2 + kstep; const char* b3 = b2 + kstep;
            if constexpr (SP2) {
            PG8_LDB(B0, 0, 0); PG8_LDB(B1, 0, 1); PG8_SCHED; PG8_LDA(At, 0, 0); PG8_STAGE(PG8_SA(1, 1), a1 + hstep, voffA);
            PG8_WAIT_V(8); PG8_WAIT_L(0); PG8_BAR; PG8_MMA(0, 0, At, B0); PG8_MMA(0, 1, At, B1); PG8_BAR; PG8_SCHED;
            PG8_LDA(At, 0, 1); PG8_STAGE(PG8_SB(0, 0), b2, voffB); PG8_STAGE(PG8_SB(0, 1), b2 + hstep, voffB); PG8_STAGE(PG8_SA(0, 0), a2, voffA);
            PG8_WAIT_V(8); PG8_WAIT_L(0); PG8_BAR; PG8_MMA(1, 0, At, B0); PG8_MMA(1, 1, At, B1); PG8_BAR; PG8_SCHED;
            PG8_LDB(B0, 1, 0); PG8_LDB(B1, 1, 1); PG8_SCHED; PG8_LDA(At, 1, 0); PG8_STAGE(PG8_SA(0, 1), a2 + hstep, voffA);
            PG8_WAIT_V(8); PG8_WAIT_L(0); PG8_BAR; PG8_MMA(0, 0, At, B0); PG8_MMA(0, 1, At, B1); PG8_BAR; PG8_SCHED;
            PG8_LDA(At, 1, 1); PG8_STAGE(PG8_SB(1, 0), b3, voffB); PG8_STAGE(PG8_SB(1, 1), b3 + hstep, voffB); PG8_STAGE(PG8_SA(1, 0), a3, voffA);
            PG8_WAIT_V(8); PG8_WAIT_L(0); PG8_BAR; PG8_MMA(1, 0, At, B0); PG8_MMA(1, 1, At, B1); PG8_BAR; PG8_SCHED;
            } else {
            PG8_LDB(B0, 0, 0); PG8_SCHED; PG8_LDA(At, 0, 0); PG8_STAGE(PG8_SA(1, 1), a1 + hstep, voffA);
            PG8_WAIT_L(8); PG8_BAR; PG8_WAIT_L(0); PG8_MMA(0, 0, At, B0); PG8_BAR; PG8_SCHED;
            PG8_LDB(B1, 0, 1); PG8_STAGE(PG8_SB(0, 0), b2, voffB);
            PG8_BAR; PG8_WAIT_L(0); PG8_MMA(0, 1, At, B1); PG8_BAR;
            PG8_LDA(At, 0, 1); PG8_STAGE(PG8_SA(0, 0), a2, voffA);
            PG8_BAR; PG8_WAIT_L(0); PG8_MMA(1, 0, At, B0); PG8_BAR; PG8_SCHED;
            PG8_STAGE(PG8_SB(0, 1), b2 + hstep, voffB);
            PG8_WAIT_V(6); PG8_BAR; PG8_MMA(1, 1, At, B1); PG8_BAR;
            PG8_LDB(B0, 1, 0); PG8_SCHED; PG8_LDA(At, 1, 0); PG8_STAGE(PG8_SA(0, 1), a2 + hstep, voffA);
            PG8_WAIT_L(8); PG8_BAR; PG8_WAIT_L(0); PG8_MMA(0, 0, At, B0); PG8_BAR; PG8_SCHED;
            PG8_LDB(B1, 1, 1); PG8_STAGE(PG8_SB(1, 0), b3, voffB);
            PG8_BAR; PG8_WAIT_L(0); PG8_MMA(0, 1, At, B1); PG8_BAR;
            PG8_LDA(At, 1, 1); PG8_STAGE(PG8_SA(1, 0), a3, voffA);
            PG8_BAR; PG8_WAIT_L(0); PG8_MMA(1, 0, At, B0); PG8_BAR; PG8_SCHED;
            PG8_STAGE(PG8_SB(1, 1), b3 + hstep, voffB);
            PG8_WAIT_V(6); PG8_BAR; PG8_MMA(1, 1, At, B1); PG8_BAR;
            }
        }
        if constexpr (ALIGN_EPI) { if (wr == 0) PG8_BAR; }
        E(acc, cur, wr, wc, fr, fq);
        if (!has_next) break;
#pragma unroll
        for (int a = 0; a < 2; ++a)
#pragma unroll
            for (int b = 0; b < 2; ++b)
#pragma unroll
                for (int m = 0; m < 4; ++m)
#pragma unroll
                    for (int n = 0; n < 2; ++n) acc[a][b][m][n] = (f32x4){0.f, 0.f, 0.f, 0.f};
        cur = nxt; cA = nA; cB = nB; ++ui;
        if constexpr (ALIGN_EPI) { if (wr == 1) PG8_BAR; }
    }
    PG8_WAIT_V(0);
    if constexpr (!ALIGN_EPI) { if (wr == 0) PG8_BAR; }
    PG8_BAR;
#undef PG8_SA
#undef PG8_SB
#undef PG8_STAGE
#undef PG8_LDA
#undef PG8_LDB
#undef PG8_MMA
#undef PG8_WAIT_V
#undef PG8_WAIT_L
#undef PG8_BAR
#undef PG8_SCHED
}
}

constexpr int NBATCH = 4, SEQ = 8192, D = 1024, NTOK = NBATCH * SEQ, DEPTH = 2;
constexpr int HD = 64, NSB = 6, NFX = 6, SBD = 384, FXD = 384, POOLD = 256, CIN = 2566;
constexpr int MEML = 256, NMEM = NBATCH * MEML, XAH = 4, XAD = 256;
constexpr int DFF = 2816, NE = 8;
constexpr float EPS = 1e-6f;
constexpr int PP = 1792, C_SQ = 0, C_SK = 384, C_FQ = 768, C_FK = 1152, C_U = 1536;
constexpr int VTN = 768, VTP = NTOK + 2112;
constexpr int MAXBLK = 264, CHUNK_BLK = 132;

constexpr size_t MiB = 1u << 20;
constexpr size_t WS_CTL = 0, CTL_ZERO_BYTES = 1 * MiB;
constexpr size_t WS_WF   = 1 * MiB;
constexpr size_t WS_WR   = WS_WF + 65536;
constexpr size_t WS_BLKE = WS_WR + 32768;
constexpr size_t WS_LOGF = 2 * MiB;
constexpr size_t WS_CCUM = 3 * MiB;
constexpr size_t WS_TOKT = 4 * MiB;
constexpr size_t WS_MN   = 5 * MiB;
constexpr size_t WS_XKV  = 7 * MiB;
constexpr size_t WS_WS1  = 16 * MiB;
constexpr size_t WS_WMOE = 31 * MiB;
constexpr size_t WS_R2   = 163 * MiB;
constexpr size_t WS_R1   = 295 * MiB;
constexpr size_t WS_END  = 295 * MiB + 190316544;
constexpr size_t OW_IN = 0, OW_OUT = 5 * MiB, OW_Q = 7 * MiB, OW_KV = 9 * MiB, OW_O = 13 * MiB, OW_LAYER = 15 * MiB;
constexpr size_t WS_WS0 = WS_WMOE;
constexpr size_t WS_WGU0 = WS_WS0 + OW_LAYER;
constexpr size_t WS_WD0 = WS_WGU0 + 11 * MiB;
constexpr size_t MOE_GU_BYTES = (size_t)2 * DFF * D * 2, MOE_D_BYTES = (size_t)D * DFF * 2, MOE_E_BYTES = MOE_GU_BYTES + MOE_D_BYTES;
static_assert(WS_WD0 + MOE_D_BYTES <= WS_WMOE + 132 * MiB && 8 * MOE_E_BYTES <= 132 * MiB, "weights map");
constexpr size_t R2_HN = WS_R2, R2_MIX = WS_R2 + 64 * MiB;
constexpr size_t R1_PROJ = WS_R1;
constexpr size_t R1_VT = WS_R1 + 112 * MiB;
constexpr size_t R1_A = WS_R1, R1_B = WS_R1 + 64 * MiB;
constexpr size_t R1_ACT = WS_R1;
constexpr size_t R2_XS = WS_R2;
static_assert((size_t)NTOK * DFF * 2 <= 190316544 && (size_t)CHUNK_BLK * 256 * DFF * 2 <= 190316544 && (size_t)MAXBLK * 256 * D * 2 <= 132 * MiB, "arena map");
constexpr int CW_CNT = 64;
constexpr int CW_KMAX = 128;
constexpr int CW_BAR = 4096;

constexpr int RING_OFF = 0, RING_BYTES = 131072;
constexpr int LDSCTL_OFF = RING_BYTES, MISC_OFF = LDSCTL_OFF + 320;
constexpr int LDS_BYTES = 147456;
constexpr int NWAVES = 8;

#define GAS __attribute__((address_space(1)))
#define LAS __attribute__((address_space(3)))
typedef unsigned short bf16;
typedef unsigned v4u __attribute__((ext_vector_type(4)));
typedef unsigned v2u __attribute__((ext_vector_type(2)));
typedef float f32x4 __attribute__((ext_vector_type(4)));
typedef GAS unsigned gu32;
#define RLX_AGENT __ATOMIC_RELAXED, __HIP_MEMORY_SCOPE_AGENT
#define LDS_WAIT() asm volatile("s_waitcnt lgkmcnt(0)" ::: "memory")
#define VM_WAIT() asm volatile("s_waitcnt vmcnt(0)" ::: "memory")
__device__ __forceinline__ unsigned f2bf(float f) { unsigned u = __builtin_bit_cast(unsigned, f); return (u + 0x7fffu + ((u >> 16) & 1u)) >> 16; }
__device__ __forceinline__ unsigned pk2(float lo, float hi) { return f2bf(lo) | (f2bf(hi) << 16); }
__device__ __forceinline__ float bflo(unsigned u) { return __uint_as_float(u << 16); }
__device__ __forceinline__ float bfhi(unsigned u) { return __uint_as_float(u & 0xffff0000u); }
__device__ __forceinline__ float bf2f(bf16 b) { return __uint_as_float(((unsigned)b) << 16); }

#define XB_TMO      128
#define XB_XCNT(j)  (256  + 64 * (j))
#define XB_XSUB(j)  (1280 + 64 * (j))
#define XB_XGEN(j)  (2304 + 64 * (j))
#define XB_TOP      3328
#define XB_TOPGEN   3392
#define XCD_BAR_WORDS 3456
#define XB_SPIN_CAP (1u << 22)

__device__ __forceinline__ unsigned xb_ld(unsigned* p)              { return __hip_atomic_load(p, __ATOMIC_RELAXED, __HIP_MEMORY_SCOPE_AGENT); }
__device__ __forceinline__ unsigned xb_add(unsigned* p, unsigned v) { return __hip_atomic_fetch_add(p, v, __ATOMIC_RELAXED, __HIP_MEMORY_SCOPE_AGENT); }
__device__ __forceinline__ unsigned xb_xcc_id() { return (unsigned)__builtin_amdgcn_s_getreg((3 << 11) | 20) & 0xFu; }
#define XB_SPIN(cond, bar) do { unsigned _sp = 0; while (cond) { __builtin_amdgcn_s_sleep(1); \
    if ((++_sp & 255u) == 0u) { if (xb_ld(&(bar)[XB_TMO])) break; if (_sp > XB_SPIN_CAP) { atomicAdd(&(bar)[XB_TMO], 1u); break; } } } } while (0)

struct XcdBarrier { unsigned* bar; unsigned x; volatile LAS unsigned* st; };

__device__ __forceinline__ XcdBarrier xcd_barrier_post(unsigned* bar, volatile LAS unsigned* st) {
    XcdBarrier b; b.bar = bar; b.x = xb_xcc_id(); b.st = st;
    if (threadIdx.x == 0) (void)xb_add(&bar[XB_XCNT(b.x)], 1u);
    return b;
}
__device__ __forceinline__ void xcd_barrier_complete(unsigned* bar, unsigned x, unsigned& nloc, unsigned& nx) {
    const unsigned G = gridDim.x * gridDim.y * gridDim.z;
    unsigned sum, cnt, mine, sp = 0u;
    for (;;) {
        sum = 0u; cnt = 0u; mine = 0u;
#pragma unroll
        for (unsigned j = 0; j < 16; ++j) { const unsigned c = xb_ld(&bar[XB_XCNT(j)]); sum += c; cnt += (c > 0u) ? 1u : 0u; mine = (j == x) ? c : mine; }
        if (sum == G) break;
        __builtin_amdgcn_s_sleep(1);
        if ((++sp & 255u) == 0u) { if (xb_ld(&bar[XB_TMO])) break; if (sp > XB_SPIN_CAP) { atomicAdd(&bar[XB_TMO], 1u); break; } }
    }
    nloc = mine > 0u ? mine : 1u; nx = cnt > 0u ? cnt : 1u;
}
__device__ __forceinline__ void xcd_barrier(const XcdBarrier& b) {
    asm volatile("s_waitcnt vmcnt(0)" ::: "memory");
    __syncthreads();
    if (threadIdx.x == 0) {
        unsigned* bar = b.bar;
        __builtin_amdgcn_s_waitcnt(0);
        unsigned nloc = b.st[0], nx = b.st[1];
        if (nloc == 0u) { xcd_barrier_complete(bar, b.x, nloc, nx); b.st[0] = nloc; b.st[1] = nx; }
        const unsigned old = xb_add(&bar[XB_XSUB(b.x)], 1u);
        const unsigned gen = old / nloc;
        if (old + 1u == (gen + 1u) * nloc) {
            __builtin_amdgcn_fence(__ATOMIC_RELEASE, "agent");
            asm volatile("s_waitcnt vmcnt(0)" ::: "memory");
            const unsigned og = xb_add(&bar[XB_TOP], 1u);
            const unsigned tg = og / nx;
            if (og + 1u == (tg + 1u) * nx) xb_add(&bar[XB_TOPGEN], 1u);
            else XB_SPIN(xb_ld(&bar[XB_TOPGEN]) == tg, bar);
            __builtin_amdgcn_fence(__ATOMIC_ACQUIRE, "agent");
            xb_add(&bar[XB_XGEN(b.x)], 1u);
            asm volatile("s_waitcnt vmcnt(0)" ::: "memory");
        } else {
            XB_SPIN(xb_ld(&bar[XB_XGEN(b.x)]) == gen, bar);
            __builtin_amdgcn_fence(__ATOMIC_ACQUIRE, "agent");
            asm volatile("s_waitcnt vmcnt(0)" ::: "memory");
        }
    }
    __syncthreads();
}

enum In { I_X = 0, I_MEM, I_MIXPRE, I_MIXPOST, I_WIN, I_BF, I_POOLW, I_POOLS, I_WOUT, I_XAPRE, I_XAPOST, I_MEMN, I_XQ, I_XKV, I_XO, I_FFPRE, I_FFPOST,
          I_DG, I_DU, I_DD, I_RW, I_MG, I_MU, I_MD };

struct Args { const float* in[24]; float* out; unsigned char* ws; int ph_lo, ph_hi; };
__device__ __forceinline__ const __attribute__((address_space(4))) Args* kargs() { const __attribute__((address_space(4))) Args* p = (const __attribute__((address_space(4))) Args*)__builtin_amdgcn_kernarg_segment_ptr(); asm volatile("" : "+s"(p)); return p; }
#define WSB (kargs()->ws)
#define INP(i) (kargs()->in[i])
#define OUTP (kargs()->out)
struct Frame {
    LAS unsigned char* lds;
    gu32* ctl;
    int tid, lane, wave;
    int vcu, G, roff;
};


__device__ __forceinline__ void fresh(Frame& F) { int t = threadIdx.x; asm volatile("" : "+v"(t)); F.tid = t; F.lane = t & 63; F.wave = __builtin_amdgcn_readfirstlane(t >> 6); }
__device__ __forceinline__ float wave_sum(float v) {
#pragma unroll
    for (int o = 1; o < 64; o <<= 1) v += __shfl_xor(v, o);
    return v;
}
__device__ __forceinline__ float wave_max(float v) {
#pragma unroll
    for (int o = 1; o < 64; o <<= 1) v = fmaxf(v, __shfl_xor(v, o));
    return v;
}
__device__ __forceinline__ float log_sigmoid(float x) { return x < 0.f ? x - log1pf(__expf(x)) : -log1pf(__expf(-x)); }

template <bool GU>
__device__ __forceinline__ void conv_item4(const float* W, int ldw, int n, int k0, bf16* WT, int K, int row0, int which) {
    const int rb = GU ? (256 * (n >> 7) + 128 * which + (n & 127)) : (row0 + n);
#pragma unroll
    for (int kk = 0; kk < 32; kk += 8) {
        f32x4 f[8];
#pragma unroll
        for (int i = 0; i < 8; ++i) f[i] = *(const f32x4*)(W + (size_t)(k0 + kk + i) * ldw + n);
#pragma unroll
        for (int j = 0; j < 4; ++j) { v4u o; o.x = pk2(f[0][j], f[1][j]); o.y = pk2(f[2][j], f[3][j]); o.z = pk2(f[4][j], f[5][j]); o.w = pk2(f[6][j], f[7][j]);
            *(v4u*)(WT + (size_t)(rb + j) * K + k0 + kk) = o; }
    }
}
__device__ __forceinline__ void conv_item1(const float* W, int ldw, int col, int k0, bf16* WT, int K, int row) {
#pragma unroll
    for (int kk = 0; kk < 32; kk += 8) {
        float f[8];
#pragma unroll
        for (int i = 0; i < 8; ++i) f[i] = W[(size_t)(k0 + kk + i) * ldw + col];
        v4u o; o.x = pk2(f[0], f[1]); o.y = pk2(f[2], f[3]); o.z = pk2(f[4], f[5]); o.w = pk2(f[6], f[7]);
        *(v4u*)(WT + (size_t)row * K + k0 + kk) = o;
    }
}
__device__ __forceinline__ int conv_first(Frame& F, int nitems) {
    const int gw = F.vcu * NWAVES + F.wave, NGW = F.G * NWAVES; int it = gw - F.roff; if (it < 0) it += NGW; F.roff = (F.roff + nitems) % NGW; return it;
}
__device__ __forceinline__ void transpose_mat(Frame& F, const float* W, int ldw, int col0, int ncols, int K, bf16* WT, int row0, LAS float* scr) {
    (void)scr; const int NGW = F.G * NWAVES, nkb = K / 32;
    if ((ldw & 3) == 0 && (col0 & 3) == 0 && (ncols & 255) == 0) {
        const int nitems = nkb * (ncols / 256);
        for (int it = conv_first(F, nitems); it < nitems; it += NGW) { const int kb = it % nkb, nb = it / nkb; conv_item4<false>(W + col0, ldw, 256 * nb + 4 * F.lane, 32 * kb, WT, K, row0, 0); }
    } else {
        const int nitems = nkb * (ncols / 64);
        for (int it = conv_first(F, nitems); it < nitems; it += NGW) { const int kb = it % nkb, nb = it / nkb; conv_item1(W, ldw, col0 + 64 * nb + F.lane, 32 * kb, WT, K, row0 + 64 * nb + F.lane); }
    }
}
__device__ __forceinline__ void transpose_gu(Frame& F, const float* Wg, const float* Wu, bf16* WT, LAS float* scr) {
    (void)scr; const int NGW = F.G * NWAVES, nkb = D / 32, ncb = DFF / 256, nitems = 2 * nkb * ncb;
    for (int it = conv_first(F, nitems); it < nitems; it += NGW) { const int kb = it % nkb, r = it / nkb, nb = r % ncb, which = r / ncb;
        conv_item4<true>(which ? Wu : Wg, DFF, 256 * nb + 4 * F.lane, 32 * kb, WT, D, 0, which); }
}
__device__ __forceinline__ void convert_layer_small(Frame& F, int l, bf16* base, LAS float* scr) {
    const float* win = INP(I_WIN) + (size_t)l * D * CIN;
    bf16* wt = base + OW_IN / 2;
    transpose_mat(F, win, CIN, 0, 768, D, wt, 0, scr);
    transpose_mat(F, win, CIN, 1152, 768, D, wt, 768, scr);
    { const float* pw = INP(I_POOLW) + (size_t)l * 4 * 4096; const float* psc = INP(I_POOLS) + (size_t)l * POOLD;
      for (int i = (F.vcu * NWAVES + F.wave) * 64 + F.lane; i < POOLD * D; i += F.G * NWAVES * 64) { const int n = i / D, k = i % D, g = n >> 6, co = n & 63;
          const float* wr = win + (size_t)k * CIN + 2310 + g * 64; const float* pc = pw + g * 4096 + co; float acc = 0.f;
#pragma unroll 8
          for (int ci = 0; ci < 64; ++ci) acc += wr[ci] * pc[ci * 64];
          wt[(size_t)(1536 + n) * D + k] = (bf16)f2bf(acc * psc[n]); } }
    transpose_mat(F, win, CIN, 768, 384, D, wt, 1792, scr);
    transpose_mat(F, win, CIN, 1920, 384, D, wt, 2176, scr);
    transpose_mat(F, INP(I_WOUT) + (size_t)l * D * D, D, 0, D, D, base + OW_OUT / 2, 0, scr);
    transpose_mat(F, INP(I_XQ) + (size_t)l * D * D, D, 0, D, D, base + OW_Q / 2, 0, scr);
    transpose_mat(F, INP(I_XKV) + (size_t)l * D * 2 * D, 2 * D, 0, 2 * D, D, base + OW_KV / 2, 0, scr);
    transpose_mat(F, INP(I_XO) + (size_t)l * D * D, D, 0, D, D, base + OW_O / 2, 0, scr);
    float* wf = (float*)(WSB + WS_WF) + (size_t)l * 8 * D;
    for (int i = (F.vcu * NWAVES + F.wave) * 64 + F.lane; i < 6 * D; i += F.G * NWAVES * 64) { const int j = i / D, k = i % D; wf[j * D + k] = win[(size_t)k * CIN + 2304 + j]; }
}

#define DPP_ADD(v, ctrl) ((v) + __int_as_float(__builtin_amdgcn_update_dpp(0, __float_as_int(v), (ctrl), 0xf, 0xf, false)))
__device__ __forceinline__ float wave_sum_fast(float v) {
    v = DPP_ADD(v, 0xB1); v = DPP_ADD(v, 0x4E); v = DPP_ADD(v, 0x141); v = DPP_ADD(v, 0x140);
    const int iv = __float_as_int(v);
    return (__int_as_float(__builtin_amdgcn_readlane(iv, 0)) + __int_as_float(__builtin_amdgcn_readlane(iv, 16))) + (__int_as_float(__builtin_amdgcn_readlane(iv, 32)) + __int_as_float(__builtin_amdgcn_readlane(iv, 48)));
}
struct ThinIn { f32x4 v[4]; v2u d0[4]; v2u d1[4]; float g0, g1; };
template <int DELTA>
__device__ __forceinline__ void thin_load(ThinIn& t, int row, int lane, const float* h_in, const bf16* delta, const int* tokt) {
#pragma unroll
    for (int j = 0; j < 4; ++j) t.v[j] = *(const f32x4*)(h_in + (size_t)row * D + 4 * lane + 256 * j);
    if constexpr (DELTA == 1) {
#pragma unroll
        for (int j = 0; j < 4; ++j) t.d0[j] = *(const v2u*)(delta + (size_t)row * D + 4 * lane + 256 * j);
    }
    if constexpr (DELTA == 2) {
        const int r0 = tokt[row * 8 + 1], r1 = tokt[row * 8 + 4]; t.g0 = __int_as_float(tokt[row * 8 + 2]); t.g1 = __int_as_float(tokt[row * 8 + 5]);
#pragma unroll
        for (int j = 0; j < 4; ++j) { t.d0[j] = *(const v2u*)(delta + (size_t)r0 * D + 4 * lane + 256 * j); t.d1[j] = *(const v2u*)(delta + (size_t)r1 * D + 4 * lane + 256 * j); }
    }
}
template <int DELTA, bool WRITE_H, bool WRITE_HN, int EXTRA>
__device__ __forceinline__ void thin_rows(Frame& F, const float* h_in, const bf16* delta, const float* g_post, float* h_out, const float* g_pre, bf16* hn_out,
                                          const float* wx, const float* bfo, float* logf, int* tokt, gu32* cnt) {
    const int gw = F.vcu * NWAVES + F.wave, NGW = F.G * NWAVES, lane = F.lane;
    constexpr int NX = EXTRA == 1 ? 6 : (EXTRA == 2 ? 8 : 0);
    f32x4 gp[4], gq[4], wv[NX > 0 ? NX : 1][4];
#pragma unroll
    for (int j = 0; j < 4; ++j) { if constexpr (DELTA != 0) gp[j] = *(const f32x4*)(g_post + 4 * lane + 256 * j); if constexpr (WRITE_HN) gq[j] = *(const f32x4*)(g_pre + 4 * lane + 256 * j); }
#pragma unroll
    for (int e = 0; e < NX; ++e)
#pragma unroll
        for (int j = 0; j < 4; ++j) wv[e][j] = *(const f32x4*)(wx + e * D + 4 * lane + 256 * j);
    float bfl = 0.f; if constexpr (EXTRA == 1) { if (lane < 6) bfl = bfo[lane]; }
    ThinIn cur, nxt;
    if (gw < NTOK) thin_load<DELTA>(cur, gw, lane, h_in, delta, tokt);
    for (int row = gw; row < NTOK; row += NGW) {
        if (row + NGW < NTOK) thin_load<DELTA>(nxt, row + NGW, lane, h_in, delta, tokt);
        f32x4 v[4];
#pragma unroll
        for (int j = 0; j < 4; ++j) v[j] = cur.v[j];
        if constexpr (DELTA != 0) {
            f32x4 d[4];
            if constexpr (DELTA == 1) {
#pragma unroll
                for (int j = 0; j < 4; ++j) { const v2u r = cur.d0[j]; d[j] = (f32x4){bflo(r.x), bfhi(r.x), bflo(r.y), bfhi(r.y)}; }
            } else {
                const float g0 = cur.g0, g1 = cur.g1;
#pragma unroll
                for (int j = 0; j < 4; ++j) { const v2u r0 = cur.d0[j], r1 = cur.d1[j];
                    d[j] = (f32x4){g0 * bflo(r0.x) + g1 * bflo(r1.x), g0 * bfhi(r0.x) + g1 * bfhi(r1.x), g0 * bflo(r0.y) + g1 * bflo(r1.y), g0 * bfhi(r0.y) + g1 * bfhi(r1.y)}; }
            }
            float ss = 0.f;
#pragma unroll
            for (int j = 0; j < 4; ++j) ss += (d[j].x * d[j].x + d[j].y * d[j].y) + (d[j].z * d[j].z + d[j].w * d[j].w);
            const float rs = rsqrtf(wave_sum_fast(ss) * (1.f / D) + EPS);
#pragma unroll
            for (int j = 0; j < 4; ++j) v[j] = v[j] + d[j] * rs * gp[j];
        }
        if constexpr (WRITE_H) {
#pragma unroll
            for (int j = 0; j < 4; ++j) *(f32x4*)(h_out + (size_t)row * D + 4 * lane + 256 * j) = v[j];
        }
        if constexpr (WRITE_HN) {
            float ss = 0.f;
#pragma unroll
            for (int j = 0; j < 4; ++j) ss += (v[j].x * v[j].x + v[j].y * v[j].y) + (v[j].z * v[j].z + v[j].w * v[j].w);
            const float rs = rsqrtf(wave_sum_fast(ss) * (1.f / D) + EPS);
#pragma unroll
            for (int j = 0; j < 4; ++j) { v[j] = v[j] * rs * gq[j];
                v2u o; o.x = pk2(v[j].x, v[j].y); o.y = pk2(v[j].z, v[j].w); *(v2u*)(hn_out + (size_t)row * D + 4 * lane + 256 * j) = o; }
            if constexpr (NX > 0) {
                float lg[NX];
#pragma unroll
                for (int e = 0; e < NX; ++e) { float s2 = 0.f;
#pragma unroll
                    for (int j = 0; j < 4; ++j) { const f32x4 w = wv[e][j]; s2 += (v[j].x * w.x + v[j].y * w.y) + (v[j].z * w.z + v[j].w * w.w); }
                    lg[e] = wave_sum_fast(s2); }
                if constexpr (EXTRA == 1) {
                    if (lane < 6) { float x = lg[0];
#pragma unroll
                        for (int e = 1; e < 6; ++e) x = (lane == e) ? lg[e] : x;
                        logf[(size_t)row * 8 + lane] = log_sigmoid(x + bfl); }
                } else {
                    int e0 = 0; float v0 = lg[0];
#pragma unroll
                    for (int e = 1; e < 8; ++e) if (lg[e] > v0) { v0 = lg[e]; e0 = e; }
                    int e1 = -1; float v1 = -INFINITY;
#pragma unroll
                    for (int e = 0; e < 8; ++e) if (e != e0 && lg[e] > v1) { v1 = lg[e]; e1 = e; }
                    if (lane == 0) {
                        const float g0 = 1.f / (1.f + __expf(v1 - v0)), g1 = 1.f - g0;
                        const unsigned p0 = __hip_atomic_fetch_add(cnt + e0, 1u, RLX_AGENT), p1 = __hip_atomic_fetch_add(cnt + e1, 1u, RLX_AGENT);
                        int* t = tokt + (size_t)row * 8; t[0] = e0; t[1] = (int)p0; t[2] = __float_as_int(g0); t[3] = e1; t[4] = (int)p1; t[5] = __float_as_int(g1);
                    }
                }
            }
        }
        cur = nxt;
    }
}
__device__ __forceinline__ void mem_norm(Frame& F, const float* mem, const float* g, bf16* mn) {
    const int gw = F.vcu * NWAVES + F.wave, NGW = F.G * NWAVES, lane = F.lane;
    for (int row = gw; row < NMEM; row += NGW) {
        f32x4 v[4]; float ss = 0.f;
#pragma unroll
        for (int j = 0; j < 4; ++j) { v[j] = *(const f32x4*)(mem + (size_t)row * D + 4 * lane + 256 * j); ss += (v[j].x * v[j].x + v[j].y * v[j].y) + (v[j].z * v[j].z + v[j].w * v[j].w); }
        const float rs = rsqrtf(wave_sum(ss) * (1.f / D) + EPS);
#pragma unroll
        for (int j = 0; j < 4; ++j) { const f32x4 gg = *(const f32x4*)(g + 4 * lane + 256 * j); v[j] = v[j] * rs * gg;
            v2u o; o.x = pk2(v[j].x, v[j].y); o.y = pk2(v[j].z, v[j].w); *(v2u*)(mn + (size_t)row * D + 4 * lane + 256 * j) = o; }
    }
}
__device__ __forceinline__ void scan_logf(Frame& F, const float* logf, float* ccum) {
    if (blockIdx.x >= NBATCH * NFX) return;
    const int b = blockIdx.x / NFX, h = blockIdx.x % NFX, tid = F.tid;
    LAS float* wsum = (LAS float*)(F.lds + RING_OFF);
    float x[16]; float run = 0.f;
#pragma unroll
    for (int i = 0; i < 16; ++i) { run += logf[((size_t)b * SEQ + tid * 16 + i) * 8 + h]; x[i] = run; }
    float incl = run;
#pragma unroll
    for (int o = 1; o < 64; o <<= 1) { const float t = __shfl_up(incl, o); if (F.lane >= o) incl += t; }
    if (F.lane == 63) wsum[F.wave] = incl;
    LDS_WAIT(); __syncthreads();
    float base = incl - run;
    for (int w = 0; w < F.wave; ++w) base += wsum[w];
    float* o = ccum + ((size_t)b * NFX + h) * SEQ + tid * 16;
#pragma unroll
    for (int i = 0; i < 16; ++i) o[i] = (base + x[i]) * 1.4426950408889634f;
    __syncthreads();
}

__device__ __forceinline__ void pool_window(Frame& F, const bf16* proj, bf16* mix) {
    const int g0 = (F.vcu * NWAVES + F.wave) * 64 + F.lane, GS = F.G * NWAVES * 64;
    for (int it = g0; it < NTOK * 32; it += GS) {
        const int tok = it >> 5, ch = it & 31, pos = tok % SEQ, win = 2 << (ch >> 3), cnt = (pos + 1 < win) ? pos + 1 : win;
        const bf16* yp = proj + (size_t)tok * PP + C_U + 8 * ch;
        float a[8], y0[8];
        { const v4u q = *(const v4u*)yp; y0[0] = bflo(q.x); y0[1] = bfhi(q.x); y0[2] = bflo(q.y); y0[3] = bfhi(q.y); y0[4] = bflo(q.z); y0[5] = bfhi(q.z); y0[6] = bflo(q.w); y0[7] = bfhi(q.w); }
#pragma unroll
        for (int i = 0; i < 8; ++i) a[i] = y0[i];
        for (int j = 1; j < cnt; ++j) { const v4u q = *(const v4u*)(yp - (size_t)j * PP);
            a[0] += bflo(q.x); a[1] += bfhi(q.x); a[2] += bflo(q.y); a[3] += bfhi(q.y); a[4] += bflo(q.z); a[5] += bfhi(q.z); a[6] += bflo(q.w); a[7] += bfhi(q.w); }
        const float ic = 1.f / (float)cnt;
        v4u w; w.x = pk2(a[0] * ic - y0[0], a[1] * ic - y0[1]); w.y = pk2(a[2] * ic - y0[2], a[3] * ic - y0[3]); w.z = pk2(a[4] * ic - y0[4], a[5] * ic - y0[5]); w.w = pk2(a[6] * ic - y0[6], a[7] * ic - y0[7]);
        *(v4u*)(mix + (size_t)tok * D + SBD + FXD + 8 * ch) = w;
    }
}

typedef short bf16x8 __attribute__((ext_vector_type(8)));
typedef float f32x16 __attribute__((ext_vector_type(16)));
__device__ __forceinline__ int kperm(int r) { const int g = (r >> 2) & 3; const int g2 = (g == 1) ? 2 : (g == 2) ? 1 : g; return (r & 16) + 4 * g2 + (r & 3); }
__device__ __forceinline__ float xhalf(float v) { return __shfl_xor(v, 32); }
__device__ __forceinline__ bf16x8 pack8(const f32x16& p, int s) {
    v4u w; w.x = pg8::cvt_pk_bf16(p[8 * s + 0], p[8 * s + 1]); w.y = pg8::cvt_pk_bf16(p[8 * s + 2], p[8 * s + 3]); w.z = pg8::cvt_pk_bf16(p[8 * s + 4], p[8 * s + 5]); w.w = pg8::cvt_pk_bf16(p[8 * s + 6], p[8 * s + 7]);
    return __builtin_bit_cast(bf16x8, w);
}
__device__ __forceinline__ void store_ot(bf16* dst, const f32x16& o, float sc, int hh) {
#pragma unroll
    for (int g = 0; g < 4; ++g) { v2u w; w.x = pg8::cvt_pk_bf16(o[4 * g] * sc, o[4 * g + 1] * sc); w.y = pg8::cvt_pk_bf16(o[4 * g + 2] * sc, o[4 * g + 3] * sc); *(v2u*)(dst + 8 * g + 4 * hh) = w; }
}

__device__ __forceinline__ void fox_knorm(Frame& F, const bf16* proj, gu32* kmax) {
    const int gw = F.vcu * NWAVES + F.wave, NGW = F.G * NWAVES, lane = F.lane;
    const int NU = NBATCH * NFX * (SEQ / 64);
    for (int u = gw; u < NU; u += NGW) {
        const int bh = u / (SEQ / 64), tb = u % (SEQ / 64), b = bh / NFX, h = bh % NFX;
        const bf16* kr = proj + ((size_t)b * SEQ + tb * 64 + lane) * PP + C_FK + h * HD;
        float ss = 0.f;
#pragma unroll
        for (int i = 0; i < 8; ++i) { const v4u r = *(const v4u*)(kr + 8 * i);
            ss += (bflo(r.x) * bflo(r.x) + bfhi(r.x) * bfhi(r.x)) + (bflo(r.y) * bflo(r.y) + bfhi(r.y) * bfhi(r.y)) + (bflo(r.z) * bflo(r.z) + bfhi(r.z) * bfhi(r.z)) + (bflo(r.w) * bflo(r.w) + bfhi(r.w) * bfhi(r.w)); }
        ss = wave_max(ss);
        if (lane == 0) __hip_atomic_fetch_max(kmax + bh, __float_as_uint(ss), RLX_AGENT);
    }
}
#ifndef FOX_THR
#define FOX_THR 104.0f
#endif
constexpr int AT_STB = 8192 + 8192 + 256;
template <int FOX>
__device__ __forceinline__ void attn_wg(Frame& F, const bf16* proj, const bf16* vt, const float* ccum, const gu32* kmax, bf16* mix) {
    constexpr int NH = FOX ? NFX : NSB, COLQ = FOX ? C_FQ : C_SQ, COLK = FOX ? C_FK : C_SK, VROW0 = FOX ? SBD : 0, OCOL = FOX ? SBD : 0;
    constexpr float L2E = 1.4426950408889634f, SC = 0.125f * L2E;
    LAS unsigned char* L = F.lds + RING_OFF;
    LAS unsigned* flags = (LAS unsigned*)(L + 2 * AT_STB);
    const int tid = F.tid, lane = F.lane, wave = F.wave, r = lane & 31, hh = lane >> 5;
    const int srow = tid >> 3, sch = tid & 7, swr = srow * 128 + 16 * (sch ^ ((srow >> 1) & 7));
    const int krow = kperm(r), ksw = (krow >> 1) & 7, vsw = (r >> 1) & 7;
    const int NT = SEQ / 256, NU = NBATCH * NH * NT;
    for (int u = F.vcu; u < NU; u += F.G) {
        const int bh = u / NT, tile = (NT - 1) - u % NT, b = bh / NH, h = bh % NH, T0 = tile * 256, tq = T0 + 32 * wave + r, myblk = tile * 8 + wave;
        const size_t tokb = (size_t)b * SEQ;
        const float* cc = ccum + (size_t)bh * SEQ;
        const bf16* kg = proj + (tokb + srow) * PP + COLK + h * HD + 8 * sch;
        const bf16* vg = vt + (size_t)(VROW0 + h * HD + srow) * VTP + tokb + 8 * sch;
        bf16x8 qf[4]; float qn = 0.f;
        { const bf16* qp = proj + (tokb + tq) * PP + COLQ + h * HD + 8 * hh;
#pragma unroll
          for (int ks = 0; ks < 4; ++ks) { qf[ks] = *(const bf16x8*)(qp + 16 * ks);
              if (FOX) {
#pragma unroll
                  for (int j = 0; j < 8; ++j) { const float x = bf2f((bf16)qf[ks][j]); qn += x * x; } } } }
        float zb2 = 0.f, ct2 = 0.f;
        if (FOX) { qn += xhalf(qn); zb2 = (0.125f * sqrtf(qn * __uint_as_float(__hip_atomic_load(kmax + bh, RLX_AGENT))) * 1.01f + 0.01f) * L2E; ct2 = cc[tq]; }
        float l = 0.f, cb = 0.f, Rp = 1.f; f32x16 o[2] = {};
        bool mydone = false;
        const int nst = tile * 4 + 4;
        v4u gk, gv; float gc = 0.f;
        { const int k0 = T0 + 192; gk = *(const v4u*)(kg + (size_t)k0 * PP); gv = *(const v4u*)(vg + k0); if (FOX && tid < 64) gc = cc[k0 + tid]; }
        *(LAS v4u*)(L + swr) = gk; *(LAS v4u*)(L + 8192 + swr) = gv; if (FOX && tid < 64) *(LAS float*)(L + 16384 + 4 * tid) = gc;
        LDS_WAIT(); __syncthreads();
        for (int j = 0; j < nst; ++j) {
            const int k0 = T0 + 192 - 64 * j;
            LAS unsigned char* B = L + (j & 1) * AT_STB;
            if (j + 1 < nst) { const int k1 = k0 - 64; gk = *(const v4u*)(kg + (size_t)k1 * PP); gv = *(const v4u*)(vg + k1); if (FOX && tid < 64) gc = cc[k1 + tid]; }
#pragma unroll
            for (int sbi = 0; sbi < 2; ++sbi) {
                const int sb = 1 - sbi, blk = (k0 >> 5) + sb, s0 = k0 + 32 * sb;
                if (blk > myblk || mydone) continue;
                const bool diag = (blk == myblk);
                f32x16 S = {};
#pragma unroll
                for (int ks = 0; ks < 4; ++ks) { const bf16x8 kf = *(const LAS bf16x8*)(B + (32 * sb + krow) * 128 + 16 * ((2 * ks + hh) ^ ksw)); S = __builtin_amdgcn_mfma_f32_32x32x16_bf16(kf, qf[ks], S, 0, 0, 0); }
                if (FOX) {
                    f32x4 c4[4];
#pragma unroll
                    for (int s2 = 0; s2 < 2; ++s2) { c4[2 * s2] = *(const LAS f32x4*)(B + 16384 + 4 * (32 * sb + 16 * s2 + 8 * hh)); c4[2 * s2 + 1] = *(const LAS f32x4*)(B + 16384 + 4 * (32 * sb + 16 * s2 + 8 * hh + 4)); }
                    if (diag) {
                        float bm = -INFINITY;
#pragma unroll
                        for (int i = 0; i < 16; ++i) { const int key = s0 + 16 * (i >> 3) + 8 * hh + (i & 7); float x = S[i] * SC + (ct2 - c4[i >> 2][i & 3]); if (key > tq) x = -INFINITY; S[i] = x; bm = fmaxf(bm, x); }
                        bm = fmaxf(bm, xhalf(bm));
                        const float mref = fmaxf(bm, zb2 - 60.f * L2E); cb = ct2 - mref;
#pragma unroll
                        for (int i = 0; i < 16; ++i) { const float pv = __builtin_amdgcn_exp2f(S[i] - mref); S[i] = pv; l += pv; }
                    } else {
#pragma unroll
                        for (int i = 0; i < 16; ++i) { const float pv = __builtin_amdgcn_exp2f(S[i] * SC + (cb - c4[i >> 2][i & 3])); S[i] = pv; l += pv; }
                    }
                    mydone = __all(zb2 + (cb - c4[0][0]) + 13.f <= __log2f(l) - FOX_THR * L2E);
                } else {
                    float om[16];
#pragma unroll
                    for (int i = 0; i < 16; ++i) { const float e = __builtin_amdgcn_exp2f(fabsf(S[i]) * -SC);
                        const float sg = __builtin_amdgcn_rcpf(1.f + e), es = e * sg; const bool pos = S[i] >= 0.f; float bb = pos ? sg : es; float omb = pos ? es : sg;
                        if (diag) { const int key = s0 + 16 * (i >> 3) + 8 * hh + (i & 7); if (key >= tq) { bb = 0.f; omb = 1.f; } }
                        S[i] = bb; om[i] = omb; }
                    float TA = 1.f, TB = 1.f;
#pragma unroll
                    for (int jj = 7; jj >= 0; --jj) { const float a = om[jj], c2 = om[8 + jj]; S[jj] *= TA; S[8 + jj] *= TB; TA *= a; TB *= c2; }
                    const float PA = xhalf(TA), PB = xhalf(TB);
                    const float offB = Rp * (hh ? 1.f : PB), offA = Rp * TB * PB * (hh ? 1.f : PA);
#pragma unroll
                    for (int jj = 0; jj < 8; ++jj) { S[jj] *= offA; S[8 + jj] *= offB; }
                    Rp *= (TA * TB) * (PA * PB);
                    mydone = __all(Rp == 0.f);
                }
                const bf16x8 p0 = pack8(S, 0), p1 = pack8(S, 1);
#pragma unroll
                for (int db = 0; db < 2; ++db) {
                    const bf16x8 v0 = *(const LAS bf16x8*)(B + 8192 + (32 * db + r) * 128 + 16 * ((4 * sb + hh) ^ vsw)), v1 = *(const LAS bf16x8*)(B + 8192 + (32 * db + r) * 128 + 16 * ((4 * sb + 2 + hh) ^ vsw));
                    o[db] = __builtin_amdgcn_mfma_f32_32x32x16_bf16(v0, p0, o[db], 0, 0, 0); o[db] = __builtin_amdgcn_mfma_f32_32x32x16_bf16(v1, p1, o[db], 0, 0, 0); }
            }
            if (lane == 0) flags[(j & 1) * 8 + wave] = mydone ? 1u : 0u;
            if (j + 1 < nst) { LAS unsigned char* Bn = L + ((j + 1) & 1) * AT_STB; *(LAS v4u*)(Bn + swr) = gk; *(LAS v4u*)(Bn + 8192 + swr) = gv; if (FOX && tid < 64) *(LAS float*)(Bn + 16384 + 4 * tid) = gc; }
            LDS_WAIT(); __syncthreads();
            const v4u f0 = *(const LAS v4u*)(flags + (j & 1) * 8), f1 = *(const LAS v4u*)(flags + (j & 1) * 8 + 4);
            if ((f0.x & f0.y & f0.z & f0.w & f1.x & f1.y & f1.z & f1.w) != 0u) break;
        }
        float inv = 1.f;
        if (FOX) { l += xhalf(l); inv = 1.f / l; }
        bf16* op = mix + (tokb + tq) * D + OCOL + h * HD;
        store_ot(op, o[0], inv, hh); store_ot(op + 32, o[1], inv, hh);
        __syncthreads();
    }
}

__device__ __forceinline__ void xa_mfma(Frame& F, const bf16* xq, const bf16* xk, const bf16* xvt, bf16* xo) {
    const int gw = F.vcu * NWAVES + F.wave, NGW = F.G * NWAVES, lane = F.lane, r = lane & 31, hh = lane >> 5;
    const int NU = (NTOK / 32) * XAH;
    for (int u = gw; u < NU; u += NGW) {
        const int hd = u & 3, tb = u >> 2, tok0 = tb * 32, b = tok0 / SEQ;
        bf16x8 qf[16];
        { const bf16* qp = xq + (size_t)(tok0 + r) * D + hd * XAD + 8 * hh;
#pragma unroll
          for (int ks = 0; ks < 16; ++ks) qf[ks] = *(const bf16x8*)(qp + 16 * ks); }
        f32x16 S[8];
#pragma unroll
        for (int kb = 0; kb < 8; ++kb) {
            const bf16* kp = xk + (size_t)(b * MEML + kb * 32 + kperm(r)) * D + hd * XAD + 8 * hh;
            f32x16 acc = {};
#pragma unroll
            for (int ks = 0; ks < 16; ++ks) { const bf16x8 kf = *(const bf16x8*)(kp + 16 * ks); acc = __builtin_amdgcn_mfma_f32_32x32x16_bf16(kf, qf[ks], acc, 0, 0, 0); }
            S[kb] = acc;
        }
        float mx = -INFINITY;
#pragma unroll
        for (int kb = 0; kb < 8; ++kb)
#pragma unroll
            for (int i = 0; i < 16; ++i) mx = fmaxf(mx, S[kb][i]);
        mx = fmaxf(mx, xhalf(mx));
        float sm = 0.f;
#pragma unroll
        for (int kb = 0; kb < 8; ++kb)
#pragma unroll
            for (int i = 0; i < 16; ++i) { const float e = __expf((S[kb][i] - mx) * 0.0625f); S[kb][i] = e; sm += e; }
        sm += xhalf(sm);
        const float inv = 1.f / sm;
        bf16x8 pb[8][2];
#pragma unroll
        for (int kb = 0; kb < 8; ++kb) { pb[kb][0] = pack8(S[kb], 0); pb[kb][1] = pack8(S[kb], 1); }
#pragma unroll
        for (int half = 0; half < 2; ++half) {
            f32x16 o[4] = {};
            const bf16* vp = xvt + (size_t)(hd * XAD + half * 128 + r) * NMEM + b * MEML + 8 * hh;
#pragma unroll
            for (int kb = 0; kb < 8; ++kb)
#pragma unroll
                for (int s2 = 0; s2 < 2; ++s2)
#pragma unroll
                    for (int db = 0; db < 4; ++db) { const bf16x8 vf = *(const bf16x8*)(vp + (size_t)db * 32 * NMEM + kb * 32 + 16 * s2); o[db] = __builtin_amdgcn_mfma_f32_32x32x16_bf16(vf, pb[kb][s2], o[db], 0, 0, 0); }
#pragma unroll
            for (int db = 0; db < 4; ++db) store_ot(xo + (size_t)(tok0 + r) * D + hd * XAD + half * 128 + db * 32, o[db], inv, hh);
        }
    }
}
__device__ __forceinline__ void moe_offsets(const gu32* cnt, int (&pstart)[8], int& nblk) {
    int acc = 0;
#pragma unroll
    for (int e = 0; e < 8; ++e) { const int c = (int)__hip_atomic_load(cnt + e, RLX_AGENT); pstart[e] = acc; acc += ((c + 255) >> 8) << 8; }
    nblk = acc >> 8;
}
__device__ __forceinline__ void moe_gather(Frame& F, const bf16* hn, bf16* xs, int* tokt, int* blke) {
    int pstart[8], nblk; moe_offsets(F.ctl + CW_CNT, pstart, nblk);
    if (blockIdx.x == 0 && F.tid < MAXBLK + 1) {
        if (F.tid == MAXBLK) blke[MAXBLK] = nblk;
        else { int e = 0;
#pragma unroll
            for (int j = 1; j < 8; ++j) if (F.tid * 256 >= pstart[j]) e = j;
            blke[F.tid] = e; }
    }
    const int gw = F.vcu * NWAVES + F.wave, NGW = F.G * NWAVES, lane = F.lane;
    for (int row = gw; row < NTOK; row += NGW) {
        int* t = tokt + (size_t)row * 8; const int e0 = t[0], p0 = t[1], e1 = t[3], p1 = t[4];
        int s0 = 0, s1 = 0;
#pragma unroll
        for (int j = 0; j < 8; ++j) { s0 = (e0 == j) ? pstart[j] : s0; s1 = (e1 == j) ? pstart[j] : s1; }
        const int d0 = s0 + p0, d1 = s1 + p1;
#pragma unroll
        for (int j = 0; j < 2; ++j) { const v4u r = *(const v4u*)(hn + (size_t)row * D + 8 * lane + 512 * j);
            *(v4u*)(xs + (size_t)d0 * D + 8 * lane + 512 * j) = r; *(v4u*)(xs + (size_t)d1 * D + 8 * lane + 512 * j) = r; }
        asm volatile("" ::: "memory");
        if (lane == 0) { t[1] = d0; t[4] = d1; }
    }
}

constexpr int NPHASE = 30;
__global__ void __launch_bounds__(NWAVES * 64, 2) fwd(Args args) {
    extern __shared__ __attribute__((aligned(16))) unsigned char lds[];
    Frame F;
    F.lds = (LAS unsigned char*)lds;
    F.tid = threadIdx.x; F.lane = F.tid & 63; F.wave = __builtin_amdgcn_readfirstlane(F.tid >> 6);
    F.roff = 0; F.G = gridDim.x; { const int bx = blockIdx.x; F.vcu = (F.G % 8 == 0) ? (bx % 8) * (F.G / 8) + bx / 8 : bx; }
    F.ctl = (gu32*)(args.ws + WS_CTL);
    volatile LAS unsigned* MISC = (volatile LAS unsigned*)(F.lds + MISC_OFF);
    for (int u = F.tid; u < (LDS_BYTES - LDSCTL_OFF) / 4; u += NWAVES * 64) ((LAS unsigned*)(F.lds + LDSCTL_OFF))[u] = 0u;
    __syncthreads();
    XcdBarrier bar; bar.bar = (unsigned*)(F.ctl + CW_BAR); bar.x = 0; bar.st = nullptr;
    const int lo = args.ph_lo, hi = args.ph_hi;
    if (hi - lo > 1) bar = xcd_barrier_post((unsigned*)(F.ctl + CW_BAR), MISC + 8);
#ifndef PHASE_MASK
#define PHASE_MASK 0xffffffffffull
#endif
#define IN(k) ((((unsigned long long)(PHASE_MASK) >> (k)) & 1ull) && lo <= (k) && (k) < hi && (fresh(F), true))
#define SEAM(k) do { if (IN(k) && IN((k) + 1)) xcd_barrier(bar); } while (0)
#ifndef PROBE_MASK
#define PROBE_MASK 0ull
#endif
#ifndef PROBE2_MASK
#define PROBE2_MASK 0
#endif
#define TWICE(bit, stmt) do { stmt; if ((PROBE2_MASK >> (bit)) & 1) { xcd_barrier(bar); stmt; } } while (0)
#define REP(k) for (int rep_ = 0; rep_ < (int)(1 + (((unsigned long long)(PROBE_MASK) >> (k)) & 1ull)); ++rep_, (rep_ < (int)(1 + (((unsigned long long)(PROBE_MASK) >> (k)) & 1ull)) ? xcd_barrier(bar) : (void)0))
#define ws WSB
#define scr ((LAS float*)(F.lds + RING_OFF + F.wave * 16384))
#define HN ((bf16*)(ws + R2_HN))
#define MIX ((bf16*)(ws + R2_MIX))
#define PROJ ((bf16*)(ws + R1_PROJ))
#define VT ((bf16*)(ws + R1_VT))
#define BA ((bf16*)(ws + R1_A))
#define BB ((bf16*)(ws + R1_B))
#define ACT ((bf16*)(ws + R1_ACT))
#define XS ((bf16*)(ws + R2_XS))
#define LOGF ((float*)(ws + WS_LOGF))
#define CCUM ((float*)(ws + WS_CCUM))
#define TOKT ((int*)(ws + WS_TOKT))
#define BLKE ((int*)(ws + WS_BLKE))
#define MN ((bf16*)(ws + WS_MN))
#define XKV ((bf16*)(ws + WS_XKV))
#define XK ((bf16*)(ws + WS_XKV))
#define XVT ((bf16*)(ws + WS_XKV + 2 * MiB))
    const int bx = (int)blockIdx.x;

#define GEMM_PLAIN(Aptr, Btptr, M_, N_, K_, Optr, ldc_) do { pg8::Gemm g{(const pg8::bf16_t*)(Aptr), (const pg8::bf16_t*)(Btptr), (M_), (N_), (K_)}; pg8::StaticOrder S; S.init(g, F.G, bx); \
        pg8::EpiBf16 E{(pg8::bf16_t*)(Optr), (ldc_), 0}; pg8::gemm_phase<pg8::EpiBf16, pg8::StaticOrder, true, true>(F.lds + RING_OFF, (K_), S, E); } while (0)

    if (IN(0)) REP(0) {
        convert_layer_small(F, 0, (bf16*)(ws + WS_WS0), scr);
        convert_layer_small(F, 1, (bf16*)(ws + WS_WS1), scr);
        transpose_gu(F, INP(I_DG), INP(I_DU), (bf16*)(ws + WS_WGU0), scr);
        transpose_mat(F, INP(I_DD), D, 0, D, DFF, (bf16*)(ws + WS_WD0), 0, scr);
        { float* wr = (float*)(ws + WS_WR); for (int i = (F.vcu * NWAVES + F.wave) * 64 + F.lane; i < 8 * D; i += F.G * NWAVES * 64) { const int e = i / D, k = i % D; wr[e * D + k] = INP(I_RW)[(size_t)k * NE + e]; } }
        mem_norm(F, INP(I_MEM), INP(I_MEMN), MN);
    }
    SEAM(0);
    if (IN(1)) REP(1) {
        thin_rows<0, false, true, 1>(F, INP(I_X), nullptr, nullptr, nullptr, INP(I_MIXPRE), HN, (const float*)(ws + WS_WF), INP(I_BF), LOGF, nullptr, nullptr);
    }
    SEAM(1);
#pragma unroll
    for (int l = 0; l < DEPTH; ++l) {
        const int p0 = (l == 0) ? 2 : 15;
        const bf16* WSL = (const bf16*)(ws + (l == 0 ? WS_WS0 : WS_WS1));
        const float* h_res = (l == 0) ? INP(I_X) : OUTP;
        if (IN(p0)) REP(p0) {
            scan_logf(F, LOGF, CCUM);
            GEMM_PLAIN(HN, WSL + OW_IN / 2, NTOK, PP, D, PROJ, PP);
            GEMM_PLAIN(WSL + OW_IN / 2 + (size_t)PP * D, HN, VTN, NTOK, D, VT, VTP);
            GEMM_PLAIN(MN, WSL + OW_KV / 2, NMEM, D, D, XK, D);
            GEMM_PLAIN(WSL + OW_KV / 2 + (size_t)D * D, MN, D, NMEM, D, XVT, NMEM);
        }
        SEAM(p0);
        if (IN(p0 + 1)) REP(p0 + 1) {
            TWICE(0, fox_knorm(F, PROJ, F.ctl + CW_KMAX + l * 24));
            TWICE(1, attn_wg<0>(F, PROJ, VT, nullptr, nullptr, MIX));
            TWICE(2, pool_window(F, PROJ, MIX));
        }
        SEAM(p0 + 1);
        if (IN(p0 + 2)) REP(p0 + 2) {
            attn_wg<1>(F, PROJ, VT, CCUM, F.ctl + CW_KMAX + l * 24, MIX);
        }
        SEAM(p0 + 2);
        if (IN(p0 + 3)) REP(p0 + 3) GEMM_PLAIN(MIX, WSL + OW_OUT / 2, NTOK, D, D, BA, D);
        SEAM(p0 + 3);
        if (IN(p0 + 4)) REP(p0 + 4) thin_rows<1, true, true, 0>(F, h_res, BA, INP(I_MIXPOST) + l * D, OUTP, INP(I_XAPRE) + l * D, HN, nullptr, nullptr, nullptr, nullptr, nullptr);
        SEAM(p0 + 4);
        if (IN(p0 + 5)) REP(p0 + 5) GEMM_PLAIN(HN, WSL + OW_Q / 2, NTOK, D, D, BB, D);
        SEAM(p0 + 5);
        if (IN(p0 + 6)) REP(p0 + 6) xa_mfma(F, BB, XK, XVT, BA);
        SEAM(p0 + 6);
        if (IN(p0 + 7)) REP(p0 + 7) GEMM_PLAIN(BA, WSL + OW_O / 2, NTOK, D, D, BB, D);
        SEAM(p0 + 7);
        if (l == 0) {
            if (IN(10)) REP(10) thin_rows<1, true, true, 0>(F, OUTP, BB, INP(I_XAPOST), OUTP, INP(I_FFPRE), HN, nullptr, nullptr, nullptr, nullptr, nullptr);
            SEAM(10);
            if (IN(11)) REP(11) { pg8::Gemm g{(const pg8::bf16_t*)HN, (const pg8::bf16_t*)(ws + WS_WGU0), NTOK, 2 * DFF, D}; pg8::StaticOrder S; S.init(g, F.G, bx);
                pg8::EpiSwiGLU E{(pg8::bf16_t*)ACT, DFF, 0}; pg8::gemm_phase<pg8::EpiSwiGLU, pg8::StaticOrder, true, true>(F.lds + RING_OFF, D, S, E); }
            SEAM(11);
            if (IN(12)) REP(12) GEMM_PLAIN(ACT, ws + WS_WD0, NTOK, D, DFF, MIX, D);
            SEAM(12);
            if (IN(13)) REP(13) thin_rows<1, true, true, 1>(F, OUTP, MIX, INP(I_FFPOST), OUTP, INP(I_MIXPRE) + D, HN, (const float*)(ws + WS_WF) + 8 * D, INP(I_BF) + NFX, LOGF, nullptr, nullptr);
            SEAM(13);
            if (IN(14)) REP(14) {
                for (int e = 0; e < NE; ++e) {
                    bf16* we = (bf16*)(ws + WS_WMOE + (size_t)e * MOE_E_BYTES);
                    transpose_gu(F, INP(I_MG) + (size_t)e * D * DFF, INP(I_MU) + (size_t)e * D * DFF, we, scr);
                    transpose_mat(F, INP(I_MD) + (size_t)e * DFF * D, D, 0, D, DFF, we + MOE_GU_BYTES / 2, 0, scr);
                }
                mem_norm(F, INP(I_MEM), INP(I_MEMN) + D, MN);
            }
            SEAM(14);
        } else {
            if (IN(23)) REP(23) thin_rows<1, true, true, 2>(F, OUTP, BB, INP(I_XAPOST) + D, OUTP, INP(I_FFPRE) + D, BA, (const float*)(ws + WS_WR), nullptr, nullptr, TOKT, F.ctl + CW_CNT);
            SEAM(23);
            if (IN(24)) REP(24) moe_gather(F, BA, XS, TOKT, BLKE);
            SEAM(24);
#pragma unroll
            for (int ch = 0; ch < 2; ++ch) {
                const int nblk = BLKE[MAXBLK]; const int c0 = ch * CHUNK_BLK, c1 = (nblk < c0 + CHUNK_BLK) ? nblk : c0 + CHUNK_BLK; const int nb = c1 > c0 ? c1 - c0 : 0;
                if (IN(25 + 2 * ch)) REP(25 + 2 * ch) { pg8::MoeOrder S{nb, 2 * DFF / 256, F.G, bx, c0, 0, (const char*)XS, (const char*)(ws + WS_WMOE), (size_t)256 * D * 2, MOE_E_BYTES, BLKE};
                    pg8::EpiSwiGLU E{(pg8::bf16_t*)ACT, DFF, c0}; pg8::gemm_phase<pg8::EpiSwiGLU, pg8::MoeOrder, true, true>(F.lds + RING_OFF, D, S, E); }
                SEAM(25 + 2 * ch);
                if (IN(26 + 2 * ch)) REP(26 + 2 * ch) { pg8::MoeOrder S{nb, D / 256, F.G, bx, c0, c0, (const char*)ACT, (const char*)(ws + WS_WMOE + MOE_GU_BYTES), (size_t)256 * DFF * 2, MOE_E_BYTES, BLKE};
                    pg8::EpiBf16 E{(pg8::bf16_t*)XS, D, 0}; pg8::gemm_phase<pg8::EpiBf16, pg8::MoeOrder, true, true>(F.lds + RING_OFF, DFF, S, E); }
                SEAM(26 + 2 * ch);
            }
            if (IN(29)) REP(29) thin_rows<2, true, false, 0>(F, OUTP, XS, INP(I_FFPOST) + D, OUTP, nullptr, nullptr, nullptr, nullptr, nullptr, TOKT, nullptr);
        }
    }
#undef IN
#undef SEAM
#undef ws
#undef scr
#undef HN
#undef MIX
#undef PROJ
#undef VT
#undef BA
#undef BB
#undef ACT
#undef XS
#undef LOGF
#undef CCUM
#undef TOKT
#undef BLKE
#undef MN
#undef XKV
#undef XK
#undef XVT
}

extern "C" void kernel_launch(void* const* d_in, const int* in_sizes, int n_in, void* d_out, int out_size, void* d_ws, size_t ws_size, hipStream_t stream) {
    static int grid = 0;
    if (grid == 0) {
        if (n_in != 24 || in_sizes[0] != NTOK * D || out_size != NTOK * D || ws_size < WS_END) { fprintf(stderr, "kernel_launch: unexpected shapes / workspace (%d inputs, ws %zu < %zu)\n", n_in, ws_size, (size_t)WS_END); grid = -1; return; }
        int dev = 0, cus = 0, per_cu = 0;
        if (hipGetDevice(&dev) != hipSuccess || hipDeviceGetAttribute(&cus, hipDeviceAttributeMultiprocessorCount, dev) != hipSuccess) { grid = -1; return; }
        if (hipFuncSetAttribute((const void*)fwd, hipFuncAttributeMaxDynamicSharedMemorySize, LDS_BYTES) != hipSuccess) { fprintf(stderr, "kernel_launch: hipFuncSetAttribute failed\n"); grid = -1; return; }
        if (hipOccupancyMaxActiveBlocksPerMultiprocessor(&per_cu, (const void*)fwd, NWAVES * 64, LDS_BYTES) != hipSuccess || per_cu < 1) { fprintf(stderr, "kernel_launch: occupancy query reports %d\n", per_cu); }
        (void)hipGetLastError();
        grid = cus;
    }
    if (grid < 0) return;
    (void)hipMemsetAsync((char*)d_ws + WS_CTL, 0, CTL_ZERO_BYTES, stream);
    Args a{};
    for (int i = 0; i < 24; ++i) a.in[i] = (const float*)d_in[i];
    a.out = (float*)d_out; a.ws = (unsigned char*)d_ws;
#if MK_ONE_LAUNCH
    a.ph_lo = 0; a.ph_hi = NPHASE;
    hipLaunchKernelGGL(fwd, dim3(grid), dim3(NWAVES * 64), LDS_BYTES, stream, a);
#else
    for (int p = 0; p < NPHASE; ++p) {
        a.ph_lo = p; a.ph_hi = p + 1;
        hipLaunchKernelGGL(fwd, dim3(grid), dim3(NWAVES * 64), LDS_BYTES, stream, a);
    }
#endif
}
```

```cpp
#include <hip/hip_runtime.h>
#include <cstdio>
#include <cstdint>

#ifndef MK_ONE_LAUNCH
#define MK_ONE_LAUNCH 1
#endif

namespace pg8 {
#define PG8_LAS __attribute__((address_space(3)))
typedef unsigned short bf16_t;
typedef short bf16x8 __attribute__((ext_vector_type(8)));
typedef float f32x4 __attribute__((ext_vector_type(4)));
typedef unsigned u32x4 __attribute__((ext_vector_type(4)));
constexpr int BM = 256, BK = 64, HALF = 128, HTB = HALF * BK * 2  , STAGE_BYTES = 8 * HTB, NXCD = 8, WGM = 8;

__host__ __device__ __forceinline__ int lds_byte(int r, int c) { const int st = (r >> 4) * 2 + (c >> 5), rr = r & 15, cc = c & 31, ob = rr * 64 + cc * 2; return st * 1024 + (ob ^ (((ob >> 9) & 1) << 5)); }
__host__ __device__ __forceinline__ void stage_rc(int b, int& R, int& C) { const int st = b / 1024, sb = b % 1024, swz = sb ^ (((sb >> 9) & 1) << 5); R = (st >> 1) * 16 + swz / 64; C = (st & 1) * 32 + (swz % 64) / 2; }
__host__ __device__ __forceinline__ int perm32(int rho) { const int n = rho >> 4, i = rho & 15; return 8 * (i >> 2) + 4 * n + (i & 3); }

struct Unit { int pm, pn; const char* a; const char* b; };
struct Gemm { const bf16_t* A; const bf16_t* Bt; int M, N, K; };

__device__ __forceinline__ bool order_map(int i, int G, int c, int nM, int nN, int& pm, int& pn) {
    const int nwg = nM * nN; const long L = (long)i * G + c; if (L >= nwg) return false;
    int wgid = (int)L; { const int q = nwg / NXCD, r = nwg % NXCD, xcd = wgid % NXCD, off = wgid / NXCD; wgid = (xcd < r ? xcd * (q + 1) : r * (q + 1) + (xcd - r) * q) + off; }
    const int nig = WGM * nN, gid = wgid / nig, fm = gid * WGM, gsz = (nM - fm) < WGM ? (nM - fm) : WGM;
    pm = fm + ((wgid % nig) % gsz); pn = (wgid % nig) / gsz; return true;
}
struct StaticOrder {
    int nM, nN, G, c; const char* A; const char* B; size_t tstep;
    __device__ void init(const Gemm& g, int G_, int c_) { nM = g.M / BM; nN = g.N / BM; G = G_; c = c_; A = (const char*)g.A; B = (const char*)g.Bt; tstep = (size_t)BM * g.K * 2; }
    __device__ __forceinline__ bool next(int i, Unit& u) const {
        if (!order_map(i, G, c, nM, nN, u.pm, u.pn)) return false;
        u.a = A + (size_t)u.pm * tstep; u.b = B + (size_t)u.pn * tstep; return true;
    }
};
struct MoeOrder {
    int nM, nN, G, c, pb0, pbA; const char* A; const char* W; size_t tstep, wstride; const int* blk_e;
    __device__ __forceinline__ bool next(int i, Unit& u) const {
        int pm, pn; if (!order_map(i, G, c, nM, nN, pm, pn)) return false;
        u.pm = pb0 + pm; u.pn = pn; const int e = __builtin_amdgcn_readfirstlane(blk_e[u.pm]);
        u.a = A + (size_t)(u.pm - pbA) * tstep; u.b = W + (size_t)e * wstride + (size_t)pn * tstep; return true;
    }
};

__device__ __forceinline__ unsigned cvt_pk_bf16(float lo, float hi) { unsigned r; asm volatile("v_cvt_pk_bf16_f32 %0, %1, %2" : "=v"(r) : "v"(lo), "v"(hi)); return r; }

struct EpiBf16 {
    static constexpr bool PERM = true;
    bf16_t* O; int ldc; int pm_off;
    __device__ __forceinline__ void operator()(const f32x4 (&acc)[2][2][4][2], const Unit& u, int wr, int wc, int fr, int fq) const {
        const int row0 = (u.pm - pm_off) * BM + wr * 64 + fr; const int col0 = u.pn * BM + wc * 32 + 8 * fq;
#pragma unroll
        for (int ai = 0; ai < 2; ++ai)
#pragma unroll
            for (int m = 0; m < 4; ++m) { bf16_t* rowp = O + (size_t)(row0 + ai * HALF + m * 16) * ldc + col0;
#pragma unroll
                for (int bj = 0; bj < 2; ++bj) { const f32x4 v0 = acc[ai][bj][m][0], v1 = acc[ai][bj][m][1];
                    u32x4 w; w.x = cvt_pk_bf16(v0[0], v0[1]); w.y = cvt_pk_bf16(v0[2], v0[3]); w.z = cvt_pk_bf16(v1[0], v1[1]); w.w = cvt_pk_bf16(v1[2], v1[3]);
                    *(u32x4*)(rowp + bj * HALF) = w; } }
    }
};
__device__ __forceinline__ float silu_mul(float g, float u) { return g * __builtin_amdgcn_rcpf(1.0f + __expf(-g)) * u; }
struct EpiSwiGLU {
    static constexpr bool PERM = true;
    bf16_t* O; int ldc; int pm_off;
    __device__ __forceinline__ void operator()(const f32x4 (&acc)[2][2][4][2], const Unit& u, int wr, int wc, int fr, int fq) const {
        const int row0 = (u.pm - pm_off) * BM + wr * 64 + fr; const int col0 = u.pn * HALF + wc * 32 + 8 * fq;
#pragma unroll
        for (int ai = 0; ai < 2; ++ai)
#pragma unroll
            for (int m = 0; m < 4; ++m) { bf16_t* rowp = O + (size_t)(row0 + ai * HALF + m * 16) * ldc + col0;
                const f32x4 g0 = acc[ai][0][m][0], g1 = acc[ai][0][m][1], u0 = acc[ai][1][m][0], u1 = acc[ai][1][m][1];
                u32x4 w; w.x = cvt_pk_bf16(silu_mul(g0[0], u0[0]), silu_mul(g0[1], u0[1])); w.y = cvt_pk_bf16(silu_mul(g0[2], u0[2]), silu_mul(g0[3], u0[3]));
                w.z = cvt_pk_bf16(silu_mul(g1[0], u1[0]), silu_mul(g1[1], u1[1])); w.w = cvt_pk_bf16(silu_mul(g1[2], u1[2]), silu_mul(g1[3], u1[3]));
                *(u32x4*)rowp = w; }
    }
};


__device__ __forceinline__ float clamp448(float x) { return __builtin_amdgcn_fmed3f(x, -448.f, 448.f); }
__device__ __forceinline__ unsigned pack4_fp8(float a, float b, float c, float d) { unsigned w = 0; w = __builtin_amdgcn_cvt_pk_fp8_f32(clamp448(a), clamp448(b), w, false); w = __builtin_amdgcn_cvt_pk_fp8_f32(clamp448(c), clamp448(d), w, true); return w; }
struct EpiBf16S {
    static constexpr bool PERM = true;
    bf16_t* O; int ldc; int pm_off; float sc;
    __device__ __forceinline__ void operator()(const f32x4 (&acc)[2][2][4][2], const Unit& u, int wr, int wc, int fr, int fq) const {
        const int row0 = (u.pm - pm_off) * BM + wr * 64 + fr; const int col0 = u.pn * BM + wc * 32 + 8 * fq;
#pragma unroll
        for (int ai = 0; ai < 2; ++ai)
#pragma unroll
            for (int m = 0; m < 4; ++m) { bf16_t* rowp = O + (size_t)(row0 + ai * HALF + m * 16) * ldc + col0;
#pragma unroll
                for (int bj = 0; bj < 2; ++bj) { const f32x4 v0 = acc[ai][bj][m][0] * sc, v1 = acc[ai][bj][m][1] * sc;
                    u32x4 w; w.x = cvt_pk_bf16(v0[0], v0[1]); w.y = cvt_pk_bf16(v0[2], v0[3]); w.z = cvt_pk_bf16(v1[0], v1[1]); w.w = cvt_pk_bf16(v1[2], v1[3]);
                    *(u32x4*)(rowp + bj * HALF) = w; } }
    }
};
struct EpiSwiGLU8 {
    static constexpr bool PERM = true;
    unsigned char* O; int ldc; int pm_off; float sc_in, sc_out;
    __device__ __forceinline__ void operator()(const f32x4 (&acc)[2][2][4][2], const Unit& u, int wr, int wc, int fr, int fq) const {
        typedef unsigned u32x2 __attribute__((ext_vector_type(2)));
        const int row0 = (u.pm - pm_off) * BM + wr * 64 + fr; const int col0 = u.pn * HALF + wc * 32 + 8 * fq;
#pragma unroll
        for (int ai = 0; ai < 2; ++ai)
#pragma unroll
            for (int m = 0; m < 4; ++m) { unsigned char* rowp = O + (size_t)(row0 + ai * HALF + m * 16) * ldc + col0;
                const f32x4 g0 = acc[ai][0][m][0] * sc_in, g1 = acc[ai][0][m][1] * sc_in, u0 = acc[ai][1][m][0] * sc_in, u1 = acc[ai][1][m][1] * sc_in;
                u32x2 w; w.x = pack4_fp8(silu_mul(g0[0], u0[0]) * sc_out, silu_mul(g0[1], u0[1]) * sc_out, silu_mul(g0[2], u0[2]) * sc_out, silu_mul(g0[3], u0[3]) * sc_out);
                w.y = pack4_fp8(silu_mul(g1[0], u1[0]) * sc_out, silu_mul(g1[1], u1[1]) * sc_out, silu_mul(g1[2], u1[2]) * sc_out, silu_mul(g1[3], u1[3]) * sc_out);
                *(u32x2*)rowp = w; __builtin_amdgcn_sched_barrier(0); }
    }
};

typedef int v8i32 __attribute__((ext_vector_type(8)));
typedef int v4i32 __attribute__((ext_vector_type(4)));
__device__ __forceinline__ v8i32 cat8(bf16x8 a, bf16x8 b) { return __builtin_shufflevector(__builtin_bit_cast(v4i32, a), __builtin_bit_cast(v4i32, b), 0, 1, 2, 3, 4, 5, 6, 7); }
template <class Epi, class Sched, bool ALIGN_EPI = false, bool SP2 = false, bool F8 = false>
__device__ __forceinline__ void gemm_phase(PG8_LAS unsigned char* lds, const int K, const Sched& S, const Epi& E) {
    int tid_ = threadIdx.x; asm volatile("" : "+v"(tid_));
    const int tid = tid_, wid = __builtin_amdgcn_readfirstlane(tid >> 6), lane = tid & 63, wr = wid >> 2, wc = wid & 3, fr = lane & 15, fq = lane >> 4;
    const int nt = K / BK;
    unsigned voffA[2], voffB[2];
#pragma unroll
    for (int i = 0; i < 2; ++i) { int R, C; stage_rc(tid * 16 + i * 8192, R, C); const int Rb = Epi::PERM ? ((R & ~31) + perm32(R & 31)) : R;
        voffA[i] = (unsigned)(R * K + C) * 2u; voffB[i] = (unsigned)(Rb * K + C) * 2u; }
    const size_t kstep = (size_t)(BK * 2);
    const size_t hstep = (size_t)HALF * K * 2;
    const unsigned ldsw = (unsigned)wid * 1024u;
    const int aoff = lds_byte(wr * 64 + fr, fq * 8), boff = lds_byte(wc * 32 + fr, fq * 8);
#define PG8_SA(b, h) (((b) * 2 + (h)) * HTB)
#define PG8_SB(b, h) ((4 + (b) * 2 + (h)) * HTB)
#define PG8_STAGE(bufoff, gbase, voff) do { _Pragma("unroll") for (int _i = 0; _i < 2; ++_i) \
        __builtin_amdgcn_global_load_lds((const unsigned*)((const char*)(gbase) + (voff)[_i]), (PG8_LAS unsigned*)(lds + (bufoff) + ldsw + _i * 8192), 16, 0, 0); } while (0)
#define PG8_LDA(dst, b, h) do { _Pragma("unroll") for (int m = 0; m < 4; ++m) { if constexpr (F8) { dst##8[m].lo = *(const PG8_LAS v4i32*)(lds + PG8_SA(b, h) + aoff + m * 2048); dst##8[m].hi = *(const PG8_LAS v4i32*)(lds + PG8_SA(b, h) + aoff + m * 2048 + 1024); } \
        else { _Pragma("unroll") for (int k = 0; k < 2; ++k) dst[m][k] = *(const PG8_LAS bf16x8*)(lds + PG8_SA(b, h) + aoff + m * 2048 + k * 1024); } } } while (0)
#define PG8_LDB(dst, b, h) do { _Pragma("unroll") for (int n = 0; n < 2; ++n) { if constexpr (F8) { dst##8[n].lo = *(const PG8_LAS v4i32*)(lds + PG8_SB(b, h) + boff + n * 2048); dst##8[n].hi = *(const PG8_LAS v4i32*)(lds + PG8_SB(b, h) + boff + n * 2048 + 1024); } \
        else { _Pragma("unroll") for (int k = 0; k < 2; ++k) dst[n][k] = *(const PG8_LAS bf16x8*)(lds + PG8_SB(b, h) + boff + n * 2048 + k * 1024); } } } while (0)
#define PG8_MMA(ai, bj, At, Bt) do { __builtin_amdgcn_s_setprio(1); _Pragma("unroll") for (int m = 0; m < 4; ++m) _Pragma("unroll") for (int n = 0; n < 2; ++n) { \
        if constexpr (F8) asm volatile("v_mfma_scale_f32_16x16x128_f8f6f4 %0, %1, %2, %0, %3, %3 op_sel_hi:[0,0,0]" : "+v"(acc[ai][bj][m][n]) : "v"(Bt##8[n]), "v"(At##8[m]), "v"(f8scale)); \
        else { _Pragma("unroll") for (int k = 0; k < 2; ++k) acc[ai][bj][m][n] = __builtin_amdgcn_mfma_f32_16x16x32_bf16(Bt[n][k], At[m][k], acc[ai][bj][m][n], 0, 0, 0); } } __builtin_amdgcn_s_setprio(0); } while (0)
#define PG8_WAIT_V(n) asm volatile("s_waitcnt vmcnt(" #n ")" ::: "memory")
#define PG8_WAIT_L(n) asm volatile("s_waitcnt lgkmcnt(" #n ")" ::: "memory")
#define PG8_BAR __builtin_amdgcn_s_barrier()
#define PG8_SCHED __builtin_amdgcn_sched_barrier(0)
    Unit cur, nxt; int ui = 0;
    if (!S.next(0, cur)) return;
    f32x4 acc[2][2][4][2];
#pragma unroll
    for (int a = 0; a < 2; ++a)
#pragma unroll
        for (int b = 0; b < 2; ++b)
#pragma unroll
            for (int m = 0; m < 4; ++m)
#pragma unroll
                for (int n = 0; n < 2; ++n) acc[a][b][m][n] = (f32x4){0.f, 0.f, 0.f, 0.f};
    bf16x8 At[4][2], B0[2][2], B1[2][2]; v8i32 At8[4], B08[2], B18[2];
    int f8scale = 0x7F7F7F7F; asm volatile("" : "+v"(f8scale));
    const char* cA = cur.a; const char* cB = cur.b;
    if constexpr (SP2) {
        PG8_STAGE(PG8_SB(0, 0), cB, voffB); PG8_STAGE(PG8_SB(0, 1), cB + hstep, voffB); PG8_STAGE(PG8_SA(0, 0), cA, voffA); PG8_STAGE(PG8_SA(0, 1), cA + hstep, voffA);
        if (wr == 1) PG8_BAR;
        PG8_WAIT_V(2); PG8_BAR;
        PG8_STAGE(PG8_SB(1, 0), cB + kstep, voffB); PG8_STAGE(PG8_SA(1, 0), cA + kstep, voffA); PG8_STAGE(PG8_SB(1, 1), cB + hstep + kstep, voffB);
        PG8_WAIT_V(6); PG8_BAR;
    } else {
        PG8_STAGE(PG8_SB(0, 0), cB, voffB); PG8_STAGE(PG8_SA(0, 0), cA, voffA); PG8_STAGE(PG8_SB(0, 1), cB + hstep, voffB); PG8_STAGE(PG8_SA(0, 1), cA + hstep, voffA);
        if (wr == 1) PG8_BAR;
        PG8_WAIT_V(4); PG8_BAR;
        PG8_STAGE(PG8_SB(1, 0), cB + kstep, voffB); PG8_STAGE(PG8_SA(1, 0), cA + kstep, voffA); PG8_STAGE(PG8_SB(1, 1), cB + hstep + kstep, voffB);
        PG8_WAIT_V(6); PG8_BAR;
    }
    for (;;) {
        const bool has_next = S.next(ui + 1, nxt);
        const char* nA = has_next ? nxt.a : cA; const char* nB = has_next ? nxt.b : cB;
#pragma nounroll
        for (int t = 0; t < nt; t += 2) {
            const bool last = (t == nt - 2);
            const char* a1 = cA + (size_t)(t + 1) * kstep;
            const char* a2 = last ? nA : cA + (size_t)(t + 2) * kstep; const char* b2 = last ? nB : cB + (size_t)(t + 2) * kstep;
            const char* a3 = a2 + kstep; const char* b3 = b2 + kstep;
            if constexpr (SP2) {
            PG8_LDB(B0, 0, 0); PG8_LDB(B1, 0, 1); PG8_SCHED; PG8_LDA(At, 0, 0); PG8_STAGE(PG8_SA(1, 1), a1 + hstep, voffA);
            PG8_WAIT_V(8); PG8_WAIT_L(0); PG8_BAR; PG8_MMA(0, 0, At, B0); PG8_MMA(0, 1, At, B1); PG8_BAR; PG8_SCHED;
            PG8_LDA(At, 0, 1); PG8_STAGE(PG8_SB(0, 0), b2, voffB); PG8_STAGE(PG8_SB(0, 1), b2 + hstep, voffB); PG8_STAGE(PG8_SA(0, 0), a2, voffA);
            PG8_WAIT_V(8); PG8_WAIT_L(0); PG8_BAR; PG8_MMA(1, 0, At, B0); PG8_MMA(1, 1, At, B1); PG8_BAR; PG8_SCHED;
            PG8_LDB(B0, 1, 0); PG8_LDB(B1, 1, 1); PG8_SCHED; PG8_LDA(At, 1, 0); PG8_STAGE(PG8_SA(0, 1), a2 + hstep, voffA);
            PG8_WAIT_V(8); PG8_WAIT_L(0); PG8_BAR; PG8_MMA(0, 0, At, B0); PG8_MMA(0, 1, At, B1); PG8_BAR; PG8_SCHED;
            PG8_LDA(At, 1, 1); PG8_STAGE(PG8_SB(1, 0), b3, voffB); PG8_STAGE(PG8_SB(1, 1), b3 + hstep, voffB); PG8_STAGE(PG8_SA(1, 0), a3, voffA);
            PG8_WAIT_V(8); PG8_WAIT_L(0); PG8_BAR; PG8_MMA(1, 0, At, B0); PG8_MMA(1, 1, At, B1); PG8_BAR; PG8_SCHED;
            } else {
            PG8_LDB(B0, 0, 0); PG8_SCHED; PG8_LDA(At, 0, 0); PG8_STAGE(PG8_SA(1, 1), a1 + hstep, voffA);
            PG8_WAIT_L(8); PG8_BAR; PG8_WAIT_L(0); PG8_MMA(0, 0, At, B0); PG8_BAR; PG8_SCHED;
            PG8_LDB(B1, 0, 1); PG8_STAGE(PG8_SB(0, 0), b2, voffB);
            PG8_BAR; PG8_WAIT_L(0); PG8_MMA(0, 1, At, B1); PG8_BAR;
            PG8_LDA(At, 0, 1); PG8_STAGE(PG8_SA(0, 0), a2, voffA);
            PG8_BAR; PG8_WAIT_L(0); PG8_MMA(1, 0, At, B0); PG8_BAR; PG8_SCHED;
            PG8_STAGE(PG8_SB(0, 1), b2 + hstep, voffB);
            PG8_WAIT_V(6); PG8_BAR; PG8_MMA(1, 1, At, B1); PG8_BAR;
            PG8_LDB(B0, 1, 0); PG8_SCHED; PG8_LDA(At, 1, 0); PG8_STAGE(PG8_SA(0, 1), a2 + hstep, voffA);
            PG8_WAIT_L(8); PG8_BAR; PG8_WAIT_L(0); PG8_MMA(0, 0, At, B0); PG8_BAR; PG8_SCHED;
            PG8_LDB(B1, 1, 1); PG8_STAGE(PG8_SB(1, 0), b3, voffB);
            PG8_BAR; PG8_WAIT_L(0); PG8_MMA(0, 1, At, B1); PG8_BAR;
            PG8_LDA(At, 1, 1); PG8_STAGE(PG8_SA(1, 0), a3, voffA);
            PG8_BAR; PG8_WAIT_L(0); PG8_MMA(1, 0, At, B0); PG8_BAR; PG8_SCHED;
            PG8_STAGE(PG8_SB(1, 1), b3 + hstep, voffB);
            PG8_WAIT_V(6); PG8_BAR; PG8_MMA(1, 1, At, B1); PG8_BAR;
            }
        }
        if constexpr (F8) asm volatile("s_nop 15\n\ts_nop 15" ::: "memory");
        if constexpr (ALIGN_EPI) { if (wr == 0) PG8_BAR; }
        E(acc, cur, wr, wc, fr, fq);
        if (!has_next) break;
#pragma unroll
        for (int a = 0; a < 2; ++a)
#pragma unroll
            for (int b = 0; b < 2; ++b)
#pragma unroll
                for (int m = 0; m < 4; ++m)
#pragma unroll
                    for (int n = 0; n < 2; ++n) acc[a][b][m][n] = (f32x4){0.f, 0.f, 0.f, 0.f};
        cur = nxt; cA = nA; cB = nB; ++ui;
        if constexpr (ALIGN_EPI) { if (wr == 1) PG8_BAR; }
    }
    PG8_WAIT_V(0);
    if constexpr (!ALIGN_EPI) { if (wr == 0) PG8_BAR; }
    PG8_BAR;
#undef PG8_SA
#undef PG8_SB
#undef PG8_STAGE
#undef PG8_LDA
#undef PG8_LDB
#undef PG8_MMA
#undef PG8_WAIT_V
#undef PG8_WAIT_L
#undef PG8_BAR
#undef PG8_SCHED
}
}

constexpr int NBATCH = 4, SEQ = 8192, D = 1024, NTOK = NBATCH * SEQ, DEPTH = 2;
constexpr int HD = 64, NSB = 6, NFX = 6, SBD = 384, FXD = 384, POOLD = 256, CIN = 2566;
constexpr int MEML = 256, NMEM = NBATCH * MEML, XAH = 4, XAD = 256;
constexpr int DFF = 2816, NE = 8;
constexpr float EPS = 1e-6f;
constexpr int PP = 1792, C_SQ = 0, C_SK = 384, C_FQ = 768, C_FK = 1152, C_U = 1536;
constexpr int VTN = 768, VTP = NTOK + 2112;
constexpr int MAXBLK = 264, CHUNK_BLK = 128, CHUNK1_MAX = MAXBLK - CHUNK_BLK;

constexpr size_t MiB = 1u << 20;
constexpr size_t WS_CTL = 0, CTL_ZERO_BYTES = 1 * MiB;
constexpr size_t WS_WF   = 1 * MiB;
constexpr size_t WS_WR   = WS_WF + 65536;
constexpr size_t WS_BLKE = WS_WR + 32768;
constexpr size_t WS_LOGF = 2 * MiB;
constexpr size_t WS_CCUM = 3 * MiB;
constexpr size_t WS_TOKT = 4 * MiB;
constexpr size_t WS_MN   = 5 * MiB;
constexpr size_t WS_XKV  = 7 * MiB;
constexpr size_t WS_WS1  = 16 * MiB;
constexpr size_t WS_WMOE = 31 * MiB;
constexpr size_t WS_R2   = 163 * MiB;
constexpr size_t WS_R1   = 295 * MiB;
constexpr size_t R1_BYTES = (size_t)CHUNK1_MAX * 256 * DFF * 2;
constexpr size_t WS_END  = 295 * MiB + R1_BYTES;
constexpr size_t OW_IN = 0, OW_OUT = 5 * MiB, OW_Q = 7 * MiB, OW_KV = 9 * MiB, OW_O = 13 * MiB, OW_LAYER = 15 * MiB;
constexpr size_t WS_WS0 = WS_WMOE;
constexpr size_t WS_WGU0 = WS_WS0 + OW_LAYER;
constexpr size_t WS_WD0 = WS_WGU0 + 11 * MiB;
constexpr size_t MOE_GU_BYTES = (size_t)2 * DFF * D, MOE_D_BYTES = (size_t)D * DFF, MOE_E_BYTES = MOE_GU_BYTES + MOE_D_BYTES;
constexpr size_t WS_XS8 = WS_WMOE + 8 * MOE_E_BYTES;
static_assert(WS_WD0 + (size_t)D * DFF * 2 <= WS_WMOE + 132 * MiB && WS_XS8 + (size_t)MAXBLK * 256 * D <= WS_WMOE + 132 * MiB, "weights map");
constexpr size_t R2_HN = WS_R2, R2_MIX = WS_R2 + 64 * MiB;
constexpr size_t R1_PROJ = WS_R1;
constexpr size_t R1_VT = WS_R1 + 112 * MiB;
constexpr size_t R1_A = WS_R1, R1_B = WS_R1 + 64 * MiB;
constexpr size_t R1_ACT = WS_R1;
constexpr size_t R1_ACT8 = WS_R1 + 64 * MiB;
constexpr size_t R2_XS = WS_R2;
static_assert((size_t)NTOK * DFF * 2 <= R1_BYTES && (size_t)MAXBLK * 256 * D * 2 <= 132 * MiB && WS_END <= 513026096, "arena map");
constexpr int CW_CNT = 64;
constexpr int CW_KMAX = 128;
constexpr int CW_BAR = 4096;

constexpr int RING_OFF = 0, RING_BYTES = 131072;
constexpr int LDSCTL_OFF = RING_BYTES, MISC_OFF = LDSCTL_OFF + 320;
constexpr int LDS_BYTES = 147456;
constexpr int NWAVES = 8;

#define GAS __attribute__((address_space(1)))
#define LAS __attribute__((address_space(3)))
typedef unsigned short bf16;
typedef unsigned v4u __attribute__((ext_vector_type(4)));
typedef unsigned v2u __attribute__((ext_vector_type(2)));
typedef float f32x4 __attribute__((ext_vector_type(4)));
typedef GAS unsigned gu32;
#define RLX_AGENT __ATOMIC_RELAXED, __HIP_MEMORY_SCOPE_AGENT
#define LDS_WAIT() asm volatile("s_waitcnt lgkmcnt(0)" ::: "memory")
#define VM_WAIT() asm volatile("s_waitcnt vmcnt(0)" ::: "memory")
__device__ __forceinline__ unsigned f2bf(float f) { unsigned u = __builtin_bit_cast(unsigned, f); return (u + 0x7fffu + ((u >> 16) & 1u)) >> 16; }
__device__ __forceinline__ unsigned pk2(float lo, float hi) { return f2bf(lo) | (f2bf(hi) << 16); }
__device__ __forceinline__ float bflo(unsigned u) { return __uint_as_float(u << 16); }
__device__ __forceinline__ float bfhi(unsigned u) { return __uint_as_float(u & 0xffff0000u); }
__device__ __forceinline__ float bf2f(bf16 b) { return __uint_as_float(((unsigned)b) << 16); }

#define XB_TMO      128
#define XB_XCNT(j)  (256  + 64 * (j))
#define XB_XSUB(j)  (1280 + 64 * (j))
#define XB_XGEN(j)  (2304 + 64 * (j))
#define XB_TOP      3328
#define XB_TOPGEN   3392
#define XCD_BAR_WORDS 3456
#define XB_SPIN_CAP (1u << 22)

__device__ __forceinline__ unsigned xb_ld(unsigned* p)              { return __hip_atomic_load(p, __ATOMIC_RELAXED, __HIP_MEMORY_SCOPE_AGENT); }
__device__ __forceinline__ unsigned xb_add(unsigned* p, unsigned v) { return __hip_atomic_fetch_add(p, v, __ATOMIC_RELAXED, __HIP_MEMORY_SCOPE_AGENT); }
__device__ __forceinline__ unsigned xb_xcc_id() { return (unsigned)__builtin_amdgcn_s_getreg((3 << 11) | 20) & 0xFu; }
#define XB_SPIN(cond, bar) do { unsigned _sp = 0; while (cond) { __builtin_amdgcn_s_sleep(1); \
    if ((++_sp & 255u) == 0u) { if (xb_ld(&(bar)[XB_TMO])) break; if (_sp > XB_SPIN_CAP) { atomicAdd(&(bar)[XB_TMO], 1u); break; } } } } while (0)

struct XcdBarrier { unsigned* bar; unsigned x; volatile LAS unsigned* st; };

__device__ __forceinline__ XcdBarrier xcd_barrier_post(unsigned* bar, volatile LAS unsigned* st) {
    XcdBarrier b; b.bar = bar; b.x = xb_xcc_id(); b.st = st;
    if (threadIdx.x == 0) (void)xb_add(&bar[XB_XCNT(b.x)], 1u);
    return b;
}
__device__ __forceinline__ void xcd_barrier_complete(unsigned* bar, unsigned x, unsigned& nloc, unsigned& nx) {
    const unsigned G = gridDim.x * gridDim.y * gridDim.z;
    unsigned sum, cnt, mine, sp = 0u;
    for (;;) {
        sum = 0u; cnt = 0u; mine = 0u;
#pragma unroll
        for (unsigned j = 0; j < 16; ++j) { const unsigned c = xb_ld(&bar[XB_XCNT(j)]); sum += c; cnt += (c > 0u) ? 1u : 0u; mine = (j == x) ? c : mine; }
        if (sum == G) break;
        __builtin_amdgcn_s_sleep(1);
        if ((++sp & 255u) == 0u) { if (xb_ld(&bar[XB_TMO])) break; if (sp > XB_SPIN_CAP) { atomicAdd(&bar[XB_TMO], 1u); break; } }
    }
    nloc = mine > 0u ? mine : 1u; nx = cnt > 0u ? cnt : 1u;
}
__device__ __forceinline__ void xcd_barrier(const XcdBarrier& b) {
    asm volatile("s_waitcnt vmcnt(0)" ::: "memory");
    __syncthreads();
    if (threadIdx.x == 0) {
        unsigned* bar = b.bar;
        __builtin_amdgcn_s_waitcnt(0);
        unsigned nloc = b.st[0], nx = b.st[1];
        if (nloc == 0u) { xcd_barrier_complete(bar, b.x, nloc, nx); b.st[0] = nloc; b.st[1] = nx; }
        const unsigned old = xb_add(&bar[XB_XSUB(b.x)], 1u);
        const unsigned gen = old / nloc;
        if (old + 1u == (gen + 1u) * nloc) {
            __builtin_amdgcn_fence(__ATOMIC_RELEASE, "agent");
            asm volatile("s_waitcnt vmcnt(0)" ::: "memory");
            const unsigned og = xb_add(&bar[XB_TOP], 1u);
            const unsigned tg = og / nx;
            if (og + 1u == (tg + 1u) * nx) xb_add(&bar[XB_TOPGEN], 1u);
            else XB_SPIN(xb_ld(&bar[XB_TOPGEN]) == tg, bar);
            __builtin_amdgcn_fence(__ATOMIC_ACQUIRE, "agent");
            xb_add(&bar[XB_XGEN(b.x)], 1u);
            asm volatile("s_waitcnt vmcnt(0)" ::: "memory");
        } else {
            XB_SPIN(xb_ld(&bar[XB_XGEN(b.x)]) == gen, bar);
            __builtin_amdgcn_fence(__ATOMIC_ACQUIRE, "agent");
            asm volatile("s_waitcnt vmcnt(0)" ::: "memory");
        }
    }
    __syncthreads();
}

enum In { I_X = 0, I_MEM, I_MIXPRE, I_MIXPOST, I_WIN, I_BF, I_POOLW, I_POOLS, I_WOUT, I_XAPRE, I_XAPOST, I_MEMN, I_XQ, I_XKV, I_XO, I_FFPRE, I_FFPOST,
          I_DG, I_DU, I_DD, I_RW, I_MG, I_MU, I_MD };

struct Args { const float* in[24]; float* out; unsigned char* ws; int ph_lo, ph_hi; };
__device__ __forceinline__ const __attribute__((address_space(4))) Args* kargs() { const __attribute__((address_space(4))) Args* p = (const __attribute__((address_space(4))) Args*)__builtin_amdgcn_kernarg_segment_ptr(); asm volatile("" : "+s"(p)); return p; }
#define WSB (kargs()->ws)
#define INP(i) (kargs()->in[i])
#define OUTP (kargs()->out)
struct Frame {
    LAS unsigned char* lds;
    gu32* ctl;
    int tid, lane, wave;
    int vcu, G, roff;
};


__device__ __forceinline__ void fresh(Frame& F) { int t = threadIdx.x; asm volatile("" : "+v"(t)); F.tid = t; F.lane = t & 63; F.wave = __builtin_amdgcn_readfirstlane(t >> 6); }
__device__ __forceinline__ float wave_sum(float v) {
#pragma unroll
    for (int o = 1; o < 64; o <<= 1) v += __shfl_xor(v, o);
    return v;
}
__device__ __forceinline__ float wave_max(float v) {
#pragma unroll
    for (int o = 1; o < 64; o <<= 1) v = fmaxf(v, __shfl_xor(v, o));
    return v;
}
__device__ __forceinline__ float log_sigmoid(float x) { return x < 0.f ? x - log1pf(__expf(x)) : -log1pf(__expf(-x)); }

template <bool GU>
__device__ __forceinline__ void conv_item4(const float* W, int ldw, int n, int k0, bf16* WT, int K, int row0, int which) {
    const int rb = GU ? (256 * (n >> 7) + 128 * which + (n & 127)) : (row0 + n);
#pragma unroll
    for (int kk = 0; kk < 32; kk += 8) {
        f32x4 f[8];
#pragma unroll
        for (int i = 0; i < 8; ++i) f[i] = *(const f32x4*)(W + (size_t)(k0 + kk + i) * ldw + n);
#pragma unroll
        for (int j = 0; j < 4; ++j) { v4u o; o.x = pk2(f[0][j], f[1][j]); o.y = pk2(f[2][j], f[3][j]); o.z = pk2(f[4][j], f[5][j]); o.w = pk2(f[6][j], f[7][j]);
            *(v4u*)(WT + (size_t)(rb + j) * K + k0 + kk) = o; }
    }
}
__device__ __forceinline__ void conv_item1(const float* W, int ldw, int col, int k0, bf16* WT, int K, int row) {
#pragma unroll
    for (int kk = 0; kk < 32; kk += 8) {
        float f[8];
#pragma unroll
        for (int i = 0; i < 8; ++i) f[i] = W[(size_t)(k0 + kk + i) * ldw + col];
        v4u o; o.x = pk2(f[0], f[1]); o.y = pk2(f[2], f[3]); o.z = pk2(f[4], f[5]); o.w = pk2(f[6], f[7]);
        *(v4u*)(WT + (size_t)row * K + k0 + kk) = o;
    }
}
__device__ __forceinline__ int conv_first(Frame& F, int nitems) {
    const int gw = F.vcu * NWAVES + F.wave, NGW = F.G * NWAVES; int it = gw - F.roff; if (it < 0) it += NGW; F.roff = (F.roff + nitems) % NGW; return it;
}
__device__ __forceinline__ void transpose_mat(Frame& F, const float* W, int ldw, int col0, int ncols, int K, bf16* WT, int row0, LAS float* scr) {
    (void)scr; const int NGW = F.G * NWAVES, nkb = K / 32;
    if ((ldw & 3) == 0 && (col0 & 3) == 0 && (ncols & 255) == 0) {
        const int nitems = nkb * (ncols / 256);
        for (int it = conv_first(F, nitems); it < nitems; it += NGW) { const int kb = it % nkb, nb = it / nkb; conv_item4<false>(W + col0, ldw, 256 * nb + 4 * F.lane, 32 * kb, WT, K, row0, 0); }
    } else {
        const int nitems = nkb * (ncols / 64);
        for (int it = conv_first(F, nitems); it < nitems; it += NGW) { const int kb = it % nkb, nb = it / nkb; conv_item1(W, ldw, col0 + 64 * nb + F.lane, 32 * kb, WT, K, row0 + 64 * nb + F.lane); }
    }
}
__device__ __forceinline__ void transpose_gu(Frame& F, const float* Wg, const float* Wu, bf16* WT, LAS float* scr) {
    (void)scr; const int NGW = F.G * NWAVES, nkb = D / 32, ncb = DFF / 256, nitems = 2 * nkb * ncb;
    for (int it = conv_first(F, nitems); it < nitems; it += NGW) { const int kb = it % nkb, r = it / nkb, nb = r % ncb, which = r / ncb;
        conv_item4<true>(which ? Wu : Wg, DFF, 256 * nb + 4 * F.lane, 32 * kb, WT, D, 0, which); }
}
template <bool GU>
__device__ __forceinline__ void conv_item4_f8(const float* W, int ldw, int n, int k0, unsigned char* WT, int K, int row0, int which) {
    const int rb = GU ? (256 * (n >> 7) + 128 * which + (n & 127)) : (row0 + n);
#pragma unroll
    for (int kk = 0; kk < 32; kk += 8) {
        f32x4 f[8];
#pragma unroll
        for (int i = 0; i < 8; ++i) f[i] = *(const f32x4*)(W + (size_t)(k0 + kk + i) * ldw + n) * 256.f;
#pragma unroll
        for (int j = 0; j < 4; ++j) { v2u o; o.x = pg8::pack4_fp8(f[0][j], f[1][j], f[2][j], f[3][j]); o.y = pg8::pack4_fp8(f[4][j], f[5][j], f[6][j], f[7][j]);
            *(v2u*)(WT + (size_t)(rb + j) * K + k0 + kk) = o; }
    }
}
__device__ __forceinline__ void transpose_mat_f8(Frame& F, const float* W, int ldw, int ncols, int K, unsigned char* WT) {
    const int NGW = F.G * NWAVES, nkb = K / 32, nitems = nkb * (ncols / 256);
    for (int it = conv_first(F, nitems); it < nitems; it += NGW) { const int kb = it % nkb, nb = it / nkb; conv_item4_f8<false>(W, ldw, 256 * nb + 4 * F.lane, 32 * kb, WT, K, 0, 0); }
}
__device__ __forceinline__ void transpose_gu_f8(Frame& F, const float* Wg, const float* Wu, unsigned char* WT) {
    const int NGW = F.G * NWAVES, nkb = D / 32, ncb = DFF / 256, nitems = 2 * nkb * ncb;
    for (int it = conv_first(F, nitems); it < nitems; it += NGW) { const int kb = it % nkb, r = it / nkb, nb = r % ncb, which = r / ncb;
        conv_item4_f8<true>(which ? Wu : Wg, DFF, 256 * nb + 4 * F.lane, 32 * kb, WT, D, 0, which); }
}
__device__ __forceinline__ void convert_layer_small(Frame& F, int l, bf16* base, LAS float* scr) {
    const float* win = INP(I_WIN) + (size_t)l * D * CIN;
    bf16* wt = base + OW_IN / 2;
    transpose_mat(F, win, CIN, 0, 768, D, wt, 0, scr);
    transpose_mat(F, win, CIN, 1152, 768, D, wt, 768, scr);
    { const float* pw = INP(I_POOLW) + (size_t)l * 4 * 4096; const float* psc = INP(I_POOLS) + (size_t)l * POOLD;
      for (int i = (F.vcu * NWAVES + F.wave) * 64 + F.lane; i < POOLD * D; i += F.G * NWAVES * 64) { const int n = i / D, k = i % D, g = n >> 6, co = n & 63;
          const float* wr = win + (size_t)k * CIN + 2310 + g * 64; const float* pc = pw + g * 4096 + co; float acc = 0.f;
#pragma unroll 8
          for (int ci = 0; ci < 64; ++ci) acc += wr[ci] * pc[ci * 64];
          wt[(size_t)(1536 + n) * D + k] = (bf16)f2bf(acc * psc[n]); } }
    transpose_mat(F, win, CIN, 768, 384, D, wt, 1792, scr);
    transpose_mat(F, win, CIN, 1920, 384, D, wt, 2176, scr);
    transpose_mat(F, INP(I_WOUT) + (size_t)l * D * D, D, 0, D, D, base + OW_OUT / 2, 0, scr);
    transpose_mat(F, INP(I_XQ) + (size_t)l * D * D, D, 0, D, D, base + OW_Q / 2, 0, scr);
    transpose_mat(F, INP(I_XKV) + (size_t)l * D * 2 * D, 2 * D, 0, 2 * D, D, base + OW_KV / 2, 0, scr);
    transpose_mat(F, INP(I_XO) + (size_t)l * D * D, D, 0, D, D, base + OW_O / 2, 0, scr);
    float* wf = (float*)(WSB + WS_WF) + (size_t)l * 8 * D;
    for (int i = (F.vcu * NWAVES + F.wave) * 64 + F.lane; i < 6 * D; i += F.G * NWAVES * 64) { const int j = i / D, k = i % D; wf[j * D + k] = win[(size_t)k * CIN + 2304 + j]; }
}

#define DPP_ADD(v, ctrl) ((v) + __int_as_float(__builtin_amdgcn_update_dpp(0, __float_as_int(v), (ctrl), 0xf, 0xf, false)))
__device__ __forceinline__ float wave_sum_fast(float v) {
    v = DPP_ADD(v, 0xB1); v = DPP_ADD(v, 0x4E); v = DPP_ADD(v, 0x141); v = DPP_ADD(v, 0x140);
    const int iv = __float_as_int(v);
    return (__int_as_float(__builtin_amdgcn_readlane(iv, 0)) + __int_as_float(__builtin_amdgcn_readlane(iv, 16))) + (__int_as_float(__builtin_amdgcn_readlane(iv, 32)) + __int_as_float(__builtin_amdgcn_readlane(iv, 48)));
}
struct ThinIn { f32x4 v[4]; v2u d0[4]; v2u d1[4]; float g0, g1; };
template <int DELTA>
__device__ __forceinline__ void thin_load(ThinIn& t, int row, int lane, const float* h_in, const bf16* delta, const int* tokt) {
#pragma unroll
    for (int j = 0; j < 4; ++j) t.v[j] = *(const f32x4*)(h_in + (size_t)row * D + 4 * lane + 256 * j);
    if constexpr (DELTA == 1) {
#pragma unroll
        for (int j = 0; j < 4; ++j) t.d0[j] = *(const v2u*)(delta + (size_t)row * D + 4 * lane + 256 * j);
    }
    if constexpr (DELTA == 2) {
        const int r0 = tokt[row * 8 + 1], r1 = tokt[row * 8 + 4]; t.g0 = __int_as_float(tokt[row * 8 + 2]); t.g1 = __int_as_float(tokt[row * 8 + 5]);
#pragma unroll
        for (int j = 0; j < 4; ++j) { t.d0[j] = *(const v2u*)(delta + (size_t)r0 * D + 4 * lane + 256 * j); t.d1[j] = *(const v2u*)(delta + (size_t)r1 * D + 4 * lane + 256 * j); }
    }
}
template <int DELTA, bool WRITE_H, bool WRITE_HN, int EXTRA>
__device__ __forceinline__ void thin_rows(Frame& F, const float* h_in, const bf16* delta, const float* g_post, float* h_out, const float* g_pre, bf16* hn_out,
                                          const float* wx, const float* bfo, float* logf, int* tokt, gu32* cnt) {
    const int gw = F.vcu * NWAVES + F.wave, NGW = F.G * NWAVES, lane = F.lane;
    constexpr int NX = EXTRA == 1 ? 6 : (EXTRA == 2 ? 8 : 0);
    f32x4 gp[4], gq[4], wv[NX > 0 ? NX : 1][4];
#pragma unroll
    for (int j = 0; j < 4; ++j) { if constexpr (DELTA != 0) gp[j] = *(const f32x4*)(g_post + 4 * lane + 256 * j); if constexpr (WRITE_HN) gq[j] = *(const f32x4*)(g_pre + 4 * lane + 256 * j); }
#pragma unroll
    for (int e = 0; e < NX; ++e)
#pragma unroll
        for (int j = 0; j < 4; ++j) wv[e][j] = *(const f32x4*)(wx + e * D + 4 * lane + 256 * j);
    float bfl = 0.f; if constexpr (EXTRA == 1) { if (lane < 6) bfl = bfo[lane]; }
    ThinIn cur, nxt;
    if (gw < NTOK) thin_load<DELTA>(cur, gw, lane, h_in, delta, tokt);
    for (int row = gw; row < NTOK; row += NGW) {
        if (row + NGW < NTOK) thin_load<DELTA>(nxt, row + NGW, lane, h_in, delta, tokt);
        f32x4 v[4];
#pragma unroll
        for (int j = 0; j < 4; ++j) v[j] = cur.v[j];
        if constexpr (DELTA != 0) {
            f32x4 d[4];
            if constexpr (DELTA == 1) {
#pragma unroll
                for (int j = 0; j < 4; ++j) { const v2u r = cur.d0[j]; d[j] = (f32x4){bflo(r.x), bfhi(r.x), bflo(r.y), bfhi(r.y)}; }
            } else {
                const float g0 = cur.g0, g1 = cur.g1;
#pragma unroll
                for (int j = 0; j < 4; ++j) { const v2u r0 = cur.d0[j], r1 = cur.d1[j];
                    d[j] = (f32x4){g0 * bflo(r0.x) + g1 * bflo(r1.x), g0 * bfhi(r0.x) + g1 * bfhi(r1.x), g0 * bflo(r0.y) + g1 * bflo(r1.y), g0 * bfhi(r0.y) + g1 * bfhi(r1.y)}; }
            }
            float ss = 0.f;
#pragma unroll
            for (int j = 0; j < 4; ++j) ss += (d[j].x * d[j].x + d[j].y * d[j].y) + (d[j].z * d[j].z + d[j].w * d[j].w);
            const float rs = rsqrtf(wave_sum_fast(ss) * (1.f / D) + EPS);
#pragma unroll
            for (int j = 0; j < 4; ++j) v[j] = v[j] + d[j] * rs * gp[j];
        }
        if constexpr (WRITE_H) {
#pragma unroll
            for (int j = 0; j < 4; ++j) *(f32x4*)(h_out + (size_t)row * D + 4 * lane + 256 * j) = v[j];
        }
        if constexpr (WRITE_HN) {
            float ss = 0.f;
#pragma unroll
            for (int j = 0; j < 4; ++j) ss += (v[j].x * v[j].x + v[j].y * v[j].y) + (v[j].z * v[j].z + v[j].w * v[j].w);
            const float rs = rsqrtf(wave_sum_fast(ss) * (1.f / D) + EPS);
#pragma unroll
            for (int j = 0; j < 4; ++j) { v[j] = v[j] * rs * gq[j];
                v2u o; o.x = pk2(v[j].x, v[j].y); o.y = pk2(v[j].z, v[j].w); *(v2u*)(hn_out + (size_t)row * D + 4 * lane + 256 * j) = o; }
            if constexpr (NX > 0) {
                float lg[NX];
#pragma unroll
                for (int e = 0; e < NX; ++e) { float s2 = 0.f;
#pragma unroll
                    for (int j = 0; j < 4; ++j) { const f32x4 w = wv[e][j]; s2 += (v[j].x * w.x + v[j].y * w.y) + (v[j].z * w.z + v[j].w * w.w); }
                    lg[e] = wave_sum_fast(s2); }
                if constexpr (EXTRA == 1) {
                    if (lane < 6) { float x = lg[0];
#pragma unroll
                        for (int e = 1; e < 6; ++e) x = (lane == e) ? lg[e] : x;
                        logf[(size_t)row * 8 + lane] = log_sigmoid(x + bfl); }
                } else {
                    int e0 = 0; float v0 = lg[0];
#pragma unroll
                    for (int e = 1; e < 8; ++e) if (lg[e] > v0) { v0 = lg[e]; e0 = e; }
                    int e1 = -1; float v1 = -INFINITY;
#pragma unroll
                    for (int e = 0; e < 8; ++e) if (e != e0 && lg[e] > v1) { v1 = lg[e]; e1 = e; }
                    if (lane == 0) {
                        const float g0 = 1.f / (1.f + __expf(v1 - v0)), g1 = 1.f - g0;
                        const unsigned p0 = __hip_atomic_fetch_add(cnt + e0, 1u, RLX_AGENT), p1 = __hip_atomic_fetch_add(cnt + e1, 1u, RLX_AGENT);
                        int* t = tokt + (size_t)row * 8; t[0] = e0; t[1] = (int)p0; t[2] = __float_as_int(g0); t[3] = e1; t[4] = (int)p1; t[5] = __float_as_int(g1);
                    }
                }
            }
        }
        cur = nxt;
    }
}
__device__ __forceinline__ void mem_norm(Frame& F, const float* mem, const float* g, bf16* mn) {
    const int gw = F.vcu * NWAVES + F.wave, NGW = F.G * NWAVES, lane = F.lane;
    for (int row = gw; row < NMEM; row += NGW) {
        f32x4 v[4]; float ss = 0.f;
#pragma unroll
        for (int j = 0; j < 4; ++j) { v[j] = *(const f32x4*)(mem + (size_t)row * D + 4 * lane + 256 * j); ss += (v[j].x * v[j].x + v[j].y * v[j].y) + (v[j].z * v[j].z + v[j].w * v[j].w); }
        const float rs = rsqrtf(wave_sum(ss) * (1.f / D) + EPS);
#pragma unroll
        for (int j = 0; j < 4; ++j) { const f32x4 gg = *(const f32x4*)(g + 4 * lane + 256 * j); v[j] = v[j] * rs * gg;
            v2u o; o.x = pk2(v[j].x, v[j].y); o.y = pk2(v[j].z, v[j].w); *(v2u*)(mn + (size_t)row * D + 4 * lane + 256 * j) = o; }
    }
}
__device__ __forceinline__ void scan_logf(Frame& F, const float* logf, float* ccum) {
    if (blockIdx.x >= NBATCH * NFX) return;
    const int b = blockIdx.x / NFX, h = blockIdx.x % NFX, tid = F.tid;
    LAS float* wsum = (LAS float*)(F.lds + RING_OFF);
    float x[16]; float run = 0.f;
#pragma unroll
    for (int i = 0; i < 16; ++i) { run += logf[((size_t)b * SEQ + tid * 16 + i) * 8 + h]; x[i] = run; }
    float incl = run;
#pragma unroll
    for (int o = 1; o < 64; o <<= 1) { const float t = __shfl_up(incl, o); if (F.lane >= o) incl += t; }
    if (F.lane == 63) wsum[F.wave] = incl;
    LDS_WAIT(); __syncthreads();
    float base = incl - run;
    for (int w = 0; w < F.wave; ++w) base += wsum[w];
    float* o = ccum + ((size_t)b * NFX + h) * SEQ + tid * 16;
#pragma unroll
    for (int i = 0; i < 16; ++i) o[i] = (base + x[i]) * 1.4426950408889634f;
    __syncthreads();
}

__device__ __forceinline__ void pool_window(Frame& F, const bf16* proj, bf16* mix) {
    const int g0 = (F.vcu * NWAVES + F.wave) * 64 + F.lane, GS = F.G * NWAVES * 64;
    for (int it = g0; it < NTOK * 32; it += GS) {
        const int tok = it >> 5, ch = it & 31, pos = tok % SEQ, win = 2 << (ch >> 3), cnt = (pos + 1 < win) ? pos + 1 : win;
        const bf16* yp = proj + (size_t)tok * PP + C_U + 8 * ch;
        float a[8], y0[8];
        { const v4u q = *(const v4u*)yp; y0[0] = bflo(q.x); y0[1] = bfhi(q.x); y0[2] = bflo(q.y); y0[3] = bfhi(q.y); y0[4] = bflo(q.z); y0[5] = bfhi(q.z); y0[6] = bflo(q.w); y0[7] = bfhi(q.w); }
#pragma unroll
        for (int i = 0; i < 8; ++i) a[i] = y0[i];
        for (int j = 1; j < cnt; ++j) { const v4u q = *(const v4u*)(yp - (size_t)j * PP);
            a[0] += bflo(q.x); a[1] += bfhi(q.x); a[2] += bflo(q.y); a[3] += bfhi(q.y); a[4] += bflo(q.z); a[5] += bfhi(q.z); a[6] += bflo(q.w); a[7] += bfhi(q.w); }
        const float ic = 1.f / (float)cnt;
        v4u w; w.x = pk2(a[0] * ic - y0[0], a[1] * ic - y0[1]); w.y = pk2(a[2] * ic - y0[2], a[3] * ic - y0[3]); w.z = pk2(a[4] * ic - y0[4], a[5] * ic - y0[5]); w.w = pk2(a[6] * ic - y0[6], a[7] * ic - y0[7]);
        *(v4u*)(mix + (size_t)tok * D + SBD + FXD + 8 * ch) = w;
    }
}

typedef short bf16x8 __attribute__((ext_vector_type(8)));
typedef float f32x16 __attribute__((ext_vector_type(16)));
__device__ __forceinline__ int kperm(int r) { const int g = (r >> 2) & 3; const int g2 = (g == 1) ? 2 : (g == 2) ? 1 : g; return (r & 16) + 4 * g2 + (r & 3); }
__device__ __forceinline__ float xhalf(float v) { return __shfl_xor(v, 32); }
__device__ __forceinline__ bf16x8 pack8(const f32x16& p, int s) {
    v4u w; w.x = pg8::cvt_pk_bf16(p[8 * s + 0], p[8 * s + 1]); w.y = pg8::cvt_pk_bf16(p[8 * s + 2], p[8 * s + 3]); w.z = pg8::cvt_pk_bf16(p[8 * s + 4], p[8 * s + 5]); w.w = pg8::cvt_pk_bf16(p[8 * s + 6], p[8 * s + 7]);
    return __builtin_bit_cast(bf16x8, w);
}
__device__ __forceinline__ void store_ot(bf16* dst, const f32x16& o, float sc, int hh) {
#pragma unroll
    for (int g = 0; g < 4; ++g) { v2u w; w.x = pg8::cvt_pk_bf16(o[4 * g] * sc, o[4 * g + 1] * sc); w.y = pg8::cvt_pk_bf16(o[4 * g + 2] * sc, o[4 * g + 3] * sc); *(v2u*)(dst + 8 * g + 4 * hh) = w; }
}

__device__ __forceinline__ void fox_knorm(Frame& F, const bf16* proj, gu32* kmax) {
    const int gw = F.vcu * NWAVES + F.wave, NGW = F.G * NWAVES, lane = F.lane;
    const int NU = NBATCH * NFX * (SEQ / 64);
    for (int u = gw; u < NU; u += NGW) {
        const int bh = u / (SEQ / 64), tb = u % (SEQ / 64), b = bh / NFX, h = bh % NFX;
        const bf16* kr = proj + ((size_t)b * SEQ + tb * 64 + lane) * PP + C_FK + h * HD;
        float ss = 0.f;
#pragma unroll
        for (int i = 0; i < 8; ++i) { const v4u r = *(const v4u*)(kr + 8 * i);
            ss += (bflo(r.x) * bflo(r.x) + bfhi(r.x) * bfhi(r.x)) + (bflo(r.y) * bflo(r.y) + bfhi(r.y) * bfhi(r.y)) + (bflo(r.z) * bflo(r.z) + bfhi(r.z) * bfhi(r.z)) + (bflo(r.w) * bflo(r.w) + bfhi(r.w) * bfhi(r.w)); }
        ss = wave_max(ss);
        if (lane == 0) __hip_atomic_fetch_max(kmax + bh, __float_as_uint(ss), RLX_AGENT);
    }
}
#ifndef FOX_THR
#define FOX_THR 104.0f
#endif
constexpr int AT_STB = 8192 + 8192 + 256;
template <int FOX>
__device__ __forceinline__ void attn_wg(Frame& F, const bf16* proj, const bf16* vt, const float* ccum, const gu32* kmax, bf16* mix) {
    constexpr int NH = FOX ? NFX : NSB, COLQ = FOX ? C_FQ : C_SQ, COLK = FOX ? C_FK : C_SK, VROW0 = FOX ? SBD : 0, OCOL = FOX ? SBD : 0;
    constexpr float L2E = 1.4426950408889634f, SC = 0.125f * L2E;
    LAS unsigned char* L = F.lds + RING_OFF;
    LAS unsigned* flags = (LAS unsigned*)(L + 2 * AT_STB);
    const int tid = F.tid, lane = F.lane, wave = F.wave, r = lane & 31, hh = lane >> 5;
    const int srow = tid >> 3, sch = tid & 7, swr = srow * 128 + 16 * (sch ^ ((srow >> 1) & 7));
    const int krow = kperm(r), ksw = (krow >> 1) & 7, vsw = (r >> 1) & 7;
    const int NT = SEQ / 256, NU = NBATCH * NH * NT;
    for (int u = F.vcu; u < NU; u += F.G) {
        const int bh = u / NT, tile = (NT - 1) - u % NT, b = bh / NH, h = bh % NH, T0 = tile * 256, tq = T0 + 32 * wave + r, myblk = tile * 8 + wave;
        const size_t tokb = (size_t)b * SEQ;
        const float* cc = ccum + (size_t)bh * SEQ;
        const bf16* kg = proj + (tokb + srow) * PP + COLK + h * HD + 8 * sch;
        const bf16* vg = vt + (size_t)(VROW0 + h * HD + srow) * VTP + tokb + 8 * sch;
        bf16x8 qf[4]; float qn = 0.f;
        { const bf16* qp = proj + (tokb + tq) * PP + COLQ + h * HD + 8 * hh;
#pragma unroll
          for (int ks = 0; ks < 4; ++ks) { qf[ks] = *(const bf16x8*)(qp + 16 * ks);
              if (FOX) {
#pragma unroll
                  for (int j = 0; j < 8; ++j) { const float x = bf2f((bf16)qf[ks][j]); qn += x * x; } } } }
        float zb2 = 0.f, ct2 = 0.f;
        if (FOX) { qn += xhalf(qn); zb2 = (0.125f * sqrtf(qn * __uint_as_float(__hip_atomic_load(kmax + bh, RLX_AGENT))) * 1.01f + 0.01f) * L2E; ct2 = cc[tq]; }
        float l = 0.f, cb = 0.f, Rp = 1.f; f32x16 o[2] = {};
        bool mydone = false;
        const int nst = tile * 4 + 4;
        v4u gk, gv; float gc = 0.f;
        { const int k0 = T0 + 192; gk = *(const v4u*)(kg + (size_t)k0 * PP); gv = *(const v4u*)(vg + k0); if (FOX && tid < 64) gc = cc[k0 + tid]; }
        *(LAS v4u*)(L + swr) = gk; *(LAS v4u*)(L + 8192 + swr) = gv; if (FOX && tid < 64) *(LAS float*)(L + 16384 + 4 * tid) = gc;
        LDS_WAIT(); __syncthreads();
        for (int j = 0; j < nst; ++j) {
            const int k0 = T0 + 192 - 64 * j;
            LAS unsigned char* B = L + (j & 1) * AT_STB;
            if (j + 1 < nst) { const int k1 = k0 - 64; gk = *(const v4u*)(kg + (size_t)k1 * PP); gv = *(const v4u*)(vg + k1); if (FOX && tid < 64) gc = cc[k1 + tid]; }
#pragma unroll
            for (int sbi = 0; sbi < 2; ++sbi) {
                const int sb = 1 - sbi, blk = (k0 >> 5) + sb, s0 = k0 + 32 * sb;
                if (blk > myblk || mydone) continue;
                const bool diag = (blk == myblk);
                f32x16 S = {};
#pragma unroll
                for (int ks = 0; ks < 4; ++ks) { const bf16x8 kf = *(const LAS bf16x8*)(B + (32 * sb + krow) * 128 + 16 * ((2 * ks + hh) ^ ksw)); S = __builtin_amdgcn_mfma_f32_32x32x16_bf16(kf, qf[ks], S, 0, 0, 0); }
                if (FOX) {
                    f32x4 c4[4];
#pragma unroll
                    for (int s2 = 0; s2 < 2; ++s2) { c4[2 * s2] = *(const LAS f32x4*)(B + 16384 + 4 * (32 * sb + 16 * s2 + 8 * hh)); c4[2 * s2 + 1] = *(const LAS f32x4*)(B + 16384 + 4 * (32 * sb + 16 * s2 + 8 * hh + 4)); }
                    if (diag) {
                        float bm = -INFINITY;
#pragma unroll
                        for (int i = 0; i < 16; ++i) { const int key = s0 + 16 * (i >> 3) + 8 * hh + (i & 7); float x = S[i] * SC + (ct2 - c4[i >> 2][i & 3]); if (key > tq) x = -INFINITY; S[i] = x; bm = fmaxf(bm, x); }
                        bm = fmaxf(bm, xhalf(bm));
                        const float mref = fmaxf(bm, zb2 - 60.f * L2E); cb = ct2 - mref;
#pragma unroll
                        for (int i = 0; i < 16; ++i) { const float pv = __builtin_amdgcn_exp2f(S[i] - mref); S[i] = pv; l += pv; }
                    } else {
#pragma unroll
                        for (int i = 0; i < 16; ++i) { const float pv = __builtin_amdgcn_exp2f(S[i] * SC + (cb - c4[i >> 2][i & 3])); S[i] = pv; l += pv; }
                    }
                    mydone = __all(zb2 + (cb - c4[0][0]) + 13.f <= __log2f(l) - FOX_THR * L2E);
                } else {
                    float om[16];
#pragma unroll
                    for (int i = 0; i < 16; ++i) { const float e = __builtin_amdgcn_exp2f(fabsf(S[i]) * -SC);
                        const float sg = __builtin_amdgcn_rcpf(1.f + e), es = e * sg; const bool pos = S[i] >= 0.f; float bb = pos ? sg : es; float omb = pos ? es : sg;
                        if (diag) { const int key = s0 + 16 * (i >> 3) + 8 * hh + (i & 7); if (key >= tq) { bb = 0.f; omb = 1.f; } }
                        S[i] = bb; om[i] = omb; }
                    float TA = 1.f, TB = 1.f;
#pragma unroll
                    for (int jj = 7; jj >= 0; --jj) { const float a = om[jj], c2 = om[8 + jj]; S[jj] *= TA; S[8 + jj] *= TB; TA *= a; TB *= c2; }
                    const float PA = xhalf(TA), PB = xhalf(TB);
                    const float offB = Rp * (hh ? 1.f : PB), offA = Rp * TB * PB * (hh ? 1.f : PA);
#pragma unroll
                    for (int jj = 0; jj < 8; ++jj) { S[jj] *= offA; S[8 + jj] *= offB; }
                    Rp *= (TA * TB) * (PA * PB);
                    mydone = __all(Rp == 0.f);
                }
                const bf16x8 p0 = pack8(S, 0), p1 = pack8(S, 1);
#pragma unroll
                for (int db = 0; db < 2; ++db) {
                    const bf16x8 v0 = *(const LAS bf16x8*)(B + 8192 + (32 * db + r) * 128 + 16 * ((4 * sb + hh) ^ vsw)), v1 = *(const LAS bf16x8*)(B + 8192 + (32 * db + r) * 128 + 16 * ((4 * sb + 2 + hh) ^ vsw));
                    o[db] = __builtin_amdgcn_mfma_f32_32x32x16_bf16(v0, p0, o[db], 0, 0, 0); o[db] = __builtin_amdgcn_mfma_f32_32x32x16_bf16(v1, p1, o[db], 0, 0, 0); }
            }
            if (lane == 0) flags[(j & 1) * 8 + wave] = mydone ? 1u : 0u;
            if (j + 1 < nst) { LAS unsigned char* Bn = L + ((j + 1) & 1) * AT_STB; *(LAS v4u*)(Bn + swr) = gk; *(LAS v4u*)(Bn + 8192 + swr) = gv; if (FOX && tid < 64) *(LAS float*)(Bn + 16384 + 4 * tid) = gc; }
            LDS_WAIT(); __syncthreads();
            const v4u f0 = *(const LAS v4u*)(flags + (j & 1) * 8), f1 = *(const LAS v4u*)(flags + (j & 1) * 8 + 4);
            if ((f0.x & f0.y & f0.z & f0.w & f1.x & f1.y & f1.z & f1.w) != 0u) break;
        }
        float inv = 1.f;
        if (FOX) { l += xhalf(l); inv = 1.f / l; }
        bf16* op = mix + (tokb + tq) * D + OCOL + h * HD;
        store_ot(op, o[0], inv, hh); store_ot(op + 32, o[1], inv, hh);
        __syncthreads();
    }
}

__device__ __forceinline__ void xa_mfma(Frame& F, const bf16* xq, const bf16* xk, const bf16* xvt, bf16* xo) {
    const int gw = F.vcu * NWAVES + F.wave, NGW = F.G * NWAVES, lane = F.lane, r = lane & 31, hh = lane >> 5;
    const int NU = (NTOK / 32) * XAH;
    for (int u = gw; u < NU; u += NGW) {
        const int hd = u & 3, tb = u >> 2, tok0 = tb * 32, b = tok0 / SEQ;
        bf16x8 qf[16];
        { const bf16* qp = xq + (size_t)(tok0 + r) * D + hd * XAD + 8 * hh;
#pragma unroll
          for (int ks = 0; ks < 16; ++ks) qf[ks] = *(const bf16x8*)(qp + 16 * ks); }
        f32x16 S[8];
#pragma unroll
        for (int kb = 0; kb < 8; ++kb) {
            const bf16* kp = xk + (size_t)(b * MEML + kb * 32 + kperm(r)) * D + hd * XAD + 8 * hh;
            f32x16 acc = {};
#pragma unroll
            for (int ks = 0; ks < 16; ++ks) { const bf16x8 kf = *(const bf16x8*)(kp + 16 * ks); acc = __builtin_amdgcn_mfma_f32_32x32x16_bf16(kf, qf[ks], acc, 0, 0, 0); }
            S[kb] = acc;
        }
        float mx = -INFINITY;
#pragma unroll
        for (int kb = 0; kb < 8; ++kb)
#pragma unroll
            for (int i = 0; i < 16; ++i) mx = fmaxf(mx, S[kb][i]);
        mx = fmaxf(mx, xhalf(mx));
        float sm = 0.f;
#pragma unroll
        for (int kb = 0; kb < 8; ++kb)
#pragma unroll
            for (int i = 0; i < 16; ++i) { const float e = __expf((S[kb][i] - mx) * 0.0625f); S[kb][i] = e; sm += e; }
        sm += xhalf(sm);
        const float inv = 1.f / sm;
        bf16x8 pb[8][2];
#pragma unroll
        for (int kb = 0; kb < 8; ++kb) { pb[kb][0] = pack8(S[kb], 0); pb[kb][1] = pack8(S[kb], 1); }
#pragma unroll
        for (int half = 0; half < 2; ++half) {
            f32x16 o[4] = {};
            const bf16* vp = xvt + (size_t)(hd * XAD + half * 128 + r) * NMEM + b * MEML + 8 * hh;
#pragma unroll
            for (int kb = 0; kb < 8; ++kb)
#pragma unroll
                for (int s2 = 0; s2 < 2; ++s2)
#pragma unroll
                    for (int db = 0; db < 4; ++db) { const bf16x8 vf = *(const bf16x8*)(vp + (size_t)db * 32 * NMEM + kb * 32 + 16 * s2); o[db] = __builtin_amdgcn_mfma_f32_32x32x16_bf16(vf, pb[kb][s2], o[db], 0, 0, 0); }
#pragma unroll
            for (int db = 0; db < 4; ++db) store_ot(xo + (size_t)(tok0 + r) * D + hd * XAD + half * 128 + db * 32, o[db], inv, hh);
        }
    }
}
__device__ __forceinline__ void moe_offsets(const gu32* cnt, int (&pstart)[8], int& nblk) {
    int acc = 0;
#pragma unroll
    for (int e = 0; e < 8; ++e) { const int c = (int)__hip_atomic_load(cnt + e, RLX_AGENT); pstart[e] = acc; acc += ((c + 255) >> 8) << 8; }
    nblk = acc >> 8;
}
__device__ __forceinline__ void moe_gather(Frame& F, const bf16* hn, unsigned char* xs, int* tokt, int* blke) {
    int pstart[8], nblk; moe_offsets(F.ctl + CW_CNT, pstart, nblk);
    if (blockIdx.x == 0 && F.tid < MAXBLK + 1) {
        if (F.tid == MAXBLK) blke[MAXBLK] = nblk;
        else { int e = 0;
#pragma unroll
            for (int j = 1; j < 8; ++j) if (F.tid * 256 >= pstart[j]) e = j;
            blke[F.tid] = e; }
    }
    const int gw = F.vcu * NWAVES + F.wave, NGW = F.G * NWAVES, lane = F.lane;
    for (int row = gw; row < NTOK; row += NGW) {
        int* t = tokt + (size_t)row * 8; const int e0 = t[0], p0 = t[1], e1 = t[3], p1 = t[4];
        int s0 = 0, s1 = 0;
#pragma unroll
        for (int j = 0; j < 8; ++j) { s0 = (e0 == j) ? pstart[j] : s0; s1 = (e1 == j) ? pstart[j] : s1; }
        const int d0 = s0 + p0, d1 = s1 + p1;
        const v4u a = *(const v4u*)(hn + (size_t)row * D + 16 * lane), b = *(const v4u*)(hn + (size_t)row * D + 16 * lane + 8);
        v4u o;
        o.x = pg8::pack4_fp8(bflo(a.x) * 8.f, bfhi(a.x) * 8.f, bflo(a.y) * 8.f, bfhi(a.y) * 8.f); o.y = pg8::pack4_fp8(bflo(a.z) * 8.f, bfhi(a.z) * 8.f, bflo(a.w) * 8.f, bfhi(a.w) * 8.f);
        o.z = pg8::pack4_fp8(bflo(b.x) * 8.f, bfhi(b.x) * 8.f, bflo(b.y) * 8.f, bfhi(b.y) * 8.f); o.w = pg8::pack4_fp8(bflo(b.z) * 8.f, bfhi(b.z) * 8.f, bflo(b.w) * 8.f, bfhi(b.w) * 8.f);
        *(v4u*)(xs + (size_t)d0 * D + 16 * lane) = o; *(v4u*)(xs + (size_t)d1 * D + 16 * lane) = o;
        asm volatile("" ::: "memory");
        if (lane == 0) { t[1] = d0; t[4] = d1; }
    }
}

constexpr int NPHASE = 30;
__global__ void __launch_bounds__(NWAVES * 64, 2) fwd(Args args) {
    extern __shared__ __attribute__((aligned(16))) unsigned char lds[];
    Frame F;
    F.lds = (LAS unsigned char*)lds;
    F.tid = threadIdx.x; F.lane = F.tid & 63; F.wave = __builtin_amdgcn_readfirstlane(F.tid >> 6);
    F.roff = 0; F.G = gridDim.x; { const int bx = blockIdx.x; F.vcu = (F.G % 8 == 0) ? (bx % 8) * (F.G / 8) + bx / 8 : bx; }
    F.ctl = (gu32*)(args.ws + WS_CTL);
    volatile LAS unsigned* MISC = (volatile LAS unsigned*)(F.lds + MISC_OFF);
    for (int u = F.tid; u < (LDS_BYTES - LDSCTL_OFF) / 4; u += NWAVES * 64) ((LAS unsigned*)(F.lds + LDSCTL_OFF))[u] = 0u;
    __syncthreads();
    XcdBarrier bar; bar.bar = (unsigned*)(F.ctl + CW_BAR); bar.x = 0; bar.st = nullptr;
    const int lo = args.ph_lo, hi = args.ph_hi;
    if (hi - lo > 1) bar = xcd_barrier_post((unsigned*)(F.ctl + CW_BAR), MISC + 8);
#ifndef PHASE_MASK
#define PHASE_MASK 0xffffffffffull
#endif
#define IN(k) ((((unsigned long long)(PHASE_MASK) >> (k)) & 1ull) && lo <= (k) && (k) < hi && (fresh(F), true))
#define SEAM(k) do { if (IN(k) && IN((k) + 1)) xcd_barrier(bar); } while (0)
#ifndef PROBE_MASK
#define PROBE_MASK 0ull
#endif
#ifndef PROBE2_MASK
#define PROBE2_MASK 0
#endif
#define TWICE(bit, stmt) do { stmt; if ((PROBE2_MASK >> (bit)) & 1) { xcd_barrier(bar); stmt; } } while (0)
#define REP(k) for (int rep_ = 0; rep_ < (int)(1 + (((unsigned long long)(PROBE_MASK) >> (k)) & 1ull)); ++rep_, (rep_ < (int)(1 + (((unsigned long long)(PROBE_MASK) >> (k)) & 1ull)) ? xcd_barrier(bar) : (void)0))
#define ws WSB
#define scr ((LAS float*)(F.lds + RING_OFF + F.wave * 16384))
#define HN ((bf16*)(ws + R2_HN))
#define MIX ((bf16*)(ws + R2_MIX))
#define PROJ ((bf16*)(ws + R1_PROJ))
#define VT ((bf16*)(ws + R1_VT))
#define BA ((bf16*)(ws + R1_A))
#define BB ((bf16*)(ws + R1_B))
#define ACT ((bf16*)(ws + R1_ACT))
#define XS ((bf16*)(ws + R2_XS))
#define XS8 ((unsigned char*)(ws + WS_XS8))
#define ACT8 ((unsigned char*)(ws + R1_ACT8))
#define LOGF ((float*)(ws + WS_LOGF))
#define CCUM ((float*)(ws + WS_CCUM))
#define TOKT ((int*)(ws + WS_TOKT))
#define BLKE ((int*)(ws + WS_BLKE))
#define MN ((bf16*)(ws + WS_MN))
#define XKV ((bf16*)(ws + WS_XKV))
#define XK ((bf16*)(ws + WS_XKV))
#define XVT ((bf16*)(ws + WS_XKV + 2 * MiB))
    const int bx = (int)blockIdx.x;

#define GEMM_PLAIN(Aptr, Btptr, M_, N_, K_, Optr, ldc_) do { pg8::Gemm g{(const pg8::bf16_t*)(Aptr), (const pg8::bf16_t*)(Btptr), (M_), (N_), (K_)}; pg8::StaticOrder S; S.init(g, F.G, bx); \
        pg8::EpiBf16 E{(pg8::bf16_t*)(Optr), (ldc_), 0}; pg8::gemm_phase<pg8::EpiBf16, pg8::StaticOrder, true, true>(F.lds + RING_OFF, (K_), S, E); } while (0)

    if (IN(0)) REP(0) {
        convert_layer_small(F, 0, (bf16*)(ws + WS_WS0), scr);
        convert_layer_small(F, 1, (bf16*)(ws + WS_WS1), scr);
        transpose_gu(F, INP(I_DG), INP(I_DU), (bf16*)(ws + WS_WGU0), scr);
        transpose_mat(F, INP(I_DD), D, 0, D, DFF, (bf16*)(ws + WS_WD0), 0, scr);
        { float* wr = (float*)(ws + WS_WR); for (int i = (F.vcu * NWAVES + F.wave) * 64 + F.lane; i < 8 * D; i += F.G * NWAVES * 64) { const int e = i / D, k = i % D; wr[e * D + k] = INP(I_RW)[(size_t)k * NE + e]; } }
        mem_norm(F, INP(I_MEM), INP(I_MEMN), MN);
    }
    SEAM(0);
    if (IN(1)) REP(1) {
        thin_rows<0, false, true, 1>(F, INP(I_X), nullptr, nullptr, nullptr, INP(I_MIXPRE), HN, (const float*)(ws + WS_WF), INP(I_BF), LOGF, nullptr, nullptr);
    }
    SEAM(1);
#pragma unroll
    for (int l = 0; l < DEPTH; ++l) {
        const int p0 = (l == 0) ? 2 : 15;
        const bf16* WSL = (const bf16*)(ws + (l == 0 ? WS_WS0 : WS_WS1));
        const float* h_res = (l == 0) ? INP(I_X) : OUTP;
        if (IN(p0)) REP(p0) {
            scan_logf(F, LOGF, CCUM);
            GEMM_PLAIN(HN, WSL + OW_IN / 2, NTOK, PP, D, PROJ, PP);
            GEMM_PLAIN(WSL + OW_IN / 2 + (size_t)PP * D, HN, VTN, NTOK, D, VT, VTP);
            GEMM_PLAIN(MN, WSL + OW_KV / 2, NMEM, D, D, XK, D);
            GEMM_PLAIN(WSL + OW_KV / 2 + (size_t)D * D, MN, D, NMEM, D, XVT, NMEM);
        }
        SEAM(p0);
        if (IN(p0 + 1)) REP(p0 + 1) {
            TWICE(0, fox_knorm(F, PROJ, F.ctl + CW_KMAX + l * 24));
            TWICE(1, attn_wg<0>(F, PROJ, VT, nullptr, nullptr, MIX));
            TWICE(2, pool_window(F, PROJ, MIX));
        }
        SEAM(p0 + 1);
        if (IN(p0 + 2)) REP(p0 + 2) {
            attn_wg<1>(F, PROJ, VT, CCUM, F.ctl + CW_KMAX + l * 24, MIX);
        }
        SEAM(p0 + 2);
        if (IN(p0 + 3)) REP(p0 + 3) GEMM_PLAIN(MIX, WSL + OW_OUT / 2, NTOK, D, D, BA, D);
        SEAM(p0 + 3);
        if (IN(p0 + 4)) REP(p0 + 4) thin_rows<1, true, true, 0>(F, h_res, BA, INP(I_MIXPOST) + l * D, OUTP, INP(I_XAPRE) + l * D, HN, nullptr, nullptr, nullptr, nullptr, nullptr);
        SEAM(p0 + 4);
        if (IN(p0 + 5)) REP(p0 + 5) GEMM_PLAIN(HN, WSL + OW_Q / 2, NTOK, D, D, BB, D);
        SEAM(p0 + 5);
        if (IN(p0 + 6)) REP(p0 + 6) xa_mfma(F, BB, XK, XVT, BA);
        SEAM(p0 + 6);
        if (IN(p0 + 7)) REP(p0 + 7) GEMM_PLAIN(BA, WSL + OW_O / 2, NTOK, D, D, BB, D);
        SEAM(p0 + 7);
        if (l == 0) {
            if (IN(10)) REP(10) thin_rows<1, true, true, 0>(F, OUTP, BB, INP(I_XAPOST), OUTP, INP(I_FFPRE), HN, nullptr, nullptr, nullptr, nullptr, nullptr);
            SEAM(10);
            if (IN(11)) REP(11) { pg8::Gemm g{(const pg8::bf16_t*)HN, (const pg8::bf16_t*)(ws + WS_WGU0), NTOK, 2 * DFF, D}; pg8::StaticOrder S; S.init(g, F.G, bx);
                pg8::EpiSwiGLU E{(pg8::bf16_t*)ACT, DFF, 0}; pg8::gemm_phase<pg8::EpiSwiGLU, pg8::StaticOrder, true, true>(F.lds + RING_OFF, D, S, E); }
            SEAM(11);
            if (IN(12)) REP(12) GEMM_PLAIN(ACT, ws + WS_WD0, NTOK, D, DFF, MIX, D);
            SEAM(12);
            if (IN(13)) REP(13) thin_rows<1, true, true, 1>(F, OUTP, MIX, INP(I_FFPOST), OUTP, INP(I_MIXPRE) + D, HN, (const float*)(ws + WS_WF) + 8 * D, INP(I_BF) + NFX, LOGF, nullptr, nullptr);
            SEAM(13);
            if (IN(14)) REP(14) {
                for (int e = 0; e < NE; ++e) {
                    unsigned char* we = ws + WS_WMOE + (size_t)e * MOE_E_BYTES;
                    transpose_gu_f8(F, INP(I_MG) + (size_t)e * D * DFF, INP(I_MU) + (size_t)e * D * DFF, we);
                    transpose_mat_f8(F, INP(I_MD) + (size_t)e * DFF * D, D, D, DFF, we + MOE_GU_BYTES);
                }
                mem_norm(F, INP(I_MEM), INP(I_MEMN) + D, MN);
            }
            SEAM(14);
        } else {
            if (IN(23)) REP(23) thin_rows<1, true, true, 2>(F, OUTP, BB, INP(I_XAPOST) + D, OUTP, INP(I_FFPRE) + D, BA, (const float*)(ws + WS_WR), nullptr, nullptr, TOKT, F.ctl + CW_CNT);
            SEAM(23);
            if (IN(24)) REP(24) moe_gather(F, BA, XS8, TOKT, BLKE);
            SEAM(24);
#pragma unroll
            for (int ch = 0; ch < 2; ++ch) {
                const int nblk = BLKE[MAXBLK]; const int c0 = ch * CHUNK_BLK, c1 = (ch == 0) ? ((nblk < CHUNK_BLK) ? nblk : CHUNK_BLK) : nblk; const int nb = c1 > c0 ? c1 - c0 : 0;
                if (IN(25 + 2 * ch)) REP(25 + 2 * ch) { pg8::MoeOrder S{nb, 2 * DFF / 256, F.G, bx, c0, 0, (const char*)XS8, (const char*)(ws + WS_WMOE), (size_t)256 * D, MOE_E_BYTES, BLKE};
                    pg8::EpiSwiGLU8 E{ACT8, DFF, c0, 1.f / 2048.f, 8.f}; pg8::gemm_phase<pg8::EpiSwiGLU8, pg8::MoeOrder, true, true, true>(F.lds + RING_OFF, D / 2, S, E); }
                SEAM(25 + 2 * ch);
                if (IN(26 + 2 * ch)) REP(26 + 2 * ch) { pg8::MoeOrder S{nb, D / 256, F.G, bx, c0, c0, (const char*)ACT8, (const char*)(ws + WS_WMOE + MOE_GU_BYTES), (size_t)256 * DFF, MOE_E_BYTES, BLKE};
                    pg8::EpiBf16S E{(pg8::bf16_t*)XS, D, 0, 1.f / 2048.f}; pg8::gemm_phase<pg8::EpiBf16S, pg8::MoeOrder, true, true, true>(F.lds + RING_OFF, DFF / 2, S, E); }
                SEAM(26 + 2 * ch);
            }
            if (IN(29)) REP(29) thin_rows<2, true, false, 0>(F, OUTP, XS, INP(I_FFPOST) + D, OUTP, nullptr, nullptr, nullptr, nullptr, nullptr, TOKT, nullptr);
        }
    }
#undef IN
#undef SEAM
#undef ws
#undef scr
#undef HN
#undef MIX
#undef PROJ
#undef VT
#undef BA
#undef BB
#undef ACT
#undef XS
#undef XS8
#undef ACT8
#undef LOGF
#undef CCUM
#undef TOKT
#undef BLKE
#undef MN
#undef XKV
#undef XK
#undef XVT
}

extern "C" void kernel_launch(void* const* d_in, const int* in_sizes, int n_in, void* d_out, int out_size, void* d_ws, size_t ws_size, hipStream_t stream) {
    static int grid = 0;
    if (grid == 0) {
        if (n_in != 24 || in_sizes[0] != NTOK * D || out_size != NTOK * D || ws_size < WS_END) { fprintf(stderr, "kernel_launch: unexpected shapes / workspace (%d inputs, ws %zu < %zu)\n", n_in, ws_size, (size_t)WS_END); grid = -1; return; }
        int dev = 0, cus = 0, per_cu = 0;
        if (hipGetDevice(&dev) != hipSuccess || hipDeviceGetAttribute(&cus, hipDeviceAttributeMultiprocessorCount, dev) != hipSuccess) { grid = -1; return; }
        if (hipFuncSetAttribute((const void*)fwd, hipFuncAttributeMaxDynamicSharedMemorySize, LDS_BYTES) != hipSuccess) { fprintf(stderr, "kernel_launch: hipFuncSetAttribute failed\n"); grid = -1; return; }
        if (hipOccupancyMaxActiveBlocksPerMultiprocessor(&per_cu, (const void*)fwd, NWAVES * 64, LDS_BYTES) != hipSuccess || per_cu < 1) { fprintf(stderr, "kernel_launch: occupancy query reports %d\n", per_cu); }
        (void)hipGetLastError();
        grid = cus;
    }
    if (grid < 0) return;
    (void)hipMemsetAsync((char*)d_ws + WS_CTL, 0, CTL_ZERO_BYTES, stream);
    Args a{};
    for (int i = 0; i < 24; ++i) a.in[i] = (const float*)d_in[i];
    a.out = (float*)d_out; a.ws = (unsigned char*)d_ws;
#if MK_ONE_LAUNCH
    a.ph_lo = 0; a.ph_hi = NPHASE;
    hipLaunchKernelGGL(fwd, dim3(grid), dim3(NWAVES * 64), LDS_BYTES, stream, a);
#else
    for (int p = 0; p < NPHASE; ++p) {
        a.ph_lo = p; a.ph_hi = p + 1;
        hipLaunchKernelGGL(fwd, dim3(grid), dim3(NWAVES * 64), LDS_BYTES, stream, a);
    }
#endif
}
```

```cpp
#include <hip/hip_runtime.h>
#include <cstdio>
#include <cstdint>

#ifndef MK_ONE_LAUNCH
#define MK_ONE_LAUNCH 1
#endif

namespace pg8 {
#define PG8_LAS __attribute__((address_space(3)))
typedef unsigned short bf16_t;
typedef short bf16x8 __attribute__((ext_vector_type(8)));
typedef float f32x4 __attribute__((ext_vector_type(4)));
typedef unsigned u32x4 __attribute__((ext_vector_type(4)));
constexpr int BM = 256, BK = 64, HALF = 128, HTB = HALF * BK * 2  , STAGE_BYTES = 8 * HTB, NXCD = 8, WGM = 8;

__host__ __device__ __forceinline__ int lds_byte(int r, int c) { const int st = (r >> 4) * 2 + (c >> 5), rr = r & 15, cc = c & 31, ob = rr * 64 + cc * 2; return st * 1024 + (ob ^ (((ob >> 9) & 1) << 5)); }
__host__ __device__ __forceinline__ void stage_rc(int b, int& R, int& C) { const int st = b / 1024, sb = b % 1024, swz = sb ^ (((sb >> 9) & 1) << 5); R = (st >> 1) * 16 + swz / 64; C = (st & 1) * 32 + (swz % 64) / 2; }
__host__ __device__ __forceinline__ int perm32(int rho) { const int n = rho >> 4, i = rho & 15; return 8 * (i >> 2) + 4 * n + (i & 3); }

struct Unit { int pm, pn; const char* a; const char* b; };
struct Gemm { const bf16_t* A; const bf16_t* Bt; int M, N, K; };

__device__ __forceinline__ bool order_map(int i, int G, int c, int nM, int nN, int& pm, int& pn) {
    const int nwg = nM * nN; const long L = (long)i * G + c; if (L >= nwg) return false;
    int wgid = (int)L; { const int q = nwg / NXCD, r = nwg % NXCD, xcd = wgid % NXCD, off = wgid / NXCD; wgid = (xcd < r ? xcd * (q + 1) : r * (q + 1) + (xcd - r) * q) + off; }
    const int nig = WGM * nN, gid = wgid / nig, fm = gid * WGM, gsz = (nM - fm) < WGM ? (nM - fm) : WGM;
    pm = fm + ((wgid % nig) % gsz); pn = (wgid % nig) / gsz; return true;
}
struct StaticOrder {
    int nM, nN, G, c; const char* A; const char* B; size_t tstep;
    __device__ void init(const Gemm& g, int G_, int c_) { nM = g.M / BM; nN = g.N / BM; G = G_; c = c_; A = (const char*)g.A; B = (const char*)g.Bt; tstep = (size_t)BM * g.K * 2; }
    __device__ __forceinline__ bool next(int i, Unit& u) const {
        if (!order_map(i, G, c, nM, nN, u.pm, u.pn)) return false;
        u.a = A + (size_t)u.pm * tstep; u.b = B + (size_t)u.pn * tstep; return true;
    }
};
struct MoeOrder {
    int nM, nN, G, c, pb0, pbA; const char* A; const char* W; size_t tstep, wstride; const int* blk_e;
    __device__ __forceinline__ bool next(int i, Unit& u) const {
        int pm, pn; if (!order_map(i, G, c, nM, nN, pm, pn)) return false;
        u.pm = pb0 + pm; u.pn = pn; const int e = __builtin_amdgcn_readfirstlane(blk_e[u.pm]);
        u.a = A + (size_t)(u.pm - pbA) * tstep; u.b = W + (size_t)e * wstride + (size_t)pn * tstep; return true;
    }
};

__device__ __forceinline__ unsigned cvt_pk_bf16(float lo, float hi) { unsigned r; asm volatile("v_cvt_pk_bf16_f32 %0, %1, %2" : "=v"(r) : "v"(lo), "v"(hi)); return r; }

struct EpiBf16 {
    static constexpr bool PERM = true;
    bf16_t* O; int ldc; int pm_off;
    __device__ __forceinline__ void operator()(const f32x4 (&acc)[2][2][4][2], const Unit& u, int wr, int wc, int fr, int fq) const {
        const int row0 = (u.pm - pm_off) * BM + wr * 64 + fr; const int col0 = u.pn * BM + wc * 32 + 8 * fq;
#pragma unroll
        for (int ai = 0; ai < 2; ++ai)
#pragma unroll
            for (int m = 0; m < 4; ++m) { bf16_t* rowp = O + (size_t)(row0 + ai * HALF + m * 16) * ldc + col0;
#pragma unroll
                for (int bj = 0; bj < 2; ++bj) { const f32x4 v0 = acc[ai][bj][m][0], v1 = acc[ai][bj][m][1];
                    u32x4 w; w.x = cvt_pk_bf16(v0[0], v0[1]); w.y = cvt_pk_bf16(v0[2], v0[3]); w.z = cvt_pk_bf16(v1[0], v1[1]); w.w = cvt_pk_bf16(v1[2], v1[3]);
                    *(u32x4*)(rowp + bj * HALF) = w; } }
    }
};
__device__ __forceinline__ float silu_mul(float g, float u) { return g * __builtin_amdgcn_rcpf(1.0f + __expf(-g)) * u; }
struct EpiSwiGLU {
    static constexpr bool PERM = true;
    bf16_t* O; int ldc; int pm_off;
    __device__ __forceinline__ void operator()(const f32x4 (&acc)[2][2][4][2], const Unit& u, int wr, int wc, int fr, int fq) const {
        const int row0 = (u.pm - pm_off) * BM + wr * 64 + fr; const int col0 = u.pn * HALF + wc * 32 + 8 * fq;
#pragma unroll
        for (int ai = 0; ai < 2; ++ai)
#pragma unroll
            for (int m = 0; m < 4; ++m) { bf16_t* rowp = O + (size_t)(row0 + ai * HALF + m * 16) * ldc + col0;
                const f32x4 g0 = acc[ai][0][m][0], g1 = acc[ai][0][m][1], u0 = acc[ai][1][m][0], u1 = acc[ai][1][m][1];
                u32x4 w; w.x = cvt_pk_bf16(silu_mul(g0[0], u0[0]), silu_mul(g0[1], u0[1])); w.y = cvt_pk_bf16(silu_mul(g0[2], u0[2]), silu_mul(g0[3], u0[3]));
                w.z = cvt_pk_bf16(silu_mul(g1[0], u1[0]), silu_mul(g1[1], u1[1])); w.w = cvt_pk_bf16(silu_mul(g1[2], u1[2]), silu_mul(g1[3], u1[3]));
                *(u32x4*)rowp = w; }
    }
};


__device__ __forceinline__ float clamp448(float x) { return __builtin_amdgcn_fmed3f(x, -448.f, 448.f); }
__device__ __forceinline__ unsigned pack4_fp8(float a, float b, float c, float d) { unsigned w = 0; w = __builtin_amdgcn_cvt_pk_fp8_f32(clamp448(a), clamp448(b), w, false); w = __builtin_amdgcn_cvt_pk_fp8_f32(clamp448(c), clamp448(d), w, true); return w; }
struct EpiBf16S {
    static constexpr bool PERM = true;
    bf16_t* O; int ldc; int pm_off; float sc;
    __device__ __forceinline__ void operator()(const f32x4 (&acc)[2][2][4][2], const Unit& u, int wr, int wc, int fr, int fq) const {
        const int row0 = (u.pm - pm_off) * BM + wr * 64 + fr; const int col0 = u.pn * BM + wc * 32 + 8 * fq;
#pragma unroll
        for (int ai = 0; ai < 2; ++ai)
#pragma unroll
            for (int m = 0; m < 4; ++m) { bf16_t* rowp = O + (size_t)(row0 + ai * HALF + m * 16) * ldc + col0;
#pragma unroll
                for (int bj = 0; bj < 2; ++bj) { const f32x4 v0 = acc[ai][bj][m][0] * sc, v1 = acc[ai][bj][m][1] * sc;
                    u32x4 w; w.x = cvt_pk_bf16(v0[0], v0[1]); w.y = cvt_pk_bf16(v0[2], v0[3]); w.z = cvt_pk_bf16(v1[0], v1[1]); w.w = cvt_pk_bf16(v1[2], v1[3]);
                    *(u32x4*)(rowp + bj * HALF) = w; } }
    }
};
struct EpiSwiGLU8 {
    static constexpr bool PERM = true;
    unsigned char* O; int ldc; int pm_off; float sc_in, sc_out;
    __device__ __forceinline__ void operator()(const f32x4 (&acc)[2][2][4][2], const Unit& u, int wr, int wc, int fr, int fq) const {
        typedef unsigned u32x2 __attribute__((ext_vector_type(2)));
        const int row0 = (u.pm - pm_off) * BM + wr * 64 + fr; const int col0 = u.pn * HALF + wc * 32 + 8 * fq;
#pragma unroll
        for (int ai = 0; ai < 2; ++ai)
#pragma unroll
            for (int m = 0; m < 4; ++m) { unsigned char* rowp = O + (size_t)(row0 + ai * HALF + m * 16) * ldc + col0;
                const f32x4 g0 = acc[ai][0][m][0] * sc_in, g1 = acc[ai][0][m][1] * sc_in, u0 = acc[ai][1][m][0] * sc_in, u1 = acc[ai][1][m][1] * sc_in;
                u32x2 w; w.x = pack4_fp8(silu_mul(g0[0], u0[0]) * sc_out, silu_mul(g0[1], u0[1]) * sc_out, silu_mul(g0[2], u0[2]) * sc_out, silu_mul(g0[3], u0[3]) * sc_out);
                w.y = pack4_fp8(silu_mul(g1[0], u1[0]) * sc_out, silu_mul(g1[1], u1[1]) * sc_out, silu_mul(g1[2], u1[2]) * sc_out, silu_mul(g1[3], u1[3]) * sc_out);
                *(u32x2*)rowp = w; __builtin_amdgcn_sched_barrier(0); }
    }
};

struct XaOrder {
    int G, c, mode; const char* A; const char* B;
    __device__ __forceinline__ bool next(int i, Unit& u) const {
        const int L = i * G + c; if (L >= 512) return false;
        u.pm = L >> 2; u.pn = L & 3; const int b = u.pm >> 5;
        u.a = A + (size_t)u.pm * 256 * 2048 + u.pn * 512;
        u.b = mode == 0 ? B + (size_t)(b * 256) * 2048 + u.pn * 512 : B + (size_t)(u.pn * 256) * 2048 + b * 512;
        return true;
    }
};
struct EpiXaSoftmax {
    static constexpr bool PERM = true;
    bf16_t* P; PG8_LAS float* tab;
    __device__ __forceinline__ void operator()(f32x4 (&acc)[2][2][4][2], const Unit& u, int wr, int wc, int fr, int fq) const {
        constexpr float SCL2 = 0.0625f * 1.4426950408889634f;
#pragma unroll
        for (int ai = 0; ai < 2; ++ai)
#pragma unroll
            for (int m = 0; m < 4; ++m) { float v = -INFINITY;
#pragma unroll
                for (int bj = 0; bj < 2; ++bj)
#pragma unroll
                    for (int n = 0; n < 2; ++n) { const f32x4 x = acc[ai][bj][m][n]; v = fmaxf(fmaxf(v, fmaxf(x[0], x[1])), fmaxf(x[2], x[3])); }
                v = fmaxf(v, __shfl_xor(v, 16)); v = fmaxf(v, __shfl_xor(v, 32));
                if (fq == 0) tab[(ai * HALF + wr * 64 + m * 16 + fr) * 4 + wc] = v; }
        asm volatile("s_waitcnt lgkmcnt(0)" ::: "memory"); __builtin_amdgcn_s_barrier(); asm volatile("" ::: "memory");
#pragma unroll
        for (int ai = 0; ai < 2; ++ai)
#pragma unroll
            for (int m = 0; m < 4; ++m) { const int rr = ai * HALF + wr * 64 + m * 16 + fr; const f32x4 t = *(const PG8_LAS f32x4*)(tab + rr * 4);
                const float mx = fmaxf(fmaxf(t[0], t[1]), fmaxf(t[2], t[3])) * SCL2; float sm = 0.f;
#pragma unroll
                for (int bj = 0; bj < 2; ++bj)
#pragma unroll
                    for (int n = 0; n < 2; ++n) { f32x4 x = acc[ai][bj][m][n];
#pragma unroll
                        for (int i = 0; i < 4; ++i) { x[i] = __builtin_amdgcn_exp2f(x[i] * SCL2 - mx); sm += x[i]; }
                        acc[ai][bj][m][n] = x; }
                sm += __shfl_xor(sm, 16); sm += __shfl_xor(sm, 32);
                if (fq == 0) tab[1024 + rr * 4 + wc] = sm; }
        asm volatile("s_waitcnt lgkmcnt(0)" ::: "memory"); __builtin_amdgcn_s_barrier(); asm volatile("" ::: "memory");
        const int row0 = u.pm * BM + wr * 64 + fr; const int col0 = u.pn * BM + wc * 32 + 8 * fq;
#pragma unroll
        for (int ai = 0; ai < 2; ++ai)
#pragma unroll
            for (int m = 0; m < 4; ++m) { const int rr = ai * HALF + wr * 64 + m * 16 + fr; const f32x4 t = *(const PG8_LAS f32x4*)(tab + 1024 + rr * 4);
                const float inv = 1.f / ((t[0] + t[1]) + (t[2] + t[3]));
                bf16_t* rowp = P + (size_t)(row0 + ai * HALF + m * 16) * 1024 + col0;
#pragma unroll
                for (int bj = 0; bj < 2; ++bj) { const f32x4 v0 = acc[ai][bj][m][0] * inv, v1 = acc[ai][bj][m][1] * inv;
                    u32x4 w; w.x = cvt_pk_bf16(v0[0], v0[1]); w.y = cvt_pk_bf16(v0[2], v0[3]); w.z = cvt_pk_bf16(v1[0], v1[1]); w.w = cvt_pk_bf16(v1[2], v1[3]);
                    *(u32x4*)(rowp + bj * HALF) = w; } }
    }
};

typedef int v8i32 __attribute__((ext_vector_type(8)));
typedef int v4i32 __attribute__((ext_vector_type(4)));
__device__ __forceinline__ v8i32 cat8(bf16x8 a, bf16x8 b) { return __builtin_shufflevector(__builtin_bit_cast(v4i32, a), __builtin_bit_cast(v4i32, b), 0, 1, 2, 3, 4, 5, 6, 7); }
template <class Epi, class Sched, bool ALIGN_EPI = false, bool SP2 = false, bool F8 = false>
__device__ __forceinline__ void gemm_phase(PG8_LAS unsigned char* lds, const int K, const Sched& S, const Epi& E, const int lda = 0, const int ldb = 0) {
    int tid_ = threadIdx.x; asm volatile("" : "+v"(tid_));
    const int tid = tid_, wid = __builtin_amdgcn_readfirstlane(tid >> 6), lane = tid & 63, wr = wid >> 2, wc = wid & 3, fr = lane & 15, fq = lane >> 4;
    const int nt = K / BK, pa = lda ? lda : K, pb = ldb ? ldb : K;
    unsigned voffA[2], voffB[2];
#pragma unroll
    for (int i = 0; i < 2; ++i) { int R, C; stage_rc(tid * 16 + i * 8192, R, C); const int Rb = Epi::PERM ? ((R & ~31) + perm32(R & 31)) : R;
        voffA[i] = (unsigned)(R * pa + C) * 2u; voffB[i] = (unsigned)(Rb * pb + C) * 2u; }
    const size_t kstep = (size_t)(BK * 2);
    const size_t hstepA = (size_t)HALF * pa * 2, hstepB = (size_t)HALF * pb * 2;
    const unsigned ldsw = (unsigned)wid * 1024u;
    const int aoff = lds_byte(wr * 64 + fr, fq * 8), boff = lds_byte(wc * 32 + fr, fq * 8);
#define PG8_SA(b, h) (((b) * 2 + (h)) * HTB)
#define PG8_SB(b, h) ((4 + (b) * 2 + (h)) * HTB)
#define PG8_STAGE(bufoff, gbase, voff) do { _Pragma("unroll") for (int _i = 0; _i < 2; ++_i) \
        __builtin_amdgcn_global_load_lds((const unsigned*)((const char*)(gbase) + (voff)[_i]), (PG8_LAS unsigned*)(lds + (bufoff) + ldsw + _i * 8192), 16, 0, 0); } while (0)
#define PG8_LDA(dst, b, h) do { _Pragma("unroll") for (int m = 0; m < 4; ++m) { if constexpr (F8) { dst##8[m].lo = *(const PG8_LAS v4i32*)(lds + PG8_SA(b, h) + aoff + m * 2048); dst##8[m].hi = *(const PG8_LAS v4i32*)(lds + PG8_SA(b, h) + aoff + m * 2048 + 1024); } \
        else { _Pragma("unroll") for (int k = 0; k < 2; ++k) dst[m][k] = *(const PG8_LAS bf16x8*)(lds + PG8_SA(b, h) + aoff + m * 2048 + k * 1024); } } } while (0)
#define PG8_LDB(dst, b, h) do { _Pragma("unroll") for (int n = 0; n < 2; ++n) { if constexpr (F8) { dst##8[n].lo = *(const PG8_LAS v4i32*)(lds + PG8_SB(b, h) + boff + n * 2048); dst##8[n].hi = *(const PG8_LAS v4i32*)(lds + PG8_SB(b, h) + boff + n * 2048 + 1024); } \
        else { _Pragma("unroll") for (int k = 0; k < 2; ++k) dst[n][k] = *(const PG8_LAS bf16x8*)(lds + PG8_SB(b, h) + boff + n * 2048 + k * 1024); } } } while (0)
#define PG8_MMA(ai, bj, At, Bt) do { __builtin_amdgcn_s_setprio(1); _Pragma("unroll") for (int m = 0; m < 4; ++m) _Pragma("unroll") for (int n = 0; n < 2; ++n) { \
        if constexpr (F8) asm volatile("v_mfma_scale_f32_16x16x128_f8f6f4 %0, %1, %2, %0, %3, %3 op_sel_hi:[0,0,0]" : "+v"(acc[ai][bj][m][n]) : "v"(Bt##8[n]), "v"(At##8[m]), "v"(f8scale)); \
        else { _Pragma("unroll") for (int k = 0; k < 2; ++k) acc[ai][bj][m][n] = __builtin_amdgcn_mfma_f32_16x16x32_bf16(Bt[n][k], At[m][k], acc[ai][bj][m][n], 0, 0, 0); } } __builtin_amdgcn_s_setprio(0); } while (0)
#define PG8_WAIT_V(n) asm volatile("s_waitcnt vmcnt(" #n ")" ::: "memory")
#define PG8_WAIT_L(n) asm volatile("s_waitcnt lgkmcnt(" #n ")" ::: "memory")
#define PG8_BAR __builtin_amdgcn_s_barrier()
#define PG8_SCHED __builtin_amdgcn_sched_barrier(0)
    Unit cur, nxt; int ui = 0;
    if (!S.next(0, cur)) return;
    f32x4 acc[2][2][4][2];
#pragma unroll
    for (int a = 0; a < 2; ++a)
#pragma unroll
        for (int b = 0; b < 2; ++b)
#pragma unroll
            for (int m = 0; m < 4; ++m)
#pragma unroll
                for (int n = 0; n < 2; ++n) acc[a][b][m][n] = (f32x4){0.f, 0.f, 0.f, 0.f};
    bf16x8 At[4][2], B0[2][2], B1[2][2]; v8i32 At8[4], B08[2], B18[2];
    int f8scale = 0x7F7F7F7F; asm volatile("" : "+v"(f8scale));
    const char* cA = cur.a; const char* cB = cur.b;
    if constexpr (SP2) {
        PG8_STAGE(PG8_SB(0, 0), cB, voffB); PG8_STAGE(PG8_SB(0, 1), cB + hstepB, voffB); PG8_STAGE(PG8_SA(0, 0), cA, voffA); PG8_STAGE(PG8_SA(0, 1), cA + hstepA, voffA);
        if (wr == 1) PG8_BAR;
        PG8_WAIT_V(2); PG8_BAR;
        PG8_STAGE(PG8_SB(1, 0), cB + kstep, voffB); PG8_STAGE(PG8_SA(1, 0), cA + kstep, voffA); PG8_STAGE(PG8_SB(1, 1), cB + hstepB + kstep, voffB);
        PG8_WAIT_V(6); PG8_BAR;
    } else {
        PG8_STAGE(PG8_SB(0, 0), cB, voffB); PG8_STAGE(PG8_SA(0, 0), cA, voffA); PG8_STAGE(PG8_SB(0, 1), cB + hstepB, voffB); PG8_STAGE(PG8_SA(0, 1), cA + hstepA, voffA);
        if (wr == 1) PG8_BAR;
        PG8_WAIT_V(4); PG8_BAR;
        PG8_STAGE(PG8_SB(1, 0), cB + kstep, voffB); PG8_STAGE(PG8_SA(1, 0), cA + kstep, voffA); PG8_STAGE(PG8_SB(1, 1), cB + hstepB + kstep, voffB);
        PG8_WAIT_V(6); PG8_BAR;
    }
    for (;;) {
        const bool has_next = S.next(ui + 1, nxt);
        const char* nA = has_next ? nxt.a : cA; const char* nB = has_next ? nxt.b : cB;
#pragma nounroll
        for (int t = 0; t < nt; t += 2) {
            const bool last = (t == nt - 2);
            const char* a1 = cA + (size_t)(t + 1) * kstep;
            const char* a2 = last ? nA : cA + (size_t)(t + 2) * kstep; const char* b2 = last ? nB : cB + (size_t)(t + 2) * kstep;
            const char* a3 = a2 + kstep; const char* b3 = b2 + kstep;
            if constexpr (SP2) {
            PG8_LDB(B0, 0, 0); PG8_LDB(B1, 0, 1); PG8_SCHED; PG8_LDA(At, 0, 0); PG8_STAGE(PG8_SA(1, 1), a1 + hstepA, voffA);
            PG8_WAIT_V(8); PG8_WAIT_L(0); PG8_BAR; PG8_MMA(0, 0, At, B0); PG8_MMA(0, 1, At, B1); PG8_BAR; PG8_SCHED;
            PG8_LDA(At, 0, 1); PG8_STAGE(PG8_SB(0, 0), b2, voffB); PG8_STAGE(PG8_SB(0, 1), b2 + hstepB, voffB); PG8_STAGE(PG8_SA(0, 0), a2, voffA);
            PG8_WAIT_V(8); PG8_WAIT_L(0); PG8_BAR; PG8_MMA(1, 0, At, B0); PG8_MMA(1, 1, At, B1); PG8_BAR; PG8_SCHED;
            PG8_LDB(B0, 1, 0); PG8_LDB(B1, 1, 1); PG8_SCHED; PG8_LDA(At, 1, 0); PG8_STAGE(PG8_SA(0, 1), a2 + hstepA, voffA);
            PG8_WAIT_V(8); PG8_WAIT_L(0); PG8_BAR; PG8_MMA(0, 0, At, B0); PG8_MMA(0, 1, At, B1); PG8_BAR; PG8_SCHED;
            PG8_LDA(At, 1, 1); PG8_STAGE(PG8_SB(1, 0), b3, voffB); PG8_STAGE(PG8_SB(1, 1), b3 + hstepB, voffB); PG8_STAGE(PG8_SA(1, 0), a3, voffA);
            PG8_WAIT_V(8); PG8_WAIT_L(0); PG8_BAR; PG8_MMA(1, 0, At, B0); PG8_MMA(1, 1, At, B1); PG8_BAR; PG8_SCHED;
            } else {
            PG8_LDB(B0, 0, 0); PG8_SCHED; PG8_LDA(At, 0, 0); PG8_STAGE(PG8_SA(1, 1), a1 + hstepA, voffA);
            PG8_WAIT_L(8); PG8_BAR; PG8_WAIT_L(0); PG8_MMA(0, 0, At, B0); PG8_BAR; PG8_SCHED;
            PG8_LDB(B1, 0, 1); PG8_STAGE(PG8_SB(0, 0), b2, voffB);
            PG8_BAR; PG8_WAIT_L(0); PG8_MMA(0, 1, At, B1); PG8_BAR;
            PG8_LDA(At, 0, 1); PG8_STAGE(PG8_SA(0, 0), a2, voffA);
            PG8_BAR; PG8_WAIT_L(0); PG8_MMA(1, 0, At, B0); PG8_BAR; PG8_SCHED;
            PG8_STAGE(PG8_SB(0, 1), b2 + hstepB, voffB);
            PG8_WAIT_V(6); PG8_BAR; PG8_MMA(1, 1, At, B1); PG8_BAR;
            PG8_LDB(B0, 1, 0); PG8_SCHED; PG8_LDA(At, 1, 0); PG8_STAGE(PG8_SA(0, 1), a2 + hstepA, voffA);
            PG8_WAIT_L(8); PG8_BAR; PG8_WAIT_L(0); PG8_MMA(0, 0, At, B0); PG8_BAR; PG8_SCHED;
            PG8_LDB(B1, 1, 1); PG8_STAGE(PG8_SB(1, 0), b3, voffB);
            PG8_BAR; PG8_WAIT_L(0); PG8_MMA(0, 1, At, B1); PG8_BAR;
            PG8_LDA(At, 1, 1); PG8_STAGE(PG8_SA(1, 0), a3, voffA);
            PG8_BAR; PG8_WAIT_L(0); PG8_MMA(1, 0, At, B0); PG8_BAR; PG8_SCHED;
            PG8_STAGE(PG8_SB(1, 1), b3 + hstepB, voffB);
            PG8_WAIT_V(6); PG8_BAR; PG8_MMA(1, 1, At, B1); PG8_BAR;
            }
        }
        if constexpr (F8) asm volatile("s_nop 15\n\ts_nop 15" ::: "memory");
        if constexpr (ALIGN_EPI) { if (wr == 0) PG8_BAR; }
        E(acc, cur, wr, wc, fr, fq);
        if (!has_next) break;
#pragma unroll
        for (int a = 0; a < 2; ++a)
#pragma unroll
            for (int b = 0; b < 2; ++b)
#pragma unroll
                for (int m = 0; m < 4; ++m)
#pragma unroll
                    for (int n = 0; n < 2; ++n) acc[a][b][m][n] = (f32x4){0.f, 0.f, 0.f, 0.f};
        cur = nxt; cA = nA; cB = nB; ++ui;
        if constexpr (ALIGN_EPI) { if (wr == 1) PG8_BAR; }
    }
    PG8_WAIT_V(0);
    if constexpr (!ALIGN_EPI) { if (wr == 0) PG8_BAR; }
    PG8_BAR;
#undef PG8_SA
#undef PG8_SB
#undef PG8_STAGE
#undef PG8_LDA
#undef PG8_LDB
#undef PG8_MMA
#undef PG8_WAIT_V
#undef PG8_WAIT_L
#undef PG8_BAR
#undef PG8_SCHED
}
}

constexpr int NBATCH = 4, SEQ = 8192, D = 1024, NTOK = NBATCH * SEQ, DEPTH = 2;
constexpr int HD = 64, NSB = 6, NFX = 6, SBD = 384, FXD = 384, POOLD = 256, CIN = 2566;
constexpr int MEML = 256, NMEM = NBATCH * MEML, XAH = 4, XAD = 256;
constexpr int DFF = 2816, NE = 8;
constexpr float EPS = 1e-6f;
constexpr int PP = 1792, C_SQ = 0, C_SK = 384, C_FQ = 768, C_FK = 1152, C_U = 1536;
constexpr int VTN = 768, VTP = NTOK + 2112;
constexpr int MAXBLK = 264, CHUNK_BLK = 128, CHUNK1_MAX = MAXBLK - CHUNK_BLK;

constexpr size_t MiB = 1u << 20;
constexpr size_t WS_CTL = 0, CTL_ZERO_BYTES = 1 * MiB;
constexpr size_t WS_WF   = 1 * MiB;
constexpr size_t WS_WR   = WS_WF + 65536;
constexpr size_t WS_BLKE = WS_WR + 32768;
constexpr size_t WS_LOGF = 2 * MiB;
constexpr size_t WS_CCUM = 3 * MiB;
constexpr size_t WS_TOKT = 4 * MiB;
constexpr size_t WS_MN   = 5 * MiB;
constexpr size_t WS_XKV  = 7 * MiB;
constexpr size_t WS_WS1  = 16 * MiB;
constexpr size_t WS_WMOE = 31 * MiB;
constexpr size_t WS_R2   = 163 * MiB;
constexpr size_t WS_R1   = 295 * MiB;
constexpr size_t R1_BYTES = (size_t)CHUNK1_MAX * 256 * DFF * 2;
constexpr size_t WS_END  = 295 * MiB + R1_BYTES;
constexpr size_t OW_IN = 0, OW_OUT = 5 * MiB, OW_Q = 7 * MiB, OW_KV = 9 * MiB, OW_O = 13 * MiB, OW_LAYER = 15 * MiB;
constexpr size_t WS_WS0 = WS_WMOE;
constexpr size_t WS_WGU0 = WS_WS0 + OW_LAYER;
constexpr size_t WS_WD0 = WS_WGU0 + 11 * MiB;
constexpr size_t MOE_GU_BYTES = (size_t)2 * DFF * D, MOE_D_BYTES = (size_t)D * DFF, MOE_E_BYTES = MOE_GU_BYTES + MOE_D_BYTES;
constexpr size_t WS_XS8 = WS_WMOE + 8 * MOE_E_BYTES;
static_assert(WS_WD0 + (size_t)D * DFF * 2 <= WS_WMOE + 132 * MiB && WS_XS8 + (size_t)MAXBLK * 256 * D <= WS_WMOE + 132 * MiB, "weights map");
constexpr size_t R2_HN = WS_R2, R2_MIX = WS_R2 + 64 * MiB;
constexpr size_t R1_PROJ = WS_R1;
constexpr size_t R1_VT = WS_R1 + 112 * MiB;
constexpr size_t R1_A = WS_R1, R1_B = WS_R1 + 64 * MiB;
constexpr size_t R1_ACT = WS_R1;
constexpr size_t R1_ACT8 = WS_R1;
constexpr size_t R2_XS = WS_R2;
static_assert((size_t)NTOK * DFF * 2 <= R1_BYTES && (size_t)MAXBLK * 256 * D * 2 <= 132 * MiB && WS_END <= 513026096, "arena map");
constexpr int CW_CNT = 64;
constexpr int CW_KMAX = 128;
constexpr int CW_BAR = 4096;

constexpr int RING_OFF = 0, RING_BYTES = 131072;
constexpr int LDSCTL_OFF = RING_BYTES, MISC_OFF = LDSCTL_OFF + 320;
constexpr int LDS_BYTES = 147456;
constexpr int NWAVES = 8;

#define GAS __attribute__((address_space(1)))
#define LAS __attribute__((address_space(3)))
typedef unsigned short bf16;
typedef unsigned v4u __attribute__((ext_vector_type(4)));
typedef unsigned v2u __attribute__((ext_vector_type(2)));
typedef float f32x4 __attribute__((ext_vector_type(4)));
typedef GAS unsigned gu32;
#define RLX_AGENT __ATOMIC_RELAXED, __HIP_MEMORY_SCOPE_AGENT
#define LDS_WAIT() asm volatile("s_waitcnt lgkmcnt(0)" ::: "memory")
#define VM_WAIT() asm volatile("s_waitcnt vmcnt(0)" ::: "memory")
__device__ __forceinline__ unsigned f2bf(float f) { unsigned u = __builtin_bit_cast(unsigned, f); return (u + 0x7fffu + ((u >> 16) & 1u)) >> 16; }
__device__ __forceinline__ unsigned pk2(float lo, float hi) { return f2bf(lo) | (f2bf(hi) << 16); }
__device__ __forceinline__ float bflo(unsigned u) { return __uint_as_float(u << 16); }
__device__ __forceinline__ float bfhi(unsigned u) { return __uint_as_float(u & 0xffff0000u); }
__device__ __forceinline__ float bf2f(bf16 b) { return __uint_as_float(((unsigned)b) << 16); }

#define XB_TMO      128
#define XB_XCNT(j)  (256  + 64 * (j))
#define XB_XSUB(j)  (1280 + 64 * (j))
#define XB_XGEN(j)  (2304 + 64 * (j))
#define XB_TOP      3328
#define XB_TOPGEN   3392
#define XCD_BAR_WORDS 3456
#define XB_SPIN_CAP (1u << 22)

__device__ __forceinline__ unsigned xb_ld(unsigned* p)              { return __hip_atomic_load(p, __ATOMIC_RELAXED, __HIP_MEMORY_SCOPE_AGENT); }
__device__ __forceinline__ unsigned xb_add(unsigned* p, unsigned v) { return __hip_atomic_fetch_add(p, v, __ATOMIC_RELAXED, __HIP_MEMORY_SCOPE_AGENT); }
__device__ __forceinline__ unsigned xb_xcc_id() { return (unsigned)__builtin_amdgcn_s_getreg((3 << 11) | 20) & 0xFu; }
#define XB_SPIN(cond, bar) do { unsigned _sp = 0; while (cond) { __builtin_amdgcn_s_sleep(1); \
    if ((++_sp & 255u) == 0u) { if (xb_ld(&(bar)[XB_TMO])) break; if (_sp > XB_SPIN_CAP) { atomicAdd(&(bar)[XB_TMO], 1u); break; } } } } while (0)

struct XcdBarrier { unsigned* bar; unsigned x; volatile LAS unsigned* st; };

__device__ __forceinline__ XcdBarrier xcd_barrier_post(unsigned* bar, volatile LAS unsigned* st) {
    XcdBarrier b; b.bar = bar; b.x = xb_xcc_id(); b.st = st;
    if (threadIdx.x == 0) (void)xb_add(&bar[XB_XCNT(b.x)], 1u);
    return b;
}
__device__ __forceinline__ void xcd_barrier_complete(unsigned* bar, unsigned x, unsigned& nloc, unsigned& nx) {
    const unsigned G = gridDim.x * gridDim.y * gridDim.z;
    unsigned sum, cnt, mine, sp = 0u;
    for (;;) {
        sum = 0u; cnt = 0u; mine = 0u;
#pragma unroll
        for (unsigned j = 0; j < 16; ++j) { const unsigned c = xb_ld(&bar[XB_XCNT(j)]); sum += c; cnt += (c > 0u) ? 1u : 0u; mine = (j == x) ? c : mine; }
        if (sum == G) break;
        __builtin_amdgcn_s_sleep(1);
        if ((++sp & 255u) == 0u) { if (xb_ld(&bar[XB_TMO])) break; if (sp > XB_SPIN_CAP) { atomicAdd(&bar[XB_TMO], 1u); break; } }
    }
    nloc = mine > 0u ? mine : 1u; nx = cnt > 0u ? cnt : 1u;
}
__device__ __forceinline__ void xcd_barrier(const XcdBarrier& b) {
    asm volatile("s_waitcnt vmcnt(0)" ::: "memory");
    __syncthreads();
    if (threadIdx.x == 0) {
        unsigned* bar = b.bar;
        __builtin_amdgcn_s_waitcnt(0);
        unsigned nloc = b.st[0], nx = b.st[1];
        if (nloc == 0u) { xcd_barrier_complete(bar, b.x, nloc, nx); b.st[0] = nloc; b.st[1] = nx; }
        const unsigned old = xb_add(&bar[XB_XSUB(b.x)], 1u);
        const unsigned gen = old / nloc;
        if (old + 1u == (gen + 1u) * nloc) {
            __builtin_amdgcn_fence(__ATOMIC_RELEASE, "agent");
            asm volatile("s_waitcnt vmcnt(0)" ::: "memory");
            const unsigned og = xb_add(&bar[XB_TOP], 1u);
            const unsigned tg = og / nx;
            if (og + 1u == (tg + 1u) * nx) xb_add(&bar[XB_TOPGEN], 1u);
            else XB_SPIN(xb_ld(&bar[XB_TOPGEN]) == tg, bar);
            __builtin_amdgcn_fence(__ATOMIC_ACQUIRE, "agent");
            xb_add(&bar[XB_XGEN(b.x)], 1u);
            asm volatile("s_waitcnt vmcnt(0)" ::: "memory");
        } else {
            XB_SPIN(xb_ld(&bar[XB_XGEN(b.x)]) == gen, bar);
            __builtin_amdgcn_fence(__ATOMIC_ACQUIRE, "agent");
            asm volatile("s_waitcnt vmcnt(0)" ::: "memory");
        }
    }
    __syncthreads();
}

enum In { I_X = 0, I_MEM, I_MIXPRE, I_MIXPOST, I_WIN, I_BF, I_POOLW, I_POOLS, I_WOUT, I_XAPRE, I_XAPOST, I_MEMN, I_XQ, I_XKV, I_XO, I_FFPRE, I_FFPOST,
          I_DG, I_DU, I_DD, I_RW, I_MG, I_MU, I_MD };

struct Args { const float* in[24]; float* out; unsigned char* ws; int ph_lo, ph_hi; };
__device__ __forceinline__ const __attribute__((address_space(4))) Args* kargs() { const __attribute__((address_space(4))) Args* p = (const __attribute__((address_space(4))) Args*)__builtin_amdgcn_kernarg_segment_ptr(); asm volatile("" : "+s"(p)); return p; }
#define WSB (kargs()->ws)
#define INP(i) (kargs()->in[i])
#define OUTP (kargs()->out)
struct Frame {
    LAS unsigned char* lds;
    gu32* ctl;
    int tid, lane, wave;
    int vcu, G, roff;
};


__device__ __forceinline__ void fresh(Frame& F) { int t = threadIdx.x; asm volatile("" : "+v"(t)); F.tid = t; F.lane = t & 63; F.wave = __builtin_amdgcn_readfirstlane(t >> 6); }
__device__ __forceinline__ float wave_sum(float v) {
#pragma unroll
    for (int o = 1; o < 64; o <<= 1) v += __shfl_xor(v, o);
    return v;
}
__device__ __forceinline__ float wave_max(float v) {
#pragma unroll
    for (int o = 1; o < 64; o <<= 1) v = fmaxf(v, __shfl_xor(v, o));
    return v;
}
__device__ __forceinline__ float log_sigmoid(float x) { return x < 0.f ? x - log1pf(__expf(x)) : -log1pf(__expf(-x)); }

template <bool GU>
__device__ __forceinline__ void conv_item4(const float* W, int ldw, int n, int k0, bf16* WT, int K, int row0, int which) {
    const int rb = GU ? (256 * (n >> 7) + 128 * which + (n & 127)) : (row0 + n);
#pragma unroll
    for (int kk = 0; kk < 32; kk += 8) {
        f32x4 f[8];
#pragma unroll
        for (int i = 0; i < 8; ++i) f[i] = *(const f32x4*)(W + (size_t)(k0 + kk + i) * ldw + n);
#pragma unroll
        for (int j = 0; j < 4; ++j) { v4u o; o.x = pk2(f[0][j], f[1][j]); o.y = pk2(f[2][j], f[3][j]); o.z = pk2(f[4][j], f[5][j]); o.w = pk2(f[6][j], f[7][j]);
            *(v4u*)(WT + (size_t)(rb + j) * K + k0 + kk) = o; }
    }
}
__device__ __forceinline__ void conv_item1(const float* W, int ldw, int col, int k0, bf16* WT, int K, int row) {
#pragma unroll
    for (int kk = 0; kk < 32; kk += 8) {
        float f[8];
#pragma unroll
        for (int i = 0; i < 8; ++i) f[i] = W[(size_t)(k0 + kk + i) * ldw + col];
        v4u o; o.x = pk2(f[0], f[1]); o.y = pk2(f[2], f[3]); o.z = pk2(f[4], f[5]); o.w = pk2(f[6], f[7]);
        *(v4u*)(WT + (size_t)row * K + k0 + kk) = o;
    }
}
__device__ __forceinline__ int conv_first(Frame& F, int nitems) {
    const int gw = F.vcu * NWAVES + F.wave, NGW = F.G * NWAVES; int it = gw - F.roff; if (it < 0) it += NGW; F.roff = (F.roff + nitems) % NGW; return it;
}
__device__ __forceinline__ void transpose_mat(Frame& F, const float* W, int ldw, int col0, int ncols, int K, bf16* WT, int row0, LAS float* scr) {
    (void)scr; const int NGW = F.G * NWAVES, nkb = K / 32;
    if ((ldw & 3) == 0 && (col0 & 3) == 0 && (ncols & 255) == 0) {
        const int nitems = nkb * (ncols / 256);
        for (int it = conv_first(F, nitems); it < nitems; it += NGW) { const int kb = it % nkb, nb = it / nkb; conv_item4<false>(W + col0, ldw, 256 * nb + 4 * F.lane, 32 * kb, WT, K, row0, 0); }
    } else {
        const int nitems = nkb * (ncols / 64);
        for (int it = conv_first(F, nitems); it < nitems; it += NGW) { const int kb = it % nkb, nb = it / nkb; conv_item1(W, ldw, col0 + 64 * nb + F.lane, 32 * kb, WT, K, row0 + 64 * nb + F.lane); }
    }
}
__device__ __forceinline__ void transpose_gu(Frame& F, const float* Wg, const float* Wu, bf16* WT, LAS float* scr) {
    (void)scr; const int NGW = F.G * NWAVES, nkb = D / 32, ncb = DFF / 256, nitems = 2 * nkb * ncb;
    for (int it = conv_first(F, nitems); it < nitems; it += NGW) { const int kb = it % nkb, r = it / nkb, nb = r % ncb, which = r / ncb;
        conv_item4<true>(which ? Wu : Wg, DFF, 256 * nb + 4 * F.lane, 32 * kb, WT, D, 0, which); }
}
template <bool GU>
__device__ __forceinline__ void conv_item4_f8(const float* W, int ldw, int n, int k0, unsigned char* WT, int K, int row0, int which) {
    const int rb = GU ? (256 * (n >> 7) + 128 * which + (n & 127)) : (row0 + n);
#pragma unroll
    for (int kk = 0; kk < 32; kk += 8) {
        f32x4 f[8];
#pragma unroll
        for (int i = 0; i < 8; ++i) f[i] = *(const f32x4*)(W + (size_t)(k0 + kk + i) * ldw + n) * 256.f;
#pragma unroll
        for (int j = 0; j < 4; ++j) { v2u o; o.x = pg8::pack4_fp8(f[0][j], f[1][j], f[2][j], f[3][j]); o.y = pg8::pack4_fp8(f[4][j], f[5][j], f[6][j], f[7][j]);
            *(v2u*)(WT + (size_t)(rb + j) * K + k0 + kk) = o; }
    }
}
__device__ __forceinline__ void transpose_mat_f8(Frame& F, const float* W, int ldw, int ncols, int K, unsigned char* WT) {
    const int NGW = F.G * NWAVES, nkb = K / 32, nitems = nkb * (ncols / 256);
    for (int it = conv_first(F, nitems); it < nitems; it += NGW) { const int kb = it % nkb, nb = it / nkb; conv_item4_f8<false>(W, ldw, 256 * nb + 4 * F.lane, 32 * kb, WT, K, 0, 0); }
}
__device__ __forceinline__ void transpose_gu_f8(Frame& F, const float* Wg, const float* Wu, unsigned char* WT) {
    const int NGW = F.G * NWAVES, nkb = D / 32, ncb = DFF / 256, nitems = 2 * nkb * ncb;
    for (int it = conv_first(F, nitems); it < nitems; it += NGW) { const int kb = it % nkb, r = it / nkb, nb = r % ncb, which = r / ncb;
        conv_item4_f8<true>(which ? Wu : Wg, DFF, 256 * nb + 4 * F.lane, 32 * kb, WT, D, 0, which); }
}
__device__ __forceinline__ void convert_layer_small(Frame& F, int l, bf16* base, LAS float* scr) {
    const float* win = INP(I_WIN) + (size_t)l * D * CIN;
    bf16* wt = base + OW_IN / 2;
    transpose_mat(F, win, CIN, 0, 768, D, wt, 0, scr);
    transpose_mat(F, win, CIN, 1152, 768, D, wt, 768, scr);
    { const float* pw = INP(I_POOLW) + (size_t)l * 4 * 4096; const float* psc = INP(I_POOLS) + (size_t)l * POOLD;
      for (int i = (F.vcu * NWAVES + F.wave) * 64 + F.lane; i < POOLD * D; i += F.G * NWAVES * 64) { const int n = i / D, k = i % D, g = n >> 6, co = n & 63;
          const float* wr = win + (size_t)k * CIN + 2310 + g * 64; const float* pc = pw + g * 4096 + co; float acc = 0.f;
#pragma unroll 8
          for (int ci = 0; ci < 64; ++ci) acc += wr[ci] * pc[ci * 64];
          wt[(size_t)(1536 + n) * D + k] = (bf16)f2bf(acc * psc[n]); } }
    transpose_mat(F, win, CIN, 768, 384, D, wt, 1792, scr);
    transpose_mat(F, win, CIN, 1920, 384, D, wt, 2176, scr);
    transpose_mat(F, INP(I_WOUT) + (size_t)l * D * D, D, 0, D, D, base + OW_OUT / 2, 0, scr);
    transpose_mat(F, INP(I_XQ) + (size_t)l * D * D, D, 0, D, D, base + OW_Q / 2, 0, scr);
    transpose_mat(F, INP(I_XKV) + (size_t)l * D * 2 * D, 2 * D, 0, 2 * D, D, base + OW_KV / 2, 0, scr);
    transpose_mat(F, INP(I_XO) + (size_t)l * D * D, D, 0, D, D, base + OW_O / 2, 0, scr);
    float* wf = (float*)(WSB + WS_WF) + (size_t)l * 8 * D;
    for (int i = (F.vcu * NWAVES + F.wave) * 64 + F.lane; i < 6 * D; i += F.G * NWAVES * 64) { const int j = i / D, k = i % D; wf[j * D + k] = win[(size_t)k * CIN + 2304 + j]; }
}

#define DPP_ADD(v, ctrl) ((v) + __int_as_float(__builtin_amdgcn_update_dpp(0, __float_as_int(v), (ctrl), 0xf, 0xf, false)))
__device__ __forceinline__ float wave_sum_fast(float v) {
    v = DPP_ADD(v, 0xB1); v = DPP_ADD(v, 0x4E); v = DPP_ADD(v, 0x141); v = DPP_ADD(v, 0x140);
    const int iv = __float_as_int(v);
    return (__int_as_float(__builtin_amdgcn_readlane(iv, 0)) + __int_as_float(__builtin_amdgcn_readlane(iv, 16))) + (__int_as_float(__builtin_amdgcn_readlane(iv, 32)) + __int_as_float(__builtin_amdgcn_readlane(iv, 48)));
}
struct ThinIn { f32x4 v[4]; v2u d0[4]; v2u d1[4]; float g0, g1; };
template <int DELTA>
__device__ __forceinline__ void thin_load(ThinIn& t, int row, int lane, const float* h_in, const bf16* delta, const int* tokt) {
#pragma unroll
    for (int j = 0; j < 4; ++j) t.v[j] = *(const f32x4*)(h_in + (size_t)row * D + 4 * lane + 256 * j);
    if constexpr (DELTA == 1) {
#pragma unroll
        for (int j = 0; j < 4; ++j) t.d0[j] = *(const v2u*)(delta + (size_t)row * D + 4 * lane + 256 * j);
    }
    if constexpr (DELTA == 2) {
        const int r0 = tokt[row * 8 + 1], r1 = tokt[row * 8 + 4]; t.g0 = __int_as_float(tokt[row * 8 + 2]); t.g1 = __int_as_float(tokt[row * 8 + 5]);
#pragma unroll
        for (int j = 0; j < 4; ++j) { t.d0[j] = *(const v2u*)(delta + (size_t)r0 * D + 4 * lane + 256 * j); t.d1[j] = *(const v2u*)(delta + (size_t)r1 * D + 4 * lane + 256 * j); }
    }
}
template <int DELTA, bool WRITE_H, bool WRITE_HN, int EXTRA>
__device__ __forceinline__ void thin_rows(Frame& F, const float* h_in, const bf16* delta, const float* g_post, float* h_out, const float* g_pre, bf16* hn_out,
                                          const float* wx, const float* bfo, float* logf, int* tokt, gu32* cnt) {
    const int gw = F.vcu * NWAVES + F.wave, NGW = F.G * NWAVES, lane = F.lane;
    constexpr int NX = EXTRA == 1 ? 6 : (EXTRA == 2 ? 8 : 0);
    f32x4 gp[4], gq[4], wv[NX > 0 ? NX : 1][4];
#pragma unroll
    for (int j = 0; j < 4; ++j) { if constexpr (DELTA != 0) gp[j] = *(const f32x4*)(g_post + 4 * lane + 256 * j); if constexpr (WRITE_HN) gq[j] = *(const f32x4*)(g_pre + 4 * lane + 256 * j); }
#pragma unroll
    for (int e = 0; e < NX; ++e)
#pragma unroll
        for (int j = 0; j < 4; ++j) wv[e][j] = *(const f32x4*)(wx + e * D + 4 * lane + 256 * j);
    float bfl = 0.f; if constexpr (EXTRA == 1) { if (lane < 6) bfl = bfo[lane]; }
    ThinIn cur, nxt;
    if (gw < NTOK) thin_load<DELTA>(cur, gw, lane, h_in, delta, tokt);
    for (int row = gw; row < NTOK; row += NGW) {
        if (row + NGW < NTOK) thin_load<DELTA>(nxt, row + NGW, lane, h_in, delta, tokt);
        f32x4 v[4];
#pragma unroll
        for (int j = 0; j < 4; ++j) v[j] = cur.v[j];
        if constexpr (DELTA != 0) {
            f32x4 d[4];
            if constexpr (DELTA == 1) {
#pragma unroll
                for (int j = 0; j < 4; ++j) { const v2u r = cur.d0[j]; d[j] = (f32x4){bflo(r.x), bfhi(r.x), bflo(r.y), bfhi(r.y)}; }
            } else {
                const float g0 = cur.g0, g1 = cur.g1;
#pragma unroll
                for (int j = 0; j < 4; ++j) { const v2u r0 = cur.d0[j], r1 = cur.d1[j];
                    d[j] = (f32x4){g0 * bflo(r0.x) + g1 * bflo(r1.x), g0 * bfhi(r0.x) + g1 * bfhi(r1.x), g0 * bflo(r0.y) + g1 * bflo(r1.y), g0 * bfhi(r0.y) + g1 * bfhi(r1.y)}; }
            }
            float ss = 0.f;
#pragma unroll
            for (int j = 0; j < 4; ++j) ss += (d[j].x * d[j].x + d[j].y * d[j].y) + (d[j].z * d[j].z + d[j].w * d[j].w);
            const float rs = rsqrtf(wave_sum_fast(ss) * (1.f / D) + EPS);
#pragma unroll
            for (int j = 0; j < 4; ++j) v[j] = v[j] + d[j] * rs * gp[j];
        }
        if constexpr (WRITE_H) {
#pragma unroll
            for (int j = 0; j < 4; ++j) *(f32x4*)(h_out + (size_t)row * D + 4 * lane + 256 * j) = v[j];
        }
        if constexpr (WRITE_HN) {
            float ss = 0.f;
#pragma unroll
            for (int j = 0; j < 4; ++j) ss += (v[j].x * v[j].x + v[j].y * v[j].y) + (v[j].z * v[j].z + v[j].w * v[j].w);
            const float rs = rsqrtf(wave_sum_fast(ss) * (1.f / D) + EPS);
#pragma unroll
            for (int j = 0; j < 4; ++j) { v[j] = v[j] * rs * gq[j];
                v2u o; o.x = pk2(v[j].x, v[j].y); o.y = pk2(v[j].z, v[j].w); *(v2u*)(hn_out + (size_t)row * D + 4 * lane + 256 * j) = o; }
            if constexpr (NX > 0) {
                float lg[NX];
#pragma unroll
                for (int e = 0; e < NX; ++e) { float s2 = 0.f;
#pragma unroll
                    for (int j = 0; j < 4; ++j) { const f32x4 w = wv[e][j]; s2 += (v[j].x * w.x + v[j].y * w.y) + (v[j].z * w.z + v[j].w * w.w); }
                    lg[e] = wave_sum_fast(s2); }
                if constexpr (EXTRA == 1) {
                    if (lane < 6) { float x = lg[0];
#pragma unroll
                        for (int e = 1; e < 6; ++e) x = (lane == e) ? lg[e] : x;
                        logf[(size_t)row * 8 + lane] = log_sigmoid(x + bfl); }
                } else {
                    int e0 = 0; float v0 = lg[0];
#pragma unroll
                    for (int e = 1; e < 8; ++e) if (lg[e] > v0) { v0 = lg[e]; e0 = e; }
                    int e1 = -1; float v1 = -INFINITY;
#pragma unroll
                    for (int e = 0; e < 8; ++e) if (e != e0 && lg[e] > v1) { v1 = lg[e]; e1 = e; }
                    if (lane == 0) {
                        const float g0 = 1.f / (1.f + __expf(v1 - v0)), g1 = 1.f - g0;
                        const unsigned p0 = __hip_atomic_fetch_add(cnt + e0, 1u, RLX_AGENT), p1 = __hip_atomic_fetch_add(cnt + e1, 1u, RLX_AGENT);
                        int* t = tokt + (size_t)row * 8; t[0] = e0; t[1] = (int)p0; t[2] = __float_as_int(g0); t[3] = e1; t[4] = (int)p1; t[5] = __float_as_int(g1);
                    }
                }
            }
        }
        cur = nxt;
    }
}
__device__ __forceinline__ void mem_norm(Frame& F, const float* mem, const float* g, bf16* mn) {
    const int gw = F.vcu * NWAVES + F.wave, NGW = F.G * NWAVES, lane = F.lane;
    for (int row = gw; row < NMEM; row += NGW) {
        f32x4 v[4]; float ss = 0.f;
#pragma unroll
        for (int j = 0; j < 4; ++j) { v[j] = *(const f32x4*)(mem + (size_t)row * D + 4 * lane + 256 * j); ss += (v[j].x * v[j].x + v[j].y * v[j].y) + (v[j].z * v[j].z + v[j].w * v[j].w); }
        const float rs = rsqrtf(wave_sum(ss) * (1.f / D) + EPS);
#pragma unroll
        for (int j = 0; j < 4; ++j) { const f32x4 gg = *(const f32x4*)(g + 4 * lane + 256 * j); v[j] = v[j] * rs * gg;
            v2u o; o.x = pk2(v[j].x, v[j].y); o.y = pk2(v[j].z, v[j].w); *(v2u*)(mn + (size_t)row * D + 4 * lane + 256 * j) = o; }
    }
}
__device__ __forceinline__ void scan_logf(Frame& F, const float* logf, float* ccum) {
    if (blockIdx.x >= NBATCH * NFX) return;
    const int b = blockIdx.x / NFX, h = blockIdx.x % NFX, tid = F.tid;
    LAS float* wsum = (LAS float*)(F.lds + RING_OFF);
    float x[16]; float run = 0.f;
#pragma unroll
    for (int i = 0; i < 16; ++i) { run += logf[((size_t)b * SEQ + tid * 16 + i) * 8 + h]; x[i] = run; }
    float incl = run;
#pragma unroll
    for (int o = 1; o < 64; o <<= 1) { const float t = __shfl_up(incl, o); if (F.lane >= o) incl += t; }
    if (F.lane == 63) wsum[F.wave] = incl;
    LDS_WAIT(); __syncthreads();
    float base = incl - run;
    for (int w = 0; w < F.wave; ++w) base += wsum[w];
    float* o = ccum + ((size_t)b * NFX + h) * SEQ + tid * 16;
#pragma unroll
    for (int i = 0; i < 16; ++i) o[i] = (base + x[i]) * 1.4426950408889634f;
    __syncthreads();
}

__device__ __forceinline__ void pool_window(Frame& F, const bf16* proj, bf16* mix) {
    const int g0 = (F.vcu * NWAVES + F.wave) * 64 + F.lane, GS = F.G * NWAVES * 64;
    for (int it = g0; it < NTOK * 32; it += GS) {
        const int tok = it >> 5, ch = it & 31, pos = tok % SEQ, win = 2 << (ch >> 3), cnt = (pos + 1 < win) ? pos + 1 : win;
        const bf16* yp = proj + (size_t)tok * PP + C_U + 8 * ch;
        float a[8], y0[8];
        { const v4u q = *(const v4u*)yp; y0[0] = bflo(q.x); y0[1] = bfhi(q.x); y0[2] = bflo(q.y); y0[3] = bfhi(q.y); y0[4] = bflo(q.z); y0[5] = bfhi(q.z); y0[6] = bflo(q.w); y0[7] = bfhi(q.w); }
#pragma unroll
        for (int i = 0; i < 8; ++i) a[i] = y0[i];
        for (int j = 1; j < cnt; ++j) { const v4u q = *(const v4u*)(yp - (size_t)j * PP);
            a[0] += bflo(q.x); a[1] += bfhi(q.x); a[2] += bflo(q.y); a[3] += bfhi(q.y); a[4] += bflo(q.z); a[5] += bfhi(q.z); a[6] += bflo(q.w); a[7] += bfhi(q.w); }
        const float ic = 1.f / (float)cnt;
        v4u w; w.x = pk2(a[0] * ic - y0[0], a[1] * ic - y0[1]); w.y = pk2(a[2] * ic - y0[2], a[3] * ic - y0[3]); w.z = pk2(a[4] * ic - y0[4], a[5] * ic - y0[5]); w.w = pk2(a[6] * ic - y0[6], a[7] * ic - y0[7]);
        *(v4u*)(mix + (size_t)tok * D + SBD + FXD + 8 * ch) = w;
    }
}

typedef short bf16x8 __attribute__((ext_vector_type(8)));
typedef float f32x16 __attribute__((ext_vector_type(16)));
__device__ __forceinline__ int kperm(int r) { const int g = (r >> 2) & 3; const int g2 = (g == 1) ? 2 : (g == 2) ? 1 : g; return (r & 16) + 4 * g2 + (r & 3); }
__device__ __forceinline__ float xhalf(float v) { return __shfl_xor(v, 32); }
__device__ __forceinline__ bf16x8 pack8(const f32x16& p, int s) {
    v4u w; w.x = pg8::cvt_pk_bf16(p[8 * s + 0], p[8 * s + 1]); w.y = pg8::cvt_pk_bf16(p[8 * s + 2], p[8 * s + 3]); w.z = pg8::cvt_pk_bf16(p[8 * s + 4], p[8 * s + 5]); w.w = pg8::cvt_pk_bf16(p[8 * s + 6], p[8 * s + 7]);
    return __builtin_bit_cast(bf16x8, w);
}
__device__ __forceinline__ void store_ot(bf16* dst, const f32x16& o, float sc, int hh) {
#pragma unroll
    for (int g = 0; g < 4; ++g) { v2u w; w.x = pg8::cvt_pk_bf16(o[4 * g] * sc, o[4 * g + 1] * sc); w.y = pg8::cvt_pk_bf16(o[4 * g + 2] * sc, o[4 * g + 3] * sc); *(v2u*)(dst + 8 * g + 4 * hh) = w; }
}

__device__ __forceinline__ void fox_knorm(Frame& F, const bf16* proj, gu32* kmax) {
    const int gw = F.vcu * NWAVES + F.wave, NGW = F.G * NWAVES, lane = F.lane;
    const int NU = NBATCH * NFX * (SEQ / 64);
    for (int u = gw; u < NU; u += NGW) {
        const int bh = u / (SEQ / 64), tb = u % (SEQ / 64), b = bh / NFX, h = bh % NFX;
        const bf16* kr = proj + ((size_t)b * SEQ + tb * 64 + lane) * PP + C_FK + h * HD;
        float ss = 0.f;
#pragma unroll
        for (int i = 0; i < 8; ++i) { const v4u r = *(const v4u*)(kr + 8 * i);
            ss += (bflo(r.x) * bflo(r.x) + bfhi(r.x) * bfhi(r.x)) + (bflo(r.y) * bflo(r.y) + bfhi(r.y) * bfhi(r.y)) + (bflo(r.z) * bflo(r.z) + bfhi(r.z) * bfhi(r.z)) + (bflo(r.w) * bflo(r.w) + bfhi(r.w) * bfhi(r.w)); }
        ss = wave_max(ss);
        if (lane == 0) __hip_atomic_fetch_max(kmax + bh, __float_as_uint(ss), RLX_AGENT);
    }
}
#ifndef FOX_THR
#define FOX_THR 104.0f
#endif
constexpr int AT_STB = 8192 + 8192 + 256;
template <int FOX>
__device__ __forceinline__ void attn_wg(Frame& F, const bf16* proj, const bf16* vt, const float* ccum, const gu32* kmax, bf16* mix) {
    constexpr int NH = FOX ? NFX : NSB, COLQ = FOX ? C_FQ : C_SQ, COLK = FOX ? C_FK : C_SK, VROW0 = FOX ? SBD : 0, OCOL = FOX ? SBD : 0;
    constexpr float L2E = 1.4426950408889634f, SC = 0.125f * L2E;
    LAS unsigned char* L = F.lds + RING_OFF;
    LAS unsigned* flags = (LAS unsigned*)(L + 2 * AT_STB);
    const int tid = F.tid, lane = F.lane, wave = F.wave, r = lane & 31, hh = lane >> 5;
    const int srow = tid >> 3, sch = tid & 7, swr = srow * 128 + 16 * (sch ^ ((srow >> 1) & 7));
    const int krow = kperm(r), ksw = (krow >> 1) & 7, vsw = (r >> 1) & 7;
    const int NT = SEQ / 256, NU = NBATCH * NH * NT;
    for (int u = F.vcu; u < NU; u += F.G) {
        const int bh = u / NT, tile = (NT - 1) - u % NT, b = bh / NH, h = bh % NH, T0 = tile * 256, tq = T0 + 32 * wave + r, myblk = tile * 8 + wave;
        const size_t tokb = (size_t)b * SEQ;
        const float* cc = ccum + (size_t)bh * SEQ;
        const bf16* kg = proj + (tokb + srow) * PP + COLK + h * HD + 8 * sch;
        const bf16* vg = vt + (size_t)(VROW0 + h * HD + srow) * VTP + tokb + 8 * sch;
        bf16x8 qf[4]; float qn = 0.f;
        { const bf16* qp = proj + (tokb + tq) * PP + COLQ + h * HD + 8 * hh;
#pragma unroll
          for (int ks = 0; ks < 4; ++ks) { qf[ks] = *(const bf16x8*)(qp + 16 * ks);
              if (FOX) {
#pragma unroll
                  for (int j = 0; j < 8; ++j) { const float x = bf2f((bf16)qf[ks][j]); qn += x * x; } } } }
        float zb2 = 0.f, ct2 = 0.f;
        if (FOX) { qn += xhalf(qn); zb2 = (0.125f * sqrtf(qn * __uint_as_float(__hip_atomic_load(kmax + bh, RLX_AGENT))) * 1.01f + 0.01f) * L2E; ct2 = cc[tq]; }
        float l = 0.f, cb = 0.f, Rp = 1.f; f32x16 o[2] = {};
        bool mydone = false;
        const int nst = tile * 4 + 4;
        v4u gk, gv; float gc = 0.f;
        { const int k0 = T0 + 192; gk = *(const v4u*)(kg + (size_t)k0 * PP); gv = *(const v4u*)(vg + k0); if (FOX && tid < 64) gc = cc[k0 + tid]; }
        *(LAS v4u*)(L + swr) = gk; *(LAS v4u*)(L + 8192 + swr) = gv; if (FOX && tid < 64) *(LAS float*)(L + 16384 + 4 * tid) = gc;
        LDS_WAIT(); __syncthreads();
        for (int j = 0; j < nst; ++j) {
            const int k0 = T0 + 192 - 64 * j;
            LAS unsigned char* B = L + (j & 1) * AT_STB;
            if (j + 1 < nst) { const int k1 = k0 - 64; gk = *(const v4u*)(kg + (size_t)k1 * PP); gv = *(const v4u*)(vg + k1); if (FOX && tid < 64) gc = cc[k1 + tid]; }
#pragma unroll
            for (int sbi = 0; sbi < 2; ++sbi) {
                const int sb = 1 - sbi, blk = (k0 >> 5) + sb, s0 = k0 + 32 * sb;
                if (blk > myblk || mydone) continue;
                const bool diag = (blk == myblk);
                f32x16 S = {};
#pragma unroll
                for (int ks = 0; ks < 4; ++ks) { const bf16x8 kf = *(const LAS bf16x8*)(B + (32 * sb + krow) * 128 + 16 * ((2 * ks + hh) ^ ksw)); S = __builtin_amdgcn_mfma_f32_32x32x16_bf16(kf, qf[ks], S, 0, 0, 0); }
                if (FOX) {
                    f32x4 c4[4];
#pragma unroll
                    for (int s2 = 0; s2 < 2; ++s2) { c4[2 * s2] = *(const LAS f32x4*)(B + 16384 + 4 * (32 * sb + 16 * s2 + 8 * hh)); c4[2 * s2 + 1] = *(const LAS f32x4*)(B + 16384 + 4 * (32 * sb + 16 * s2 + 8 * hh + 4)); }
                    if (diag) {
                        float bm = -INFINITY;
#pragma unroll
                        for (int i = 0; i < 16; ++i) { const int key = s0 + 16 * (i >> 3) + 8 * hh + (i & 7); float x = S[i] * SC + (ct2 - c4[i >> 2][i & 3]); if (key > tq) x = -INFINITY; S[i] = x; bm = fmaxf(bm, x); }
                        bm = fmaxf(bm, xhalf(bm));
                        const float mref = fmaxf(bm, zb2 - 60.f * L2E); cb = ct2 - mref;
#pragma unroll
                        for (int i = 0; i < 16; ++i) { const float pv = __builtin_amdgcn_exp2f(S[i] - mref); S[i] = pv; l += pv; }
                    } else {
#pragma unroll
                        for (int i = 0; i < 16; ++i) { const float pv = __builtin_amdgcn_exp2f(S[i] * SC + (cb - c4[i >> 2][i & 3])); S[i] = pv; l += pv; }
                    }
                    mydone = __all(zb2 + (cb - c4[0][0]) + 13.f <= __log2f(l) - FOX_THR * L2E);
                } else {
                    float om[16];
#pragma unroll
                    for (int i = 0; i < 16; ++i) { const float e = __builtin_amdgcn_exp2f(fabsf(S[i]) * -SC);
                        const float sg = __builtin_amdgcn_rcpf(1.f + e), es = e * sg; const bool pos = S[i] >= 0.f; float bb = pos ? sg : es; float omb = pos ? es : sg;
                        if (diag) { const int key = s0 + 16 * (i >> 3) + 8 * hh + (i & 7); if (key >= tq) { bb = 0.f; omb = 1.f; } }
                        S[i] = bb; om[i] = omb; }
                    float TA = 1.f, TB = 1.f;
#pragma unroll
                    for (int jj = 7; jj >= 0; --jj) { const float a = om[jj], c2 = om[8 + jj]; S[jj] *= TA; S[8 + jj] *= TB; TA *= a; TB *= c2; }
                    const float PA = xhalf(TA), PB = xhalf(TB);
                    const float offB = Rp * (hh ? 1.f : PB), offA = Rp * TB * PB * (hh ? 1.f : PA);
#pragma unroll
                    for (int jj = 0; jj < 8; ++jj) { S[jj] *= offA; S[8 + jj] *= offB; }
                    Rp *= (TA * TB) * (PA * PB);
                    mydone = __all(Rp == 0.f);
                }
                const bf16x8 p0 = pack8(S, 0), p1 = pack8(S, 1);
#pragma unroll
                for (int db = 0; db < 2; ++db) {
                    const bf16x8 v0 = *(const LAS bf16x8*)(B + 8192 + (32 * db + r) * 128 + 16 * ((4 * sb + hh) ^ vsw)), v1 = *(const LAS bf16x8*)(B + 8192 + (32 * db + r) * 128 + 16 * ((4 * sb + 2 + hh) ^ vsw));
                    o[db] = __builtin_amdgcn_mfma_f32_32x32x16_bf16(v0, p0, o[db], 0, 0, 0); o[db] = __builtin_amdgcn_mfma_f32_32x32x16_bf16(v1, p1, o[db], 0, 0, 0); }
            }
            if (lane == 0) flags[(j & 1) * 8 + wave] = mydone ? 1u : 0u;
            if (j + 1 < nst) { LAS unsigned char* Bn = L + ((j + 1) & 1) * AT_STB; *(LAS v4u*)(Bn + swr) = gk; *(LAS v4u*)(Bn + 8192 + swr) = gv; if (FOX && tid < 64) *(LAS float*)(Bn + 16384 + 4 * tid) = gc; }
            LDS_WAIT(); __syncthreads();
            const v4u f0 = *(const LAS v4u*)(flags + (j & 1) * 8), f1 = *(const LAS v4u*)(flags + (j & 1) * 8 + 4);
            if ((f0.x & f0.y & f0.z & f0.w & f1.x & f1.y & f1.z & f1.w) != 0u) break;
        }
        float inv = 1.f;
        if (FOX) { l += xhalf(l); inv = 1.f / l; }
        bf16* op = mix + (tokb + tq) * D + OCOL + h * HD;
        store_ot(op, o[0], inv, hh); store_ot(op + 32, o[1], inv, hh);
        __syncthreads();
    }
}

__device__ __forceinline__ void xa_mfma(Frame& F, const bf16* xq, const bf16* xk, const bf16* xvt, bf16* xo) {
    const int gw = F.vcu * NWAVES + F.wave, NGW = F.G * NWAVES, lane = F.lane, r = lane & 31, hh = lane >> 5;
    const int NU = (NTOK / 32) * XAH;
    for (int u = gw; u < NU; u += NGW) {
        const int hd = u & 3, tb = u >> 2, tok0 = tb * 32, b = tok0 / SEQ;
        bf16x8 qf[16];
        { const bf16* qp = xq + (size_t)(tok0 + r) * D + hd * XAD + 8 * hh;
#pragma unroll
          for (int ks = 0; ks < 16; ++ks) qf[ks] = *(const bf16x8*)(qp + 16 * ks); }
        f32x16 S[8];
#pragma unroll
        for (int kb = 0; kb < 8; ++kb) {
            const bf16* kp = xk + (size_t)(b * MEML + kb * 32 + kperm(r)) * D + hd * XAD + 8 * hh;
            f32x16 acc = {};
#pragma unroll
            for (int ks = 0; ks < 16; ++ks) { const bf16x8 kf = *(const bf16x8*)(kp + 16 * ks); acc = __builtin_amdgcn_mfma_f32_32x32x16_bf16(kf, qf[ks], acc, 0, 0, 0); }
            S[kb] = acc;
        }
        float mx = -INFINITY;
#pragma unroll
        for (int kb = 0; kb < 8; ++kb)
#pragma unroll
            for (int i = 0; i < 16; ++i) mx = fmaxf(mx, S[kb][i]);
        mx = fmaxf(mx, xhalf(mx));
        float sm = 0.f;
#pragma unroll
        for (int kb = 0; kb < 8; ++kb)
#pragma unroll
            for (int i = 0; i < 16; ++i) { const float e = __expf((S[kb][i] - mx) * 0.0625f); S[kb][i] = e; sm += e; }
        sm += xhalf(sm);
        const float inv = 1.f / sm;
        bf16x8 pb[8][2];
#pragma unroll
        for (int kb = 0; kb < 8; ++kb) { pb[kb][0] = pack8(S[kb], 0); pb[kb][1] = pack8(S[kb], 1); }
#pragma unroll
        for (int half = 0; half < 2; ++half) {
            f32x16 o[4] = {};
            const bf16* vp = xvt + (size_t)(hd * XAD + half * 128 + r) * NMEM + b * MEML + 8 * hh;
#pragma unroll
            for (int kb = 0; kb < 8; ++kb)
#pragma unroll
                for (int s2 = 0; s2 < 2; ++s2)
#pragma unroll
                    for (int db = 0; db < 4; ++db) { const bf16x8 vf = *(const bf16x8*)(vp + (size_t)db * 32 * NMEM + kb * 32 + 16 * s2); o[db] = __builtin_amdgcn_mfma_f32_32x32x16_bf16(vf, pb[kb][s2], o[db], 0, 0, 0); }
#pragma unroll
            for (int db = 0; db < 4; ++db) store_ot(xo + (size_t)(tok0 + r) * D + hd * XAD + half * 128 + db * 32, o[db], inv, hh);
        }
    }
}
__device__ __forceinline__ void moe_offsets(const gu32* cnt, int (&pstart)[8], int& nblk) {
    int acc = 0;
#pragma unroll
    for (int e = 0; e < 8; ++e) { const int c = (int)__hip_atomic_load(cnt + e, RLX_AGENT); pstart[e] = acc; acc += ((c + 255) >> 8) << 8; }
    nblk = acc >> 8;
}
__device__ __forceinline__ void moe_gather(Frame& F, const bf16* hn, unsigned char* xs, int* tokt, int* blke) {
    int pstart[8], nblk; moe_offsets(F.ctl + CW_CNT, pstart, nblk);
    if (blockIdx.x == 0 && F.tid < MAXBLK + 1) {
        if (F.tid == MAXBLK) blke[MAXBLK] = nblk;
        else { int e = 0;
#pragma unroll
            for (int j = 1; j < 8; ++j) if (F.tid * 256 >= pstart[j]) e = j;
            blke[F.tid] = e; }
    }
    const int gw = F.vcu * NWAVES + F.wave, NGW = F.G * NWAVES, lane = F.lane;
    for (int row = gw; row < NTOK; row += NGW) {
        int* t = tokt + (size_t)row * 8; const int e0 = t[0], p0 = t[1], e1 = t[3], p1 = t[4];
        int s0 = 0, s1 = 0;
#pragma unroll
        for (int j = 0; j < 8; ++j) { s0 = (e0 == j) ? pstart[j] : s0; s1 = (e1 == j) ? pstart[j] : s1; }
        const int d0 = s0 + p0, d1 = s1 + p1;
        const v4u a = *(const v4u*)(hn + (size_t)row * D + 16 * lane), b = *(const v4u*)(hn + (size_t)row * D + 16 * lane + 8);
        v4u o;
        o.x = pg8::pack4_fp8(bflo(a.x) * 8.f, bfhi(a.x) * 8.f, bflo(a.y) * 8.f, bfhi(a.y) * 8.f); o.y = pg8::pack4_fp8(bflo(a.z) * 8.f, bfhi(a.z) * 8.f, bflo(a.w) * 8.f, bfhi(a.w) * 8.f);
        o.z = pg8::pack4_fp8(bflo(b.x) * 8.f, bfhi(b.x) * 8.f, bflo(b.y) * 8.f, bfhi(b.y) * 8.f); o.w = pg8::pack4_fp8(bflo(b.z) * 8.f, bfhi(b.z) * 8.f, bflo(b.w) * 8.f, bfhi(b.w) * 8.f);
        *(v4u*)(xs + (size_t)d0 * D + 16 * lane) = o; *(v4u*)(xs + (size_t)d1 * D + 16 * lane) = o;
        asm volatile("" ::: "memory");
        if (lane == 0) { t[1] = d0; t[4] = d1; }
    }
}

constexpr int NPHASE = 32;
__global__ void __launch_bounds__(NWAVES * 64, 2) fwd(Args args) {
    extern __shared__ __attribute__((aligned(16))) unsigned char lds[];
    Frame F;
    F.lds = (LAS unsigned char*)lds;
    F.tid = threadIdx.x; F.lane = F.tid & 63; F.wave = __builtin_amdgcn_readfirstlane(F.tid >> 6);
    F.roff = 0; F.G = gridDim.x; { const int bx = blockIdx.x; F.vcu = (F.G % 8 == 0) ? (bx % 8) * (F.G / 8) + bx / 8 : bx; }
    F.ctl = (gu32*)(args.ws + WS_CTL);
    volatile LAS unsigned* MISC = (volatile LAS unsigned*)(F.lds + MISC_OFF);
    for (int u = F.tid; u < (LDS_BYTES - LDSCTL_OFF) / 4; u += NWAVES * 64) ((LAS unsigned*)(F.lds + LDSCTL_OFF))[u] = 0u;
    __syncthreads();
    XcdBarrier bar; bar.bar = (unsigned*)(F.ctl + CW_BAR); bar.x = 0; bar.st = nullptr;
    const int lo = args.ph_lo, hi = args.ph_hi;
    if (hi - lo > 1) bar = xcd_barrier_post((unsigned*)(F.ctl + CW_BAR), MISC + 8);
#ifndef PHASE_MASK
#define PHASE_MASK 0xffffffffffull
#endif
#define IN(k) ((((unsigned long long)(PHASE_MASK) >> (k)) & 1ull) && lo <= (k) && (k) < hi && (fresh(F), true))
#define SEAM(k) do { if (IN(k) && IN((k) + 1)) xcd_barrier(bar); } while (0)
#ifndef PROBE_MASK
#define PROBE_MASK 0ull
#endif
#ifndef PROBE2_MASK
#define PROBE2_MASK 0
#endif
#define TWICE(bit, stmt) do { stmt; if ((PROBE2_MASK >> (bit)) & 1) { xcd_barrier(bar); stmt; } } while (0)
#define REP(k) for (int rep_ = 0; rep_ < (int)(1 + (((unsigned long long)(PROBE_MASK) >> (k)) & 1ull)); ++rep_, (rep_ < (int)(1 + (((unsigned long long)(PROBE_MASK) >> (k)) & 1ull)) ? xcd_barrier(bar) : (void)0))
#define ws WSB
#define scr ((LAS float*)(F.lds + RING_OFF + F.wave * 16384))
#define HN ((bf16*)(ws + R2_HN))
#define MIX ((bf16*)(ws + R2_MIX))
#define PROJ ((bf16*)(ws + R1_PROJ))
#define VT ((bf16*)(ws + R1_VT))
#define BA ((bf16*)(ws + R1_A))
#define BB ((bf16*)(ws + R1_B))
#define ACT ((bf16*)(ws + R1_ACT))
#define XS ((bf16*)(ws + R2_XS))
#define XS8 ((unsigned char*)(ws + WS_XS8))
#define ACT8 ((unsigned char*)(ws + R1_ACT8))
#define LOGF ((float*)(ws + WS_LOGF))
#define CCUM ((float*)(ws + WS_CCUM))
#define TOKT ((int*)(ws + WS_TOKT))
#define BLKE ((int*)(ws + WS_BLKE))
#define MN ((bf16*)(ws + WS_MN))
#define XKV ((bf16*)(ws + WS_XKV))
#define XK ((bf16*)(ws + WS_XKV))
#define XVT ((bf16*)(ws + WS_XKV + 2 * MiB))
    const int bx = (int)blockIdx.x;

#define GEMM_PLAIN(Aptr, Btptr, M_, N_, K_, Optr, ldc_) do { pg8::Gemm g{(const pg8::bf16_t*)(Aptr), (const pg8::bf16_t*)(Btptr), (M_), (N_), (K_)}; pg8::StaticOrder S; S.init(g, F.G, bx); \
        pg8::EpiBf16 E{(pg8::bf16_t*)(Optr), (ldc_), 0}; pg8::gemm_phase<pg8::EpiBf16, pg8::StaticOrder, true, true>(F.lds + RING_OFF, (K_), S, E); } while (0)

    if (IN(0)) REP(0) {
        convert_layer_small(F, 0, (bf16*)(ws + WS_WS0), scr);
        convert_layer_small(F, 1, (bf16*)(ws + WS_WS1), scr);
        transpose_gu(F, INP(I_DG), INP(I_DU), (bf16*)(ws + WS_WGU0), scr);
        transpose_mat(F, INP(I_DD), D, 0, D, DFF, (bf16*)(ws + WS_WD0), 0, scr);
        { float* wr = (float*)(ws + WS_WR); for (int i = (F.vcu * NWAVES + F.wave) * 64 + F.lane; i < 8 * D; i += F.G * NWAVES * 64) { const int e = i / D, k = i % D; wr[e * D + k] = INP(I_RW)[(size_t)k * NE + e]; } }
        mem_norm(F, INP(I_MEM), INP(I_MEMN), MN);
    }
    SEAM(0);
    if (IN(1)) REP(1) {
        thin_rows<0, false, true, 1>(F, INP(I_X), nullptr, nullptr, nullptr, INP(I_MIXPRE), HN, (const float*)(ws + WS_WF), INP(I_BF), LOGF, nullptr, nullptr);
    }
    SEAM(1);
#pragma unroll
    for (int l = 0; l < DEPTH; ++l) {
        const int p0 = (l == 0) ? 2 : 16;
        const bf16* WSL = (const bf16*)(ws + (l == 0 ? WS_WS0 : WS_WS1));
        const float* h_res = (l == 0) ? INP(I_X) : OUTP;
        if (IN(p0)) REP(p0) {
            scan_logf(F, LOGF, CCUM);
            GEMM_PLAIN(HN, WSL + OW_IN / 2, NTOK, PP, D, PROJ, PP);
            GEMM_PLAIN(WSL + OW_IN / 2 + (size_t)PP * D, HN, VTN, NTOK, D, VT, VTP);
            GEMM_PLAIN(MN, WSL + OW_KV / 2, NMEM, D, D, XK, D);
            GEMM_PLAIN(WSL + OW_KV / 2 + (size_t)D * D, MN, D, NMEM, D, XVT, NMEM);
        }
        SEAM(p0);
        if (IN(p0 + 1)) REP(p0 + 1) {
            TWICE(0, fox_knorm(F, PROJ, F.ctl + CW_KMAX + l * 24));
            TWICE(1, attn_wg<0>(F, PROJ, VT, nullptr, nullptr, MIX));
            TWICE(2, pool_window(F, PROJ, MIX));
        }
        SEAM(p0 + 1);
        if (IN(p0 + 2)) REP(p0 + 2) {
            attn_wg<1>(F, PROJ, VT, CCUM, F.ctl + CW_KMAX + l * 24, MIX);
        }
        SEAM(p0 + 2);
        if (IN(p0 + 3)) REP(p0 + 3) GEMM_PLAIN(MIX, WSL + OW_OUT / 2, NTOK, D, D, BA, D);
        SEAM(p0 + 3);
        if (IN(p0 + 4)) REP(p0 + 4) thin_rows<1, true, true, 0>(F, h_res, BA, INP(I_MIXPOST) + l * D, OUTP, INP(I_XAPRE) + l * D, HN, nullptr, nullptr, nullptr, nullptr, nullptr);
        SEAM(p0 + 4);
        if (IN(p0 + 5)) REP(p0 + 5) GEMM_PLAIN(HN, WSL + OW_Q / 2, NTOK, D, D, BB, D);
        SEAM(p0 + 5);
        if (IN(p0 + 6)) REP(p0 + 6) { pg8::XaOrder S{F.G, bx, 0, (const char*)BB, (const char*)XK}; pg8::EpiXaSoftmax E{(pg8::bf16_t*)BA, (PG8_LAS float*)(F.lds + LDSCTL_OFF + 2048)};
            pg8::gemm_phase<pg8::EpiXaSoftmax, pg8::XaOrder, true, true>(F.lds + RING_OFF, XAD, S, E, D, D); }
        SEAM(p0 + 6);
        if (IN(p0 + 7)) REP(p0 + 7) { pg8::XaOrder S{F.G, bx, 1, (const char*)BA, (const char*)XVT}; pg8::EpiBf16 E{(pg8::bf16_t*)BB, D, 0};
            pg8::gemm_phase<pg8::EpiBf16, pg8::XaOrder, true, true>(F.lds + RING_OFF, XAD, S, E, D, D); }
        SEAM(p0 + 7);
        if (IN(p0 + 8)) REP(p0 + 8) GEMM_PLAIN(BB, WSL + OW_O / 2, NTOK, D, D, BA, D);
        SEAM(p0 + 8);
        if (l == 0) {
            if (IN(11)) REP(11) thin_rows<1, true, true, 0>(F, OUTP, BA, INP(I_XAPOST), OUTP, INP(I_FFPRE), HN, nullptr, nullptr, nullptr, nullptr, nullptr);
            SEAM(11);
            if (IN(12)) REP(12) { pg8::Gemm g{(const pg8::bf16_t*)HN, (const pg8::bf16_t*)(ws + WS_WGU0), NTOK, 2 * DFF, D}; pg8::StaticOrder S; S.init(g, F.G, bx);
                pg8::EpiSwiGLU E{(pg8::bf16_t*)ACT, DFF, 0}; pg8::gemm_phase<pg8::EpiSwiGLU, pg8::StaticOrder, true, true>(F.lds + RING_OFF, D, S, E); }
            SEAM(12);
            if (IN(13)) REP(13) GEMM_PLAIN(ACT, ws + WS_WD0, NTOK, D, DFF, MIX, D);
            SEAM(13);
            if (IN(14)) REP(14) thin_rows<1, true, true, 1>(F, OUTP, MIX, INP(I_FFPOST), OUTP, INP(I_MIXPRE) + D, HN, (const float*)(ws + WS_WF) + 8 * D, INP(I_BF) + NFX, LOGF, nullptr, nullptr);
            SEAM(14);
            if (IN(15)) REP(15) {
                for (int e = 0; e < NE; ++e) {
                    unsigned char* we = ws + WS_WMOE + (size_t)e * MOE_E_BYTES;
                    transpose_gu_f8(F, INP(I_MG) + (size_t)e * D * DFF, INP(I_MU) + (size_t)e * D * DFF, we);
                    transpose_mat_f8(F, INP(I_MD) + (size_t)e * DFF * D, D, D, DFF, we + MOE_GU_BYTES);
                }
                mem_norm(F, INP(I_MEM), INP(I_MEMN) + D, MN);
            }
            SEAM(15);
        } else {
            if (IN(25)) REP(25) thin_rows<1, true, true, 2>(F, OUTP, BA, INP(I_XAPOST) + D, OUTP, INP(I_FFPRE) + D, BB, (const float*)(ws + WS_WR), nullptr, nullptr, TOKT, F.ctl + CW_CNT);
            SEAM(25);
            if (IN(26)) REP(26) moe_gather(F, BB, XS8, TOKT, BLKE);
            SEAM(26);
#pragma unroll
            for (int ch = 0; ch < 2; ++ch) {
                const int nblk = BLKE[MAXBLK]; const int c0 = ch * CHUNK_BLK, c1 = (ch == 0) ? ((nblk < CHUNK_BLK) ? nblk : CHUNK_BLK) : nblk; const int nb = c1 > c0 ? c1 - c0 : 0;
                if (IN(27 + 2 * ch)) REP(27 + 2 * ch) { pg8::MoeOrder S{nb, 2 * DFF / 256, F.G, bx, c0, 0, (const char*)XS8, (const char*)(ws + WS_WMOE), (size_t)256 * D, MOE_E_BYTES, BLKE};
                    pg8::EpiSwiGLU8 E{ACT8, DFF, c0, 1.f / 2048.f, 8.f}; pg8::gemm_phase<pg8::EpiSwiGLU8, pg8::MoeOrder, true, true, true>(F.lds + RING_OFF, D / 2, S, E); }
                SEAM(27 + 2 * ch);
                if (IN(28 + 2 * ch)) REP(28 + 2 * ch) { pg8::MoeOrder S{nb, D / 256, F.G, bx, c0, c0, (const char*)ACT8, (const char*)(ws + WS_WMOE + MOE_GU_BYTES), (size_t)256 * DFF, MOE_E_BYTES, BLKE};
                    pg8::EpiBf16S E{(pg8::bf16_t*)XS, D, 0, 1.f / 2048.f}; pg8::gemm_phase<pg8::EpiBf16S, pg8::MoeOrder, true, true, true>(F.lds + RING_OFF, DFF / 2, S, E); }
                SEAM(28 + 2 * ch);
            }
            if (IN(31)) REP(31) thin_rows<2, true, false, 0>(F, OUTP, XS, INP(I_FFPOST) + D, OUTP, nullptr, nullptr, nullptr, nullptr, nullptr, TOKT, nullptr);
        }
    }
#undef IN
#undef SEAM
#undef ws
#undef scr
#undef HN
#undef MIX
#undef PROJ
#undef VT
#undef BA
#undef BB
#undef ACT
#undef XS
#undef XS8
#undef ACT8
#undef LOGF
#undef CCUM
#undef TOKT
#undef BLKE
#undef MN
#undef XKV
#undef XK
#undef XVT
}

extern "C" void kernel_launch(void* const* d_in, const int* in_sizes, int n_in, void* d_out, int out_size, void* d_ws, size_t ws_size, hipStream_t stream) {
    static int grid = 0;
    if (grid == 0) {
        if (n_in != 24 || in_sizes[0] != NTOK * D || out_size != NTOK * D || ws_size < WS_END) { fprintf(stderr, "kernel_launch: unexpected shapes / workspace (%d inputs, ws %zu < %zu)\n", n_in, ws_size, (size_t)WS_END); grid = -1; return; }
        int dev = 0, cus = 0, per_cu = 0;
        if (hipGetDevice(&dev) != hipSuccess || hipDeviceGetAttribute(&cus, hipDeviceAttributeMultiprocessorCount, dev) != hipSuccess) { grid = -1; return; }
        if (hipFuncSetAttribute((const void*)fwd, hipFuncAttributeMaxDynamicSharedMemorySize, LDS_BYTES) != hipSuccess) { fprintf(stderr, "kernel_launch: hipFuncSetAttribute failed\n"); grid = -1; return; }
        if (hipOccupancyMaxActiveBlocksPerMultiprocessor(&per_cu, (const void*)fwd, NWAVES * 64, LDS_BYTES) != hipSuccess || per_cu < 1) { fprintf(stderr, "kernel_launch: occupancy query reports %d\n", per_cu); }
        (void)hipGetLastError();
        grid = cus;
    }
    if (grid < 0) return;
    (void)hipMemsetAsync((char*)d_ws + WS_CTL, 0, CTL_ZERO_BYTES, stream);
    Args a{};
    for (int i = 0; i < 24; ++i) a.in[i] = (const float*)d_in[i];
    a.out = (float*)d_out; a.ws = (unsigned char*)d_ws;
#if MK_ONE_LAUNCH
    a.ph_lo = 0; a.ph_hi = NPHASE;
    hipLaunchKernelGGL(fwd, dim3(grid), dim3(NWAVES * 64), LDS_BYTES, stream, a);
#else
    for (int p = 0; p < NPHASE; ++p) {
        a.ph_lo = p; a.ph_hi = p + 1;
        hipLaunchKernelGGL(fwd, dim3(grid), dim3(NWAVES * 64), LDS_BYTES, stream, a);
    }
#endif
}
```

```cpp
#include <hip/hip_runtime.h>
#include <cstdio>
#include <cstdint>

#ifndef MK_ONE_LAUNCH
#define MK_ONE_LAUNCH 1
#endif

namespace pg8 {
#define PG8_LAS __attribute__((address_space(3)))
typedef unsigned short bf16_t;
typedef short bf16x8 __attribute__((ext_vector_type(8)));
typedef float f32x4 __attribute__((ext_vector_type(4)));
typedef unsigned u32x4 __attribute__((ext_vector_type(4)));
constexpr int BM = 256, BK = 64, HALF = 128, HTB = HALF * BK * 2  , STAGE_BYTES = 8 * HTB, NXCD = 8, WGM = 8;

__host__ __device__ __forceinline__ int lds_byte(int r, int c) { const int st = (r >> 4) * 2 + (c >> 5), rr = r & 15, cc = c & 31, ob = rr * 64 + cc * 2; return st * 1024 + (ob ^ (((ob >> 9) & 1) << 5)); }
__host__ __device__ __forceinline__ void stage_rc(int b, int& R, int& C) { const int st = b / 1024, sb = b % 1024, swz = sb ^ (((sb >> 9) & 1) << 5); R = (st >> 1) * 16 + swz / 64; C = (st & 1) * 32 + (swz % 64) / 2; }
__host__ __device__ __forceinline__ int perm32(int rho) { const int n = rho >> 4, i = rho & 15; return 8 * (i >> 2) + 4 * n + (i & 3); }

struct Unit { int pm, pn; const char* a; const char* b; bf16_t* o; int ldc; };
struct Gemm { const bf16_t* A; const bf16_t* Bt; int M, N, K; };

__device__ __forceinline__ void tile_map(int L, int nM, int nN, int& pm, int& pn) {
    const int nwg = nM * nN;
    int wgid = L; { const int q = nwg / NXCD, r = nwg % NXCD, xcd = wgid % NXCD, off = wgid / NXCD; wgid = (xcd < r ? xcd * (q + 1) : r * (q + 1) + (xcd - r) * q) + off; }
    const int nig = WGM * nN, gid = wgid / nig, fm = gid * WGM, gsz = (nM - fm) < WGM ? (nM - fm) : WGM;
    pm = fm + ((wgid % nig) % gsz); pn = (wgid % nig) / gsz;
}
__device__ __forceinline__ bool order_map(int i, int G, int c, int nM, int nN, int& pm, int& pn) {
    const long L = (long)i * G + c; if (L >= (long)nM * nN) return false;
    tile_map((int)L, nM, nN, pm, pn); return true;
}
struct Seg { const char* A; const char* B; bf16_t* O; int nM, nN, ldc; };
template <int NS> struct MultiOrder {
    Seg sg[NS]; int G, c; size_t tstep;
    __device__ __forceinline__ bool next(int i, Unit& u) const {
        long L = (long)i * G + c;
#pragma unroll
        for (int s = 0; s < NS; ++s) { const int n = sg[s].nM * sg[s].nN;
            if (L < n) { tile_map((int)L, sg[s].nM, sg[s].nN, u.pm, u.pn); u.a = sg[s].A + (size_t)u.pm * tstep; u.b = sg[s].B + (size_t)u.pn * tstep; u.o = sg[s].O; u.ldc = sg[s].ldc; return true; }
            L -= n; }
        return false;
    }
};
struct StaticOrder {
    int nM, nN, G, c; const char* A; const char* B; size_t tstep;
    __device__ void init(const Gemm& g, int G_, int c_) { nM = g.M / BM; nN = g.N / BM; G = G_; c = c_; A = (const char*)g.A; B = (const char*)g.Bt; tstep = (size_t)BM * g.K * 2; }
    __device__ __forceinline__ bool next(int i, Unit& u) const {
        if (!order_map(i, G, c, nM, nN, u.pm, u.pn)) return false;
        u.a = A + (size_t)u.pm * tstep; u.b = B + (size_t)u.pn * tstep; return true;
    }
};
struct MoeOrder {
    int nM, nN, G, c, pb0, pbA; const char* A; const char* W; size_t tstep, wstride; const int* blk_e;
    __device__ __forceinline__ bool next(int i, Unit& u) const {
        int pm, pn; if (!order_map(i, G, c, nM, nN, pm, pn)) return false;
        u.pm = pb0 + pm; u.pn = pn; const int e = __builtin_amdgcn_readfirstlane(blk_e[u.pm]);
        u.a = A + (size_t)(u.pm - pbA) * tstep; u.b = W + (size_t)e * wstride + (size_t)pn * tstep; return true;
    }
};

__device__ __forceinline__ unsigned cvt_pk_bf16(float lo, float hi) { unsigned r; asm volatile("v_cvt_pk_bf16_f32 %0, %1, %2" : "=v"(r) : "v"(lo), "v"(hi)); return r; }

struct EpiBf16 {
    static constexpr bool PERM = true;
    bf16_t* O; int ldc; int pm_off;
    __device__ __forceinline__ void operator()(const f32x4 (&acc)[2][2][4][2], const Unit& u, int wr, int wc, int fr, int fq) const {
        const int row0 = (u.pm - pm_off) * BM + wr * 64 + fr; const int col0 = u.pn * BM + wc * 32 + 8 * fq;
#pragma unroll
        for (int ai = 0; ai < 2; ++ai)
#pragma unroll
            for (int m = 0; m < 4; ++m) { bf16_t* rowp = O + (size_t)(row0 + ai * HALF + m * 16) * ldc + col0;
#pragma unroll
                for (int bj = 0; bj < 2; ++bj) { const f32x4 v0 = acc[ai][bj][m][0], v1 = acc[ai][bj][m][1];
                    u32x4 w; w.x = cvt_pk_bf16(v0[0], v0[1]); w.y = cvt_pk_bf16(v0[2], v0[3]); w.z = cvt_pk_bf16(v1[0], v1[1]); w.w = cvt_pk_bf16(v1[2], v1[3]);
                    *(u32x4*)(rowp + bj * HALF) = w; } }
    }
};
struct EpiBf16U {
    static constexpr bool PERM = true;
    __device__ __forceinline__ void operator()(const f32x4 (&acc)[2][2][4][2], const Unit& u, int wr, int wc, int fr, int fq) const {
        const int row0 = u.pm * BM + wr * 64 + fr; const int col0 = u.pn * BM + wc * 32 + 8 * fq;
#pragma unroll
        for (int ai = 0; ai < 2; ++ai)
#pragma unroll
            for (int m = 0; m < 4; ++m) { bf16_t* rowp = u.o + (size_t)(row0 + ai * HALF + m * 16) * u.ldc + col0;
#pragma unroll
                for (int bj = 0; bj < 2; ++bj) { const f32x4 v0 = acc[ai][bj][m][0], v1 = acc[ai][bj][m][1];
                    u32x4 w; w.x = cvt_pk_bf16(v0[0], v0[1]); w.y = cvt_pk_bf16(v0[2], v0[3]); w.z = cvt_pk_bf16(v1[0], v1[1]); w.w = cvt_pk_bf16(v1[2], v1[3]);
                    *(u32x4*)(rowp + bj * HALF) = w; } }
    }
};
__device__ __forceinline__ float silu_mul(float g, float u) { return g * __builtin_amdgcn_rcpf(1.0f + __expf(-g)) * u; }
struct EpiSwiGLU {
    static constexpr bool PERM = true;
    bf16_t* O; int ldc; int pm_off;
    __device__ __forceinline__ void operator()(const f32x4 (&acc)[2][2][4][2], const Unit& u, int wr, int wc, int fr, int fq) const {
        const int row0 = (u.pm - pm_off) * BM + wr * 64 + fr; const int col0 = u.pn * HALF + wc * 32 + 8 * fq;
#pragma unroll
        for (int ai = 0; ai < 2; ++ai)
#pragma unroll
            for (int m = 0; m < 4; ++m) { bf16_t* rowp = O + (size_t)(row0 + ai * HALF + m * 16) * ldc + col0;
                const f32x4 g0 = acc[ai][0][m][0], g1 = acc[ai][0][m][1], u0 = acc[ai][1][m][0], u1 = acc[ai][1][m][1];
                u32x4 w; w.x = cvt_pk_bf16(silu_mul(g0[0], u0[0]), silu_mul(g0[1], u0[1])); w.y = cvt_pk_bf16(silu_mul(g0[2], u0[2]), silu_mul(g0[3], u0[3]));
                w.z = cvt_pk_bf16(silu_mul(g1[0], u1[0]), silu_mul(g1[1], u1[1])); w.w = cvt_pk_bf16(silu_mul(g1[2], u1[2]), silu_mul(g1[3], u1[3]));
                *(u32x4*)rowp = w; }
    }
};


__device__ __forceinline__ float clamp448(float x) { return __builtin_amdgcn_fmed3f(x, -448.f, 448.f); }
__device__ __forceinline__ unsigned pack4_fp8(float a, float b, float c, float d) { unsigned w = 0; w = __builtin_amdgcn_cvt_pk_fp8_f32(clamp448(a), clamp448(b), w, false); w = __builtin_amdgcn_cvt_pk_fp8_f32(clamp448(c), clamp448(d), w, true); return w; }
struct EpiBf16S {
    static constexpr bool PERM = true;
    bf16_t* O; int ldc; int pm_off; float sc;
    __device__ __forceinline__ void operator()(const f32x4 (&acc)[2][2][4][2], const Unit& u, int wr, int wc, int fr, int fq) const {
        const int row0 = (u.pm - pm_off) * BM + wr * 64 + fr; const int col0 = u.pn * BM + wc * 32 + 8 * fq;
#pragma unroll
        for (int ai = 0; ai < 2; ++ai)
#pragma unroll
            for (int m = 0; m < 4; ++m) { bf16_t* rowp = O + (size_t)(row0 + ai * HALF + m * 16) * ldc + col0;
#pragma unroll
                for (int bj = 0; bj < 2; ++bj) { const f32x4 v0 = acc[ai][bj][m][0] * sc, v1 = acc[ai][bj][m][1] * sc;
                    u32x4 w; w.x = cvt_pk_bf16(v0[0], v0[1]); w.y = cvt_pk_bf16(v0[2], v0[3]); w.z = cvt_pk_bf16(v1[0], v1[1]); w.w = cvt_pk_bf16(v1[2], v1[3]);
                    *(u32x4*)(rowp + bj * HALF) = w; } }
    }
};
struct EpiSwiGLU8 {
    static constexpr bool PERM = true;
    unsigned char* O; int ldc; int pm_off; float sc_in, sc_out;
    __device__ __forceinline__ void operator()(const f32x4 (&acc)[2][2][4][2], const Unit& u, int wr, int wc, int fr, int fq) const {
        typedef unsigned u32x2 __attribute__((ext_vector_type(2)));
        const int row0 = (u.pm - pm_off) * BM + wr * 64 + fr; const int col0 = u.pn * HALF + wc * 32 + 8 * fq;
#pragma unroll
        for (int ai = 0; ai < 2; ++ai)
#pragma unroll
            for (int m = 0; m < 4; ++m) { unsigned char* rowp = O + (size_t)(row0 + ai * HALF + m * 16) * ldc + col0;
                const f32x4 g0 = acc[ai][0][m][0] * sc_in, g1 = acc[ai][0][m][1] * sc_in, u0 = acc[ai][1][m][0] * sc_in, u1 = acc[ai][1][m][1] * sc_in;
                u32x2 w; w.x = pack4_fp8(silu_mul(g0[0], u0[0]) * sc_out, silu_mul(g0[1], u0[1]) * sc_out, silu_mul(g0[2], u0[2]) * sc_out, silu_mul(g0[3], u0[3]) * sc_out);
                w.y = pack4_fp8(silu_mul(g1[0], u1[0]) * sc_out, silu_mul(g1[1], u1[1]) * sc_out, silu_mul(g1[2], u1[2]) * sc_out, silu_mul(g1[3], u1[3]) * sc_out);
                *(u32x2*)rowp = w; __builtin_amdgcn_sched_barrier(0); }
    }
};

struct XaOrder {
    int G, c, mode; const char* A; const char* B;
    __device__ __forceinline__ bool next(int i, Unit& u) const {
        const int L = i * G + c; if (L >= 512) return false;
        u.pm = L >> 2; u.pn = L & 3; const int b = u.pm >> 5;
        u.a = A + (size_t)u.pm * 256 * 2048 + u.pn * 512;
        u.b = mode == 0 ? B + (size_t)(b * 256) * 2048 + u.pn * 512 : B + (size_t)(u.pn * 256) * 2048 + b * 512;
        return true;
    }
};
struct EpiXaSoftmax {
    static constexpr bool PERM = true;
    bf16_t* P; PG8_LAS float* tab;
    __device__ __forceinline__ void operator()(f32x4 (&acc)[2][2][4][2], const Unit& u, int wr, int wc, int fr, int fq) const {
        constexpr float SCL2 = 0.0625f * 1.4426950408889634f;
#pragma unroll
        for (int ai = 0; ai < 2; ++ai)
#pragma unroll
            for (int m = 0; m < 4; ++m) { float v = -INFINITY;
#pragma unroll
                for (int bj = 0; bj < 2; ++bj)
#pragma unroll
                    for (int n = 0; n < 2; ++n) { const f32x4 x = acc[ai][bj][m][n]; v = fmaxf(fmaxf(v, fmaxf(x[0], x[1])), fmaxf(x[2], x[3])); }
                v = fmaxf(v, __shfl_xor(v, 16)); v = fmaxf(v, __shfl_xor(v, 32));
                if (fq == 0) tab[(ai * HALF + wr * 64 + m * 16 + fr) * 4 + wc] = v; }
        asm volatile("s_waitcnt lgkmcnt(0)" ::: "memory"); __builtin_amdgcn_s_barrier(); asm volatile("" ::: "memory");
#pragma unroll
        for (int ai = 0; ai < 2; ++ai)
#pragma unroll
            for (int m = 0; m < 4; ++m) { const int rr = ai * HALF + wr * 64 + m * 16 + fr; const f32x4 t = *(const PG8_LAS f32x4*)(tab + rr * 4);
                const float mx = fmaxf(fmaxf(t[0], t[1]), fmaxf(t[2], t[3])) * SCL2; float sm = 0.f;
#pragma unroll
                for (int bj = 0; bj < 2; ++bj)
#pragma unroll
                    for (int n = 0; n < 2; ++n) { f32x4 x = acc[ai][bj][m][n];
#pragma unroll
                        for (int i = 0; i < 4; ++i) { x[i] = __builtin_amdgcn_exp2f(x[i] * SCL2 - mx); sm += x[i]; }
                        acc[ai][bj][m][n] = x; }
                sm += __shfl_xor(sm, 16); sm += __shfl_xor(sm, 32);
                if (fq == 0) tab[1024 + rr * 4 + wc] = sm; }
        asm volatile("s_waitcnt lgkmcnt(0)" ::: "memory"); __builtin_amdgcn_s_barrier(); asm volatile("" ::: "memory");
        const int row0 = u.pm * BM + wr * 64 + fr; const int col0 = u.pn * BM + wc * 32 + 8 * fq;
#pragma unroll
        for (int ai = 0; ai < 2; ++ai)
#pragma unroll
            for (int m = 0; m < 4; ++m) { const int rr = ai * HALF + wr * 64 + m * 16 + fr; const f32x4 t = *(const PG8_LAS f32x4*)(tab + 1024 + rr * 4);
                const float inv = 1.f / ((t[0] + t[1]) + (t[2] + t[3]));
                bf16_t* rowp = P + (size_t)(row0 + ai * HALF + m * 16) * 1024 + col0;
#pragma unroll
                for (int bj = 0; bj < 2; ++bj) { const f32x4 v0 = acc[ai][bj][m][0] * inv, v1 = acc[ai][bj][m][1] * inv;
                    u32x4 w; w.x = cvt_pk_bf16(v0[0], v0[1]); w.y = cvt_pk_bf16(v0[2], v0[3]); w.z = cvt_pk_bf16(v1[0], v1[1]); w.w = cvt_pk_bf16(v1[2], v1[3]);
                    *(u32x4*)(rowp + bj * HALF) = w; } }
    }
};

typedef int v8i32 __attribute__((ext_vector_type(8)));
typedef int v4i32 __attribute__((ext_vector_type(4)));
__device__ __forceinline__ v8i32 cat8(bf16x8 a, bf16x8 b) { return __builtin_shufflevector(__builtin_bit_cast(v4i32, a), __builtin_bit_cast(v4i32, b), 0, 1, 2, 3, 4, 5, 6, 7); }
template <class Epi, class Sched, bool ALIGN_EPI = false, bool SP2 = false, bool F8 = false>
__device__ __forceinline__ void gemm_phase(PG8_LAS unsigned char* lds, const int K, const Sched& S, const Epi& E, const int lda = 0, const int ldb = 0) {
    int tid_ = threadIdx.x; asm volatile("" : "+v"(tid_));
    const int tid = tid_, wid = __builtin_amdgcn_readfirstlane(tid >> 6), lane = tid & 63, wr = wid >> 2, wc = wid & 3, fr = lane & 15, fq = lane >> 4;
    const int nt = K / BK, pa = lda ? lda : K, pb = ldb ? ldb : K;
    unsigned voffA[2], voffB[2];
#pragma unroll
    for (int i = 0; i < 2; ++i) { int R, C; stage_rc(tid * 16 + i * 8192, R, C); const int Rb = Epi::PERM ? ((R & ~31) + perm32(R & 31)) : R;
        voffA[i] = (unsigned)(R * pa + C) * 2u; voffB[i] = (unsigned)(Rb * pb + C) * 2u; }
    const size_t kstep = (size_t)(BK * 2);
    const size_t hstepA = (size_t)HALF * pa * 2, hstepB = (size_t)HALF * pb * 2;
    const unsigned ldsw = (unsigned)wid * 1024u;
    const int aoff = lds_byte(wr * 64 + fr, fq * 8), boff = lds_byte(wc * 32 + fr, fq * 8);
#define PG8_SA(b, h) (((b) * 2 + (h)) * HTB)
#define PG8_SB(b, h) ((4 + (b) * 2 + (h)) * HTB)
#define PG8_STAGE(bufoff, gbase, voff) do { _Pragma("unroll") for (int _i = 0; _i < 2; ++_i) \
        __builtin_amdgcn_global_load_lds((const unsigned*)((const char*)(gbase) + (voff)[_i]), (PG8_LAS unsigned*)(lds + (bufoff) + ldsw + _i * 8192), 16, 0, 0); } while (0)
#define PG8_LDA(dst, b, h) do { _Pragma("unroll") for (int m = 0; m < 4; ++m) { if constexpr (F8) { dst##8[m].lo = *(const PG8_LAS v4i32*)(lds + PG8_SA(b, h) + aoff + m * 2048); dst##8[m].hi = *(const PG8_LAS v4i32*)(lds + PG8_SA(b, h) + aoff + m * 2048 + 1024); } \
        else { _Pragma("unroll") for (int k = 0; k < 2; ++k) dst[m][k] = *(const PG8_LAS bf16x8*)(lds + PG8_SA(b, h) + aoff + m * 2048 + k * 1024); } } } while (0)
#define PG8_LDB(dst, b, h) do { _Pragma("unroll") for (int n = 0; n < 2; ++n) { if constexpr (F8) { dst##8[n].lo = *(const PG8_LAS v4i32*)(lds + PG8_SB(b, h) + boff + n * 2048); dst##8[n].hi = *(const PG8_LAS v4i32*)(lds + PG8_SB(b, h) + boff + n * 2048 + 1024); } \
        else { _Pragma("unroll") for (int k = 0; k < 2; ++k) dst[n][k] = *(const PG8_LAS bf16x8*)(lds + PG8_SB(b, h) + boff + n * 2048 + k * 1024); } } } while (0)
#define PG8_MMA(ai, bj, At, Bt) do { __builtin_amdgcn_s_setprio(1); _Pragma("unroll") for (int m = 0; m < 4; ++m) _Pragma("unroll") for (int n = 0; n < 2; ++n) { \
        if constexpr (F8) asm volatile("v_mfma_scale_f32_16x16x128_f8f6f4 %0, %1, %2, %0, %3, %3 op_sel_hi:[0,0,0]" : "+v"(acc[ai][bj][m][n]) : "v"(Bt##8[n]), "v"(At##8[m]), "v"(f8scale)); \
        else { _Pragma("unroll") for (int k = 0; k < 2; ++k) acc[ai][bj][m][n] = __builtin_amdgcn_mfma_f32_16x16x32_bf16(Bt[n][k], At[m][k], acc[ai][bj][m][n], 0, 0, 0); } } __builtin_amdgcn_s_setprio(0); } while (0)
#define PG8_WAIT_V(n) asm volatile("s_waitcnt vmcnt(" #n ")" ::: "memory")
#define PG8_WAIT_L(n) asm volatile("s_waitcnt lgkmcnt(" #n ")" ::: "memory")
#define PG8_BAR __builtin_amdgcn_s_barrier()
#define PG8_SCHED __builtin_amdgcn_sched_barrier(0)
    Unit cur, nxt; int ui = 0;
    if (!S.next(0, cur)) return;
    f32x4 acc[2][2][4][2];
#pragma unroll
    for (int a = 0; a < 2; ++a)
#pragma unroll
        for (int b = 0; b < 2; ++b)
#pragma unroll
            for (int m = 0; m < 4; ++m)
#pragma unroll
                for (int n = 0; n < 2; ++n) acc[a][b][m][n] = (f32x4){0.f, 0.f, 0.f, 0.f};
    bf16x8 At[4][2], B0[2][2], B1[2][2]; v8i32 At8[4], B08[2], B18[2];
    int f8scale = 0x7F7F7F7F; asm volatile("" : "+v"(f8scale));
    const char* cA = cur.a; const char* cB = cur.b;
    if constexpr (SP2) {
        PG8_STAGE(PG8_SB(0, 0), cB, voffB); PG8_STAGE(PG8_SB(0, 1), cB + hstepB, voffB); PG8_STAGE(PG8_SA(0, 0), cA, voffA); PG8_STAGE(PG8_SA(0, 1), cA + hstepA, voffA);
        if (wr == 1) PG8_BAR;
        PG8_WAIT_V(2); PG8_BAR;
        PG8_STAGE(PG8_SB(1, 0), cB + kstep, voffB); PG8_STAGE(PG8_SA(1, 0), cA + kstep, voffA); PG8_STAGE(PG8_SB(1, 1), cB + hstepB + kstep, voffB);
        PG8_WAIT_V(6); PG8_BAR;
    } else {
        PG8_STAGE(PG8_SB(0, 0), cB, voffB); PG8_STAGE(PG8_SA(0, 0), cA, voffA); PG8_STAGE(PG8_SB(0, 1), cB + hstepB, voffB); PG8_STAGE(PG8_SA(0, 1), cA + hstepA, voffA);
        if (wr == 1) PG8_BAR;
        PG8_WAIT_V(4); PG8_BAR;
        PG8_STAGE(PG8_SB(1, 0), cB + kstep, voffB); PG8_STAGE(PG8_SA(1, 0), cA + kstep, voffA); PG8_STAGE(PG8_SB(1, 1), cB + hstepB + kstep, voffB);
        PG8_WAIT_V(6); PG8_BAR;
    }
    for (;;) {
        const bool has_next = S.next(ui + 1, nxt);
        const char* nA = has_next ? nxt.a : cA; const char* nB = has_next ? nxt.b : cB;
#pragma nounroll
        for (int t = 0; t < nt; t += 2) {
            const bool last = (t == nt - 2);
            const char* a1 = cA + (size_t)(t + 1) * kstep;
            const char* a2 = last ? nA : cA + (size_t)(t + 2) * kstep; const char* b2 = last ? nB : cB + (size_t)(t + 2) * kstep;
            const char* a3 = a2 + kstep; const char* b3 = b2 + kstep;
            if constexpr (SP2) {
            PG8_LDB(B0, 0, 0); PG8_LDB(B1, 0, 1); PG8_SCHED; PG8_LDA(At, 0, 0); PG8_STAGE(PG8_SA(1, 1), a1 + hstepA, voffA);
            PG8_WAIT_V(8); PG8_WAIT_L(0); PG8_BAR; PG8_MMA(0, 0, At, B0); PG8_MMA(0, 1, At, B1); PG8_BAR; PG8_SCHED;
            PG8_LDA(At, 0, 1); PG8_STAGE(PG8_SB(0, 0), b2, voffB); PG8_STAGE(PG8_SB(0, 1), b2 + hstepB, voffB); PG8_STAGE(PG8_SA(0, 0), a2, voffA);
            PG8_WAIT_V(8); PG8_WAIT_L(0); PG8_BAR; PG8_MMA(1, 0, At, B0); PG8_MMA(1, 1, At, B1); PG8_BAR; PG8_SCHED;
            PG8_LDB(B0, 1, 0); PG8_LDB(B1, 1, 1); PG8_SCHED; PG8_LDA(At, 1, 0); PG8_STAGE(PG8_SA(0, 1), a2 + hstepA, voffA);
            PG8_WAIT_V(8); PG8_WAIT_L(0); PG8_BAR; PG8_MMA(0, 0, At, B0); PG8_MMA(0, 1, At, B1); PG8_BAR; PG8_SCHED;
            PG8_LDA(At, 1, 1); PG8_STAGE(PG8_SB(1, 0), b3, voffB); PG8_STAGE(PG8_SB(1, 1), b3 + hstepB, voffB); PG8_STAGE(PG8_SA(1, 0), a3, voffA);
            PG8_WAIT_V(8); PG8_WAIT_L(0); PG8_BAR; PG8_MMA(1, 0, At, B0); PG8_MMA(1, 1, At, B1); PG8_BAR; PG8_SCHED;
            } else {
            PG8_LDB(B0, 0, 0); PG8_SCHED; PG8_LDA(At, 0, 0); PG8_STAGE(PG8_SA(1, 1), a1 + hstepA, voffA);
            PG8_WAIT_L(8); PG8_BAR; PG8_WAIT_L(0); PG8_MMA(0, 0, At, B0); PG8_BAR; PG8_SCHED;
            PG8_LDB(B1, 0, 1); PG8_STAGE(PG8_SB(0, 0), b2, voffB);
            PG8_BAR; PG8_WAIT_L(0); PG8_MMA(0, 1, At, B1); PG8_BAR;
            PG8_LDA(At, 0, 1); PG8_STAGE(PG8_SA(0, 0), a2, voffA);
            PG8_BAR; PG8_WAIT_L(0); PG8_MMA(1, 0, At, B0); PG8_BAR; PG8_SCHED;
            PG8_STAGE(PG8_SB(0, 1), b2 + hstepB, voffB);
            PG8_WAIT_V(6); PG8_BAR; PG8_MMA(1, 1, At, B1); PG8_BAR;
            PG8_LDB(B0, 1, 0); PG8_SCHED; PG8_LDA(At, 1, 0); PG8_STAGE(PG8_SA(0, 1), a2 + hstepA, voffA);
            PG8_WAIT_L(8); PG8_BAR; PG8_WAIT_L(0); PG8_MMA(0, 0, At, B0); PG8_BAR; PG8_SCHED;
            PG8_LDB(B1, 1, 1); PG8_STAGE(PG8_SB(1, 0), b3, voffB);
            PG8_BAR; PG8_WAIT_L(0); PG8_MMA(0, 1, At, B1); PG8_BAR;
            PG8_LDA(At, 1, 1); PG8_STAGE(PG8_SA(1, 0), a3, voffA);
            PG8_BAR; PG8_WAIT_L(0); PG8_MMA(1, 0, At, B0); PG8_BAR; PG8_SCHED;
            PG8_STAGE(PG8_SB(1, 1), b3 + hstepB, voffB);
            PG8_WAIT_V(6); PG8_BAR; PG8_MMA(1, 1, At, B1); PG8_BAR;
            }
        }
        if constexpr (F8) asm volatile("s_nop 15\n\ts_nop 15" ::: "memory");
        if constexpr (ALIGN_EPI) { if (wr == 0) PG8_BAR; }
        E(acc, cur, wr, wc, fr, fq);
        if (!has_next) break;
#pragma unroll
        for (int a = 0; a < 2; ++a)
#pragma unroll
            for (int b = 0; b < 2; ++b)
#pragma unroll
                for (int m = 0; m < 4; ++m)
#pragma unroll
                    for (int n = 0; n < 2; ++n) acc[a][b][m][n] = (f32x4){0.f, 0.f, 0.f, 0.f};
        cur = nxt; cA = nA; cB = nB; ++ui;
        if constexpr (ALIGN_EPI) { if (wr == 1) PG8_BAR; }
    }
    PG8_WAIT_V(0);
    if constexpr (!ALIGN_EPI) { if (wr == 0) PG8_BAR; }
    PG8_BAR;
#undef PG8_SA
#undef PG8_SB
#undef PG8_STAGE
#undef PG8_LDA
#undef PG8_LDB
#undef PG8_MMA
#undef PG8_WAIT_V
#undef PG8_WAIT_L
#undef PG8_BAR
#undef PG8_SCHED
}
}

constexpr int NBATCH = 4, SEQ = 8192, D = 1024, NTOK = NBATCH * SEQ, DEPTH = 2;
constexpr int HD = 64, NSB = 6, NFX = 6, SBD = 384, FXD = 384, POOLD = 256, CIN = 2566;
constexpr int MEML = 256, NMEM = NBATCH * MEML, XAH = 4, XAD = 256;
constexpr int DFF = 2816, NE = 8;
constexpr float EPS = 1e-6f;
constexpr int PP = 1792, C_SQ = 0, C_SK = 384, C_FQ = 768, C_FK = 1152, C_U = 1536;
constexpr int VTN = 768, VTP = NTOK + 2112;
constexpr int MAXBLK = 264, CHUNK_BLK = 128, CHUNK1_MAX = MAXBLK - CHUNK_BLK;

constexpr size_t MiB = 1u << 20;
constexpr size_t WS_CTL = 0, CTL_ZERO_BYTES = 1 * MiB;
constexpr size_t WS_WF   = 1 * MiB;
constexpr size_t WS_WR   = WS_WF + 65536;
constexpr size_t WS_BLKE = WS_WR + 32768;
constexpr size_t WS_LOGF = 2 * MiB;
constexpr size_t WS_CCUM = 3 * MiB;
constexpr size_t WS_TOKT = 4 * MiB;
constexpr size_t WS_MN   = 5 * MiB;
constexpr size_t WS_XKV  = 9 * MiB;
constexpr size_t WS_WS1  = 18 * MiB;
constexpr size_t WS_WMOE = 33 * MiB;
constexpr size_t WS_R2   = 165 * MiB;
constexpr size_t WS_R1   = 297 * MiB;
constexpr size_t R1_BYTES = (size_t)CHUNK1_MAX * 256 * DFF * 2;
constexpr size_t WS_END  = WS_R1 + R1_BYTES;
constexpr size_t OW_IN = 0, OW_OUT = 5 * MiB, OW_Q = 7 * MiB, OW_KV = 9 * MiB, OW_O = 13 * MiB, OW_LAYER = 15 * MiB;
constexpr size_t WS_WS0 = WS_WMOE;
constexpr size_t WS_WGU0 = WS_WS0 + OW_LAYER;
constexpr size_t WS_WD0 = WS_WGU0 + 11 * MiB;
constexpr size_t MOE_GU_BYTES = (size_t)2 * DFF * D, MOE_D_BYTES = (size_t)D * DFF, MOE_E_BYTES = MOE_GU_BYTES + MOE_D_BYTES;
constexpr size_t WS_XS8 = WS_WMOE + 8 * MOE_E_BYTES;
static_assert(WS_WD0 + (size_t)D * DFF * 2 <= WS_WMOE + 132 * MiB && WS_XS8 + (size_t)MAXBLK * 256 * D <= WS_WMOE + 132 * MiB, "weights map");
constexpr size_t R2_HN = WS_R2, R2_MIX = WS_R2 + 64 * MiB;
constexpr size_t R1_PROJ = WS_R1;
constexpr size_t R1_VT = WS_R1 + 112 * MiB;
constexpr size_t R1_A = WS_R1, R1_B = WS_R1 + 64 * MiB;
constexpr size_t R1_ACT = WS_R1;
constexpr size_t R1_ACT8 = WS_R1;
constexpr size_t R2_XS = WS_R2;
static_assert((size_t)NTOK * DFF * 2 <= R1_BYTES && (size_t)MAXBLK * 256 * D * 2 <= 132 * MiB && WS_END <= 513026096, "arena map");
constexpr int CW_CNT = 64;
constexpr int CW_KMAX = 128;
constexpr int CW_BAR = 4096;

constexpr int RING_OFF = 0, RING_BYTES = 131072;
constexpr int LDSCTL_OFF = RING_BYTES, MISC_OFF = LDSCTL_OFF + 320;
constexpr int LDS_BYTES = 147456;
constexpr int NWAVES = 8;

#define GAS __attribute__((address_space(1)))
#define LAS __attribute__((address_space(3)))
typedef unsigned short bf16;
typedef unsigned v4u __attribute__((ext_vector_type(4)));
typedef unsigned v2u __attribute__((ext_vector_type(2)));
typedef float f32x4 __attribute__((ext_vector_type(4)));
typedef GAS unsigned gu32;
#define RLX_AGENT __ATOMIC_RELAXED, __HIP_MEMORY_SCOPE_AGENT
#define LDS_WAIT() asm volatile("s_waitcnt lgkmcnt(0)" ::: "memory")
#define VM_WAIT() asm volatile("s_waitcnt vmcnt(0)" ::: "memory")
__device__ __forceinline__ unsigned f2bf(float f) { unsigned u = __builtin_bit_cast(unsigned, f); return (u + 0x7fffu + ((u >> 16) & 1u)) >> 16; }
__device__ __forceinline__ unsigned pk2(float lo, float hi) { return f2bf(lo) | (f2bf(hi) << 16); }
__device__ __forceinline__ float bflo(unsigned u) { return __uint_as_float(u << 16); }
__device__ __forceinline__ float bfhi(unsigned u) { return __uint_as_float(u & 0xffff0000u); }
__device__ __forceinline__ float bf2f(bf16 b) { return __uint_as_float(((unsigned)b) << 16); }

#define XB_TMO      128
#define XB_XCNT(j)  (256  + 64 * (j))
#define XB_XSUB(j)  (1280 + 64 * (j))
#define XB_XGEN(j)  (2304 + 64 * (j))
#define XB_TOP      3328
#define XB_TOPGEN   3392
#define XCD_BAR_WORDS 3456
#define XB_SPIN_CAP (1u << 22)

__device__ __forceinline__ unsigned xb_ld(unsigned* p)              { return __hip_atomic_load(p, __ATOMIC_RELAXED, __HIP_MEMORY_SCOPE_AGENT); }
__device__ __forceinline__ unsigned xb_add(unsigned* p, unsigned v) { return __hip_atomic_fetch_add(p, v, __ATOMIC_RELAXED, __HIP_MEMORY_SCOPE_AGENT); }
__device__ __forceinline__ unsigned xb_xcc_id() { return (unsigned)__builtin_amdgcn_s_getreg((3 << 11) | 20) & 0xFu; }
#define XB_SPIN(cond, bar) do { unsigned _sp = 0; while (cond) { __builtin_amdgcn_s_sleep(1); \
    if ((++_sp & 255u) == 0u) { if (xb_ld(&(bar)[XB_TMO])) break; if (_sp > XB_SPIN_CAP) { atomicAdd(&(bar)[XB_TMO], 1u); break; } } } } while (0)

struct XcdBarrier { unsigned* bar; unsigned x; volatile LAS unsigned* st; };

__device__ __forceinline__ XcdBarrier xcd_barrier_post(unsigned* bar, volatile LAS unsigned* st) {
    XcdBarrier b; b.bar = bar; b.x = xb_xcc_id(); b.st = st;
    if (threadIdx.x == 0) (void)xb_add(&bar[XB_XCNT(b.x)], 1u);
    return b;
}
__device__ __forceinline__ void xcd_barrier_complete(unsigned* bar, unsigned x, unsigned& nloc, unsigned& nx) {
    const unsigned G = gridDim.x * gridDim.y * gridDim.z;
    unsigned sum, cnt, mine, sp = 0u;
    for (;;) {
        sum = 0u; cnt = 0u; mine = 0u;
#pragma unroll
        for (unsigned j = 0; j < 16; ++j) { const unsigned c = xb_ld(&bar[XB_XCNT(j)]); sum += c; cnt += (c > 0u) ? 1u : 0u; mine = (j == x) ? c : mine; }
        if (sum == G) break;
        __builtin_amdgcn_s_sleep(1);
        if ((++sp & 255u) == 0u) { if (xb_ld(&bar[XB_TMO])) break; if (sp > XB_SPIN_CAP) { atomicAdd(&bar[XB_TMO], 1u); break; } }
    }
    nloc = mine > 0u ? mine : 1u; nx = cnt > 0u ? cnt : 1u;
}
__device__ __forceinline__ void xcd_barrier(const XcdBarrier& b) {
    asm volatile("s_waitcnt vmcnt(0)" ::: "memory");
    __syncthreads();
    if (threadIdx.x == 0) {
        unsigned* bar = b.bar;
        __builtin_amdgcn_s_waitcnt(0);
        unsigned nloc = b.st[0], nx = b.st[1];
        if (nloc == 0u) { xcd_barrier_complete(bar, b.x, nloc, nx); b.st[0] = nloc; b.st[1] = nx; }
        const unsigned old = xb_add(&bar[XB_XSUB(b.x)], 1u);
        const unsigned gen = old / nloc;
        if (old + 1u == (gen + 1u) * nloc) {
            __builtin_amdgcn_fence(__ATOMIC_RELEASE, "agent");
            asm volatile("s_waitcnt vmcnt(0)" ::: "memory");
            const unsigned og = xb_add(&bar[XB_TOP], 1u);
            const unsigned tg = og / nx;
            if (og + 1u == (tg + 1u) * nx) xb_add(&bar[XB_TOPGEN], 1u);
            else XB_SPIN(xb_ld(&bar[XB_TOPGEN]) == tg, bar);
            __builtin_amdgcn_fence(__ATOMIC_ACQUIRE, "agent");
            xb_add(&bar[XB_XGEN(b.x)], 1u);
            asm volatile("s_waitcnt vmcnt(0)" ::: "memory");
        } else {
            XB_SPIN(xb_ld(&bar[XB_XGEN(b.x)]) == gen, bar);
            __builtin_amdgcn_fence(__ATOMIC_ACQUIRE, "agent");
            asm volatile("s_waitcnt vmcnt(0)" ::: "memory");
        }
    }
    __syncthreads();
}

enum In { I_X = 0, I_MEM, I_MIXPRE, I_MIXPOST, I_WIN, I_BF, I_POOLW, I_POOLS, I_WOUT, I_XAPRE, I_XAPOST, I_MEMN, I_XQ, I_XKV, I_XO, I_FFPRE, I_FFPOST,
          I_DG, I_DU, I_DD, I_RW, I_MG, I_MU, I_MD };

struct Args { const float* in[24]; float* out; unsigned char* ws; int ph_lo, ph_hi; };
__device__ __forceinline__ const __attribute__((address_space(4))) Args* kargs() { const __attribute__((address_space(4))) Args* p = (const __attribute__((address_space(4))) Args*)__builtin_amdgcn_kernarg_segment_ptr(); asm volatile("" : "+s"(p)); return p; }
#define WSB (kargs()->ws)
#define INP(i) (kargs()->in[i])
#define OUTP (kargs()->out)
struct Frame {
    LAS unsigned char* lds;
    gu32* ctl;
    int tid, lane, wave;
    int vcu, G, roff;
};


__device__ __forceinline__ void fresh(Frame& F) { int t = threadIdx.x; asm volatile("" : "+v"(t)); F.tid = t; F.lane = t & 63; F.wave = __builtin_amdgcn_readfirstlane(t >> 6); }
__device__ __forceinline__ float wave_sum(float v) {
#pragma unroll
    for (int o = 1; o < 64; o <<= 1) v += __shfl_xor(v, o);
    return v;
}
__device__ __forceinline__ float wave_max(float v) {
#pragma unroll
    for (int o = 1; o < 64; o <<= 1) v = fmaxf(v, __shfl_xor(v, o));
    return v;
}
__device__ __forceinline__ float log_sigmoid(float x) { return x < 0.f ? x - log1pf(__expf(x)) : -log1pf(__expf(-x)); }

template <bool GU>
__device__ __forceinline__ void conv_item4(const float* W, int ldw, int n, int k0, bf16* WT, int K, int row0, int which) {
    const int rb = GU ? (256 * (n >> 7) + 128 * which + (n & 127)) : (row0 + n);
#pragma unroll
    for (int kk = 0; kk < 32; kk += 8) {
        f32x4 f[8];
#pragma unroll
        for (int i = 0; i < 8; ++i) f[i] = *(const f32x4*)(W + (size_t)(k0 + kk + i) * ldw + n);
#pragma unroll
        for (int j = 0; j < 4; ++j) { v4u o; o.x = pk2(f[0][j], f[1][j]); o.y = pk2(f[2][j], f[3][j]); o.z = pk2(f[4][j], f[5][j]); o.w = pk2(f[6][j], f[7][j]);
            *(v4u*)(WT + (size_t)(rb + j) * K + k0 + kk) = o; }
    }
}
__device__ __forceinline__ void conv_item1(const float* W, int ldw, int col, int k0, bf16* WT, int K, int row) {
#pragma unroll
    for (int kk = 0; kk < 32; kk += 8) {
        float f[8];
#pragma unroll
        for (int i = 0; i < 8; ++i) f[i] = W[(size_t)(k0 + kk + i) * ldw + col];
        v4u o; o.x = pk2(f[0], f[1]); o.y = pk2(f[2], f[3]); o.z = pk2(f[4], f[5]); o.w = pk2(f[6], f[7]);
        *(v4u*)(WT + (size_t)row * K + k0 + kk) = o;
    }
}
__device__ __forceinline__ int conv_first(Frame& F, int nitems) {
    const int gw = F.vcu * NWAVES + F.wave, NGW = F.G * NWAVES; int it = gw - F.roff; if (it < 0) it += NGW; F.roff = (F.roff + nitems) % NGW; return it;
}
__device__ __forceinline__ void transpose_mat(Frame& F, const float* W, int ldw, int col0, int ncols, int K, bf16* WT, int row0, LAS float* scr) {
    (void)scr; const int NGW = F.G * NWAVES, nkb = K / 32;
    if ((ldw & 3) == 0 && (col0 & 3) == 0 && (ncols & 255) == 0) {
        const int nitems = nkb * (ncols / 256);
        for (int it = conv_first(F, nitems); it < nitems; it += NGW) { const int kb = it % nkb, nb = it / nkb; conv_item4<false>(W + col0, ldw, 256 * nb + 4 * F.lane, 32 * kb, WT, K, row0, 0); }
    } else {
        const int nitems = nkb * (ncols / 64);
        for (int it = conv_first(F, nitems); it < nitems; it += NGW) { const int kb = it % nkb, nb = it / nkb; conv_item1(W, ldw, col0 + 64 * nb + F.lane, 32 * kb, WT, K, row0 + 64 * nb + F.lane); }
    }
}
__device__ __forceinline__ void transpose_gu(Frame& F, const float* Wg, const float* Wu, bf16* WT, LAS float* scr) {
    (void)scr; const int NGW = F.G * NWAVES, nkb = D / 32, ncb = DFF / 256, nitems = 2 * nkb * ncb;
    for (int it = conv_first(F, nitems); it < nitems; it += NGW) { const int kb = it % nkb, r = it / nkb, nb = r % ncb, which = r / ncb;
        conv_item4<true>(which ? Wu : Wg, DFF, 256 * nb + 4 * F.lane, 32 * kb, WT, D, 0, which); }
}
template <bool GU>
__device__ __forceinline__ void conv_item4_f8(const float* W, int ldw, int n, int k0, unsigned char* WT, int K, int row0, int which) {
    const int rb = GU ? (256 * (n >> 7) + 128 * which + (n & 127)) : (row0 + n);
#pragma unroll
    for (int kk = 0; kk < 32; kk += 8) {
        f32x4 f[8];
#pragma unroll
        for (int i = 0; i < 8; ++i) f[i] = *(const f32x4*)(W + (size_t)(k0 + kk + i) * ldw + n) * 256.f;
#pragma unroll
        for (int j = 0; j < 4; ++j) { v2u o; o.x = pg8::pack4_fp8(f[0][j], f[1][j], f[2][j], f[3][j]); o.y = pg8::pack4_fp8(f[4][j], f[5][j], f[6][j], f[7][j]);
            *(v2u*)(WT + (size_t)(rb + j) * K + k0 + kk) = o; }
    }
}
__device__ __forceinline__ void transpose_mat_f8(Frame& F, const float* W, int ldw, int ncols, int K, unsigned char* WT) {
    const int NGW = F.G * NWAVES, nkb = K / 32, nitems = nkb * (ncols / 256);
    for (int it = conv_first(F, nitems); it < nitems; it += NGW) { const int kb = it % nkb, nb = it / nkb; conv_item4_f8<false>(W, ldw, 256 * nb + 4 * F.lane, 32 * kb, WT, K, 0, 0); }
}
__device__ __forceinline__ void transpose_gu_f8(Frame& F, const float* Wg, const float* Wu, unsigned char* WT) {
    const int NGW = F.G * NWAVES, nkb = D / 32, ncb = DFF / 256, nitems = 2 * nkb * ncb;
    for (int it = conv_first(F, nitems); it < nitems; it += NGW) { const int kb = it % nkb, r = it / nkb, nb = r % ncb, which = r / ncb;
        conv_item4_f8<true>(which ? Wu : Wg, DFF, 256 * nb + 4 * F.lane, 32 * kb, WT, D, 0, which); }
}
__device__ __forceinline__ void convert_layer_small(Frame& F, int l, bf16* base, LAS float* scr) {
    const float* win = INP(I_WIN) + (size_t)l * D * CIN;
    bf16* wt = base + OW_IN / 2;
    transpose_mat(F, win, CIN, 0, 768, D, wt, 0, scr);
    transpose_mat(F, win, CIN, 1152, 768, D, wt, 768, scr);
    { const float* pw = INP(I_POOLW) + (size_t)l * 4 * 4096; const float* psc = INP(I_POOLS) + (size_t)l * POOLD;
      for (int i = (F.vcu * NWAVES + F.wave) * 64 + F.lane; i < POOLD * D; i += F.G * NWAVES * 64) { const int n = i / D, k = i % D, g = n >> 6, co = n & 63;
          const float* wr = win + (size_t)k * CIN + 2310 + g * 64; const float* pc = pw + g * 4096 + co; float acc = 0.f;
#pragma unroll 8
          for (int ci = 0; ci < 64; ++ci) acc += wr[ci] * pc[ci * 64];
          wt[(size_t)(1536 + n) * D + k] = (bf16)f2bf(acc * psc[n]); } }
    transpose_mat(F, win, CIN, 768, 384, D, wt, 1792, scr);
    transpose_mat(F, win, CIN, 1920, 384, D, wt, 2176, scr);
    transpose_mat(F, INP(I_WOUT) + (size_t)l * D * D, D, 0, D, D, base + OW_OUT / 2, 0, scr);
    transpose_mat(F, INP(I_XQ) + (size_t)l * D * D, D, 0, D, D, base + OW_Q / 2, 0, scr);
    transpose_mat(F, INP(I_XKV) + (size_t)l * D * 2 * D, 2 * D, 0, 2 * D, D, base + OW_KV / 2, 0, scr);
    transpose_mat(F, INP(I_XO) + (size_t)l * D * D, D, 0, D, D, base + OW_O / 2, 0, scr);
    float* wf = (float*)(WSB + WS_WF) + (size_t)l * 8 * D;
    for (int i = (F.vcu * NWAVES + F.wave) * 64 + F.lane; i < 6 * D; i += F.G * NWAVES * 64) { const int j = i / D, k = i % D; wf[j * D + k] = win[(size_t)k * CIN + 2304 + j]; }
}

#define DPP_ADD(v, ctrl) ((v) + __int_as_float(__builtin_amdgcn_update_dpp(0, __float_as_int(v), (ctrl), 0xf, 0xf, false)))
__device__ __forceinline__ float wave_sum_fast(float v) {
    v = DPP_ADD(v, 0xB1); v = DPP_ADD(v, 0x4E); v = DPP_ADD(v, 0x141); v = DPP_ADD(v, 0x140);
    const int iv = __float_as_int(v);
    return (__int_as_float(__builtin_amdgcn_readlane(iv, 0)) + __int_as_float(__builtin_amdgcn_readlane(iv, 16))) + (__int_as_float(__builtin_amdgcn_readlane(iv, 32)) + __int_as_float(__builtin_amdgcn_readlane(iv, 48)));
}
struct ThinIn { f32x4 v[4]; v2u d0[4]; v2u d1[4]; float g0, g1; };
template <int DELTA>
__device__ __forceinline__ void thin_load(ThinIn& t, int row, int lane, const float* h_in, const bf16* delta, const int* tokt) {
#pragma unroll
    for (int j = 0; j < 4; ++j) t.v[j] = *(const f32x4*)(h_in + (size_t)row * D + 4 * lane + 256 * j);
    if constexpr (DELTA == 1) {
#pragma unroll
        for (int j = 0; j < 4; ++j) t.d0[j] = *(const v2u*)(delta + (size_t)row * D + 4 * lane + 256 * j);
    }
    if constexpr (DELTA == 2) {
        const int r0 = tokt[row * 8 + 1], r1 = tokt[row * 8 + 4]; t.g0 = __int_as_float(tokt[row * 8 + 2]); t.g1 = __int_as_float(tokt[row * 8 + 5]);
#pragma unroll
        for (int j = 0; j < 4; ++j) { t.d0[j] = *(const v2u*)(delta + (size_t)r0 * D + 4 * lane + 256 * j); t.d1[j] = *(const v2u*)(delta + (size_t)r1 * D + 4 * lane + 256 * j); }
    }
}
template <int DELTA, bool WRITE_H, bool WRITE_HN, int EXTRA>
__device__ __forceinline__ void thin_rows(Frame& F, const float* h_in, const bf16* delta, const float* g_post, float* h_out, const float* g_pre, bf16* hn_out,
                                          const float* wx, const float* bfo, float* logf, int* tokt, gu32* cnt, int wg0 = 0) {
    if ((int)blockIdx.x < wg0) return;
    const int gw = wg0 ? ((int)blockIdx.x - wg0) * NWAVES + F.wave : F.vcu * NWAVES + F.wave, NGW = (F.G - wg0) * NWAVES, lane = F.lane;
    constexpr int NX = EXTRA == 1 ? 6 : (EXTRA == 2 ? 8 : 0);
    f32x4 gp[4], gq[4], wv[NX > 0 ? NX : 1][4];
#pragma unroll
    for (int j = 0; j < 4; ++j) { if constexpr (DELTA != 0) gp[j] = *(const f32x4*)(g_post + 4 * lane + 256 * j); if constexpr (WRITE_HN) gq[j] = *(const f32x4*)(g_pre + 4 * lane + 256 * j); }
#pragma unroll
    for (int e = 0; e < NX; ++e)
#pragma unroll
        for (int j = 0; j < 4; ++j) wv[e][j] = *(const f32x4*)(wx + e * D + 4 * lane + 256 * j);
    float bfl = 0.f; if constexpr (EXTRA == 1) { if (lane < 6) bfl = bfo[lane]; }
    ThinIn cur, nxt;
    if (gw < NTOK) thin_load<DELTA>(cur, gw, lane, h_in, delta, tokt);
    for (int row = gw; row < NTOK; row += NGW) {
        if (row + NGW < NTOK) thin_load<DELTA>(nxt, row + NGW, lane, h_in, delta, tokt);
        f32x4 v[4];
#pragma unroll
        for (int j = 0; j < 4; ++j) v[j] = cur.v[j];
        if constexpr (DELTA != 0) {
            f32x4 d[4];
            if constexpr (DELTA == 1) {
#pragma unroll
                for (int j = 0; j < 4; ++j) { const v2u r = cur.d0[j]; d[j] = (f32x4){bflo(r.x), bfhi(r.x), bflo(r.y), bfhi(r.y)}; }
            } else {
                const float g0 = cur.g0, g1 = cur.g1;
#pragma unroll
                for (int j = 0; j < 4; ++j) { const v2u r0 = cur.d0[j], r1 = cur.d1[j];
                    d[j] = (f32x4){g0 * bflo(r0.x) + g1 * bflo(r1.x), g0 * bfhi(r0.x) + g1 * bfhi(r1.x), g0 * bflo(r0.y) + g1 * bflo(r1.y), g0 * bfhi(r0.y) + g1 * bfhi(r1.y)}; }
            }
            float ss = 0.f;
#pragma unroll
            for (int j = 0; j < 4; ++j) ss += (d[j].x * d[j].x + d[j].y * d[j].y) + (d[j].z * d[j].z + d[j].w * d[j].w);
            const float rs = rsqrtf(wave_sum_fast(ss) * (1.f / D) + EPS);
#pragma unroll
            for (int j = 0; j < 4; ++j) v[j] = v[j] + d[j] * rs * gp[j];
        }
        if constexpr (WRITE_H) {
#pragma unroll
            for (int j = 0; j < 4; ++j) *(f32x4*)(h_out + (size_t)row * D + 4 * lane + 256 * j) = v[j];
        }
        if constexpr (WRITE_HN) {
            float ss = 0.f;
#pragma unroll
            for (int j = 0; j < 4; ++j) ss += (v[j].x * v[j].x + v[j].y * v[j].y) + (v[j].z * v[j].z + v[j].w * v[j].w);
            const float rs = rsqrtf(wave_sum_fast(ss) * (1.f / D) + EPS);
#pragma unroll
            for (int j = 0; j < 4; ++j) { v[j] = v[j] * rs * gq[j];
                v2u o; o.x = pk2(v[j].x, v[j].y); o.y = pk2(v[j].z, v[j].w); *(v2u*)(hn_out + (size_t)row * D + 4 * lane + 256 * j) = o; }
            if constexpr (NX > 0) {
                float lg[NX];
#pragma unroll
                for (int e = 0; e < NX; ++e) { float s2 = 0.f;
#pragma unroll
                    for (int j = 0; j < 4; ++j) { const f32x4 w = wv[e][j]; s2 += (v[j].x * w.x + v[j].y * w.y) + (v[j].z * w.z + v[j].w * w.w); }
                    lg[e] = wave_sum_fast(s2); }
                if constexpr (EXTRA == 1) {
                    if (lane < 6) { float x = lg[0];
#pragma unroll
                        for (int e = 1; e < 6; ++e) x = (lane == e) ? lg[e] : x;
                        logf[(size_t)row * 8 + lane] = log_sigmoid(x + bfl); }
                } else {
                    int e0 = 0; float v0 = lg[0];
#pragma unroll
                    for (int e = 1; e < 8; ++e) if (lg[e] > v0) { v0 = lg[e]; e0 = e; }
                    int e1 = -1; float v1 = -INFINITY;
#pragma unroll
                    for (int e = 0; e < 8; ++e) if (e != e0 && lg[e] > v1) { v1 = lg[e]; e1 = e; }
                    if (lane == 0) {
                        const float g0 = 1.f / (1.f + __expf(v1 - v0)), g1 = 1.f - g0;
                        const unsigned p0 = __hip_atomic_fetch_add(cnt + e0, 1u, RLX_AGENT), p1 = __hip_atomic_fetch_add(cnt + e1, 1u, RLX_AGENT);
                        int* t = tokt + (size_t)row * 8; t[0] = e0; t[1] = (int)p0; t[2] = __float_as_int(g0); t[3] = e1; t[4] = (int)p1; t[5] = __float_as_int(g1);
                    }
                }
            }
        }
        cur = nxt;
    }
}
__device__ __forceinline__ void mem_norm(Frame& F, const float* mem, const float* g, bf16* mn) {
    const int gw = F.vcu * NWAVES + F.wave, NGW = F.G * NWAVES, lane = F.lane;
    for (int row = gw; row < NMEM; row += NGW) {
        f32x4 v[4]; float ss = 0.f;
#pragma unroll
        for (int j = 0; j < 4; ++j) { v[j] = *(const f32x4*)(mem + (size_t)row * D + 4 * lane + 256 * j); ss += (v[j].x * v[j].x + v[j].y * v[j].y) + (v[j].z * v[j].z + v[j].w * v[j].w); }
        const float rs = rsqrtf(wave_sum(ss) * (1.f / D) + EPS);
#pragma unroll
        for (int j = 0; j < 4; ++j) { const f32x4 gg = *(const f32x4*)(g + 4 * lane + 256 * j); v[j] = v[j] * rs * gg;
            v2u o; o.x = pk2(v[j].x, v[j].y); o.y = pk2(v[j].z, v[j].w); *(v2u*)(mn + (size_t)row * D + 4 * lane + 256 * j) = o; }
    }
}
__device__ __forceinline__ void scan_logf(Frame& F, const float* logf, float* ccum) {
    if (blockIdx.x >= NBATCH * NFX) return;
    const int b = blockIdx.x / NFX, h = blockIdx.x % NFX, tid = F.tid;
    LAS float* wsum = (LAS float*)(F.lds + RING_OFF);
    float x[16]; float run = 0.f;
#pragma unroll
    for (int i = 0; i < 16; ++i) { run += logf[((size_t)b * SEQ + tid * 16 + i) * 8 + h]; x[i] = run; }
    float incl = run;
#pragma unroll
    for (int o = 1; o < 64; o <<= 1) { const float t = __shfl_up(incl, o); if (F.lane >= o) incl += t; }
    if (F.lane == 63) wsum[F.wave] = incl;
    LDS_WAIT(); __syncthreads();
    float base = incl - run;
    for (int w = 0; w < F.wave; ++w) base += wsum[w];
    float* o = ccum + ((size_t)b * NFX + h) * SEQ + tid * 16;
#pragma unroll
    for (int i = 0; i < 16; ++i) o[i] = (base + x[i]) * 1.4426950408889634f;
    __syncthreads();
}

__device__ __forceinline__ void pool_window(Frame& F, const bf16* proj, bf16* mix) {
    const int g0 = (F.vcu * NWAVES + F.wave) * 64 + F.lane, GS = F.G * NWAVES * 64;
    for (int it = g0; it < NTOK * 32; it += GS) {
        const int tok = it >> 5, ch = it & 31, pos = tok % SEQ, win = 2 << (ch >> 3), cnt = (pos + 1 < win) ? pos + 1 : win;
        const bf16* yp = proj + (size_t)tok * PP + C_U + 8 * ch;
        float a[8], y0[8];
        { const v4u q = *(const v4u*)yp; y0[0] = bflo(q.x); y0[1] = bfhi(q.x); y0[2] = bflo(q.y); y0[3] = bfhi(q.y); y0[4] = bflo(q.z); y0[5] = bfhi(q.z); y0[6] = bflo(q.w); y0[7] = bfhi(q.w); }
#pragma unroll
        for (int i = 0; i < 8; ++i) a[i] = y0[i];
        for (int j = 1; j < cnt; ++j) { const v4u q = *(const v4u*)(yp - (size_t)j * PP);
            a[0] += bflo(q.x); a[1] += bfhi(q.x); a[2] += bflo(q.y); a[3] += bfhi(q.y); a[4] += bflo(q.z); a[5] += bfhi(q.z); a[6] += bflo(q.w); a[7] += bfhi(q.w); }
        const float ic = 1.f / (float)cnt;
        v4u w; w.x = pk2(a[0] * ic - y0[0], a[1] * ic - y0[1]); w.y = pk2(a[2] * ic - y0[2], a[3] * ic - y0[3]); w.z = pk2(a[4] * ic - y0[4], a[5] * ic - y0[5]); w.w = pk2(a[6] * ic - y0[6], a[7] * ic - y0[7]);
        *(v4u*)(mix + (size_t)tok * D + SBD + FXD + 8 * ch) = w;
    }
}

typedef short bf16x8 __attribute__((ext_vector_type(8)));
typedef float f32x16 __attribute__((ext_vector_type(16)));
__device__ __forceinline__ int kperm(int r) { const int g = (r >> 2) & 3; const int g2 = (g == 1) ? 2 : (g == 2) ? 1 : g; return (r & 16) + 4 * g2 + (r & 3); }
__device__ __forceinline__ float xhalf(float v) { return __shfl_xor(v, 32); }
__device__ __forceinline__ bf16x8 pack8(const f32x16& p, int s) {
    v4u w; w.x = pg8::cvt_pk_bf16(p[8 * s + 0], p[8 * s + 1]); w.y = pg8::cvt_pk_bf16(p[8 * s + 2], p[8 * s + 3]); w.z = pg8::cvt_pk_bf16(p[8 * s + 4], p[8 * s + 5]); w.w = pg8::cvt_pk_bf16(p[8 * s + 6], p[8 * s + 7]);
    return __builtin_bit_cast(bf16x8, w);
}
__device__ __forceinline__ void store_ot(bf16* dst, const f32x16& o, float sc, int hh) {
#pragma unroll
    for (int g = 0; g < 4; ++g) { v2u w; w.x = pg8::cvt_pk_bf16(o[4 * g] * sc, o[4 * g + 1] * sc); w.y = pg8::cvt_pk_bf16(o[4 * g + 2] * sc, o[4 * g + 3] * sc); *(v2u*)(dst + 8 * g + 4 * hh) = w; }
}

__device__ __forceinline__ void fox_knorm(Frame& F, const bf16* proj, gu32* kmax) {
    const int gw = F.vcu * NWAVES + F.wave, NGW = F.G * NWAVES, lane = F.lane;
    const int NU = NBATCH * NFX * (SEQ / 64);
    for (int u = gw; u < NU; u += NGW) {
        const int bh = u / (SEQ / 64), tb = u % (SEQ / 64), b = bh / NFX, h = bh % NFX;
        const bf16* kr = proj + ((size_t)b * SEQ + tb * 64 + lane) * PP + C_FK + h * HD;
        float ss = 0.f;
#pragma unroll
        for (int i = 0; i < 8; ++i) { const v4u r = *(const v4u*)(kr + 8 * i);
            ss += (bflo(r.x) * bflo(r.x) + bfhi(r.x) * bfhi(r.x)) + (bflo(r.y) * bflo(r.y) + bfhi(r.y) * bfhi(r.y)) + (bflo(r.z) * bflo(r.z) + bfhi(r.z) * bfhi(r.z)) + (bflo(r.w) * bflo(r.w) + bfhi(r.w) * bfhi(r.w)); }
        ss = wave_max(ss);
        if (lane == 0) __hip_atomic_fetch_max(kmax + bh, __float_as_uint(ss), RLX_AGENT);
    }
}
#ifndef FOX_THR
#define FOX_THR 40.0f
#endif
#ifndef SB_EPS
#define SB_EPS 4.0e-18f
#endif
constexpr int AT_STB = 8192 + 8192 + 256;
template <int FOX>
__device__ __forceinline__ void attn_wg(Frame& F, const bf16* proj, const bf16* vt, const float* ccum, const gu32* kmax, bf16* mix) {
    constexpr int NH = FOX ? NFX : NSB, COLQ = FOX ? C_FQ : C_SQ, COLK = FOX ? C_FK : C_SK, VROW0 = FOX ? SBD : 0, OCOL = FOX ? SBD : 0;
    constexpr float L2E = 1.4426950408889634f, SC = 0.125f * L2E;
    LAS unsigned char* L = F.lds + RING_OFF;
    LAS unsigned* flags = (LAS unsigned*)(L + 2 * AT_STB);
    const int tid = F.tid, lane = F.lane, wave = F.wave, r = lane & 31, hh = lane >> 5;
    const int srow = tid >> 3, sch = tid & 7, swr = srow * 128 + 16 * (sch ^ ((srow >> 1) & 7));
    const int krow = kperm(r), ksw = (krow >> 1) & 7, vsw = (r >> 1) & 7;
    const int NT = SEQ / 256, NU = NBATCH * NH * NT;
    for (int u = F.vcu; u < NU; u += F.G) {
        const int bh = u / NT, tile = (NT - 1) - u % NT, b = bh / NH, h = bh % NH, T0 = tile * 256, tq = T0 + 32 * wave + r, myblk = tile * 8 + wave;
        const size_t tokb = (size_t)b * SEQ;
        const float* cc = ccum + (size_t)bh * SEQ;
        const bf16* kg = proj + (tokb + srow) * PP + COLK + h * HD + 8 * sch;
        const bf16* vg = vt + (size_t)(VROW0 + h * HD + srow) * VTP + tokb + 8 * sch;
        bf16x8 qf[4]; float qn = 0.f;
        { const bf16* qp = proj + (tokb + tq) * PP + COLQ + h * HD + 8 * hh;
#pragma unroll
          for (int ks = 0; ks < 4; ++ks) { qf[ks] = *(const bf16x8*)(qp + 16 * ks);
              if (FOX) {
#pragma unroll
                  for (int j = 0; j < 8; ++j) { const float x = bf2f((bf16)qf[ks][j]); qn += x * x; } } } }
        float zb2 = 0.f, ct2 = 0.f;
        if (FOX) { qn += xhalf(qn); zb2 = (0.125f * sqrtf(qn * __uint_as_float(__hip_atomic_load(kmax + bh, RLX_AGENT))) * 1.01f + 0.01f) * L2E; ct2 = cc[tq]; }
        float l = 0.f, cb = 0.f, Rp = 1.f; f32x16 o[2] = {};
        bool mydone = false;
        const int nst = tile * 4 + 4;
        v4u gk, gv; float gc = 0.f;
        { const int k0 = T0 + 192; gk = *(const v4u*)(kg + (size_t)k0 * PP); gv = *(const v4u*)(vg + k0); if (FOX && tid < 64) gc = cc[k0 + tid]; }
        *(LAS v4u*)(L + swr) = gk; *(LAS v4u*)(L + 8192 + swr) = gv; if (FOX && tid < 64) *(LAS float*)(L + 16384 + 4 * tid) = gc;
        LDS_WAIT(); __syncthreads();
        for (int j = 0; j < nst; ++j) {
            const int k0 = T0 + 192 - 64 * j;
            LAS unsigned char* B = L + (j & 1) * AT_STB;
            if (j + 1 < nst) { const int k1 = k0 - 64; gk = *(const v4u*)(kg + (size_t)k1 * PP); gv = *(const v4u*)(vg + k1); if (FOX && tid < 64) gc = cc[k1 + tid]; }
            const int blk0 = k0 >> 5;
            if (blk0 <= myblk && !mydone) {
                const bool dstage = (blk0 == (myblk & ~1));
                f32x16 S0 = {}, S1 = {};
#pragma unroll
                for (int ks = 0; ks < 4; ++ks) { const bf16x8 k1 = *(const LAS bf16x8*)(B + (32 + krow) * 128 + 16 * ((2 * ks + hh) ^ ksw)), k0f = *(const LAS bf16x8*)(B + krow * 128 + 16 * ((2 * ks + hh) ^ ksw));
                    S1 = __builtin_amdgcn_mfma_f32_32x32x16_bf16(k1, qf[ks], S1, 0, 0, 0); S0 = __builtin_amdgcn_mfma_f32_32x32x16_bf16(k0f, qf[ks], S0, 0, 0, 0); }
                if (FOX) {
                    f32x4 c1[4], c0[4];
#pragma unroll
                    for (int q4 = 0; q4 < 4; ++q4) { c1[q4] = *(const LAS f32x4*)(B + 16384 + 4 * (32 + 16 * (q4 >> 1) + 8 * hh + 4 * (q4 & 1))); c0[q4] = *(const LAS f32x4*)(B + 16384 + 4 * (16 * (q4 >> 1) + 8 * hh + 4 * (q4 & 1))); }
                    if (dstage) {
                        float bm = -INFINITY;
#pragma unroll
                        for (int i = 0; i < 16; ++i) { const int kk = 16 * (i >> 3) + 8 * hh + (i & 7);
                            float x1 = S1[i] * SC + (ct2 - c1[i >> 2][i & 3]); if (k0 + 32 + kk > tq) x1 = -INFINITY; S1[i] = x1;
                            float x0 = S0[i] * SC + (ct2 - c0[i >> 2][i & 3]); if (k0 + kk > tq) x0 = -INFINITY; S0[i] = x0; bm = fmaxf(bm, fmaxf(x0, x1)); }
                        bm = fmaxf(bm, xhalf(bm));
                        const float mref = fmaxf(bm, zb2 - 60.f * L2E); cb = ct2 - mref;
#pragma unroll
                        for (int i = 0; i < 16; ++i) { const float p1 = __builtin_amdgcn_exp2f(S1[i] - mref), p0 = __builtin_amdgcn_exp2f(S0[i] - mref); S1[i] = p1; S0[i] = p0; l += p1 + p0; }
                    } else {
#pragma unroll
                        for (int i = 0; i < 16; ++i) { const float p1 = __builtin_amdgcn_exp2f(S1[i] * SC + (cb - c1[i >> 2][i & 3])), p0 = __builtin_amdgcn_exp2f(S0[i] * SC + (cb - c0[i >> 2][i & 3])); S1[i] = p1; S0[i] = p0; l += p1 + p0; }
                    }
                    mydone = __all(zb2 + (cb - c0[0][0]) + 13.f <= __log2f(l) - FOX_THR * L2E);
                } else {
#pragma unroll
                    for (int sbi = 0; sbi < 2; ++sbi) {
                        f32x16& S = sbi ? S0 : S1; const int s0 = k0 + (sbi ? 0 : 32);
                        float om[16];
#pragma unroll
                        for (int i = 0; i < 16; ++i) { const float e = __builtin_amdgcn_exp2f(fabsf(S[i]) * -SC);
                            const float sg = __builtin_amdgcn_rcpf(1.f + e), es = e * sg; const bool pos = S[i] >= 0.f; float bb = pos ? sg : es; float omb = pos ? es : sg;
                            if (dstage) { const int key = s0 + 16 * (i >> 3) + 8 * hh + (i & 7); if (key >= tq) { bb = 0.f; omb = 1.f; } }
                            S[i] = bb; om[i] = omb; }
                        float TA = 1.f, TB = 1.f;
#pragma unroll
                        for (int jj = 7; jj >= 0; --jj) { const float a2 = om[jj], c2 = om[8 + jj]; S[jj] *= TA; S[8 + jj] *= TB; TA *= a2; TB *= c2; }
                        const float PA = xhalf(TA), PB = xhalf(TB);
                        const float offB = Rp * (hh ? 1.f : PB), offA = Rp * TB * PB * (hh ? 1.f : PA);
#pragma unroll
                        for (int jj = 0; jj < 8; ++jj) { S[jj] *= offA; S[8 + jj] *= offB; }
                        Rp *= (TA * TB) * (PA * PB);
                    }
                    mydone = __all(Rp <= SB_EPS);
                }
                const bf16x8 p10 = pack8(S1, 0), p11 = pack8(S1, 1), p00 = pack8(S0, 0), p01 = pack8(S0, 1);
#pragma unroll
                for (int db = 0; db < 2; ++db) { const LAS unsigned char* vr = B + 8192 + (32 * db + r) * 128;
                    const bf16x8 v10 = *(const LAS bf16x8*)(vr + 16 * ((4 + hh) ^ vsw)), v11 = *(const LAS bf16x8*)(vr + 16 * ((6 + hh) ^ vsw)), v00 = *(const LAS bf16x8*)(vr + 16 * (hh ^ vsw)), v01 = *(const LAS bf16x8*)(vr + 16 * ((2 + hh) ^ vsw));
                    o[db] = __builtin_amdgcn_mfma_f32_32x32x16_bf16(v10, p10, o[db], 0, 0, 0); o[db] = __builtin_amdgcn_mfma_f32_32x32x16_bf16(v11, p11, o[db], 0, 0, 0);
                    o[db] = __builtin_amdgcn_mfma_f32_32x32x16_bf16(v00, p00, o[db], 0, 0, 0); o[db] = __builtin_amdgcn_mfma_f32_32x32x16_bf16(v01, p01, o[db], 0, 0, 0); }
            }
            if (lane == 0) flags[(j & 1) * 8 + wave] = mydone ? 1u : 0u;
            if (j + 1 < nst) { LAS unsigned char* Bn = L + ((j + 1) & 1) * AT_STB; *(LAS v4u*)(Bn + swr) = gk; *(LAS v4u*)(Bn + 8192 + swr) = gv; if (FOX && tid < 64) *(LAS float*)(Bn + 16384 + 4 * tid) = gc; }
            LDS_WAIT(); __syncthreads();
            const v4u f0 = *(const LAS v4u*)(flags + (j & 1) * 8), f1 = *(const LAS v4u*)(flags + (j & 1) * 8 + 4);
            if ((f0.x & f0.y & f0.z & f0.w & f1.x & f1.y & f1.z & f1.w) != 0u) break;
        }
        float inv = 1.f;
        if (FOX) { l += xhalf(l); inv = 1.f / l; }
        bf16* op = mix + (tokb + tq) * D + OCOL + h * HD;
        store_ot(op, o[0], inv, hh); store_ot(op + 32, o[1], inv, hh);
        __syncthreads();
    }
}

__device__ __forceinline__ void xa_mfma(Frame& F, const bf16* xq, const bf16* xk, const bf16* xvt, bf16* xo) {
    const int gw = F.vcu * NWAVES + F.wave, NGW = F.G * NWAVES, lane = F.lane, r = lane & 31, hh = lane >> 5;
    const int NU = (NTOK / 32) * XAH;
    for (int u = gw; u < NU; u += NGW) {
        const int hd = u & 3, tb = u >> 2, tok0 = tb * 32, b = tok0 / SEQ;
        bf16x8 qf[16];
        { const bf16* qp = xq + (size_t)(tok0 + r) * D + hd * XAD + 8 * hh;
#pragma unroll
          for (int ks = 0; ks < 16; ++ks) qf[ks] = *(const bf16x8*)(qp + 16 * ks); }
        f32x16 S[8];
#pragma unroll
        for (int kb = 0; kb < 8; ++kb) {
            const bf16* kp = xk + (size_t)(b * MEML + kb * 32 + kperm(r)) * D + hd * XAD + 8 * hh;
            f32x16 acc = {};
#pragma unroll
            for (int ks = 0; ks < 16; ++ks) { const bf16x8 kf = *(const bf16x8*)(kp + 16 * ks); acc = __builtin_amdgcn_mfma_f32_32x32x16_bf16(kf, qf[ks], acc, 0, 0, 0); }
            S[kb] = acc;
        }
        float mx = -INFINITY;
#pragma unroll
        for (int kb = 0; kb < 8; ++kb)
#pragma unroll
            for (int i = 0; i < 16; ++i) mx = fmaxf(mx, S[kb][i]);
        mx = fmaxf(mx, xhalf(mx));
        float sm = 0.f;
#pragma unroll
        for (int kb = 0; kb < 8; ++kb)
#pragma unroll
            for (int i = 0; i < 16; ++i) { const float e = __expf((S[kb][i] - mx) * 0.0625f); S[kb][i] = e; sm += e; }
        sm += xhalf(sm);
        const float inv = 1.f / sm;
        bf16x8 pb[8][2];
#pragma unroll
        for (int kb = 0; kb < 8; ++kb) { pb[kb][0] = pack8(S[kb], 0); pb[kb][1] = pack8(S[kb], 1); }
#pragma unroll
        for (int half = 0; half < 2; ++half) {
            f32x16 o[4] = {};
            const bf16* vp = xvt + (size_t)(hd * XAD + half * 128 + r) * NMEM + b * MEML + 8 * hh;
#pragma unroll
            for (int kb = 0; kb < 8; ++kb)
#pragma unroll
                for (int s2 = 0; s2 < 2; ++s2)
#pragma unroll
                    for (int db = 0; db < 4; ++db) { const bf16x8 vf = *(const bf16x8*)(vp + (size_t)db * 32 * NMEM + kb * 32 + 16 * s2); o[db] = __builtin_amdgcn_mfma_f32_32x32x16_bf16(vf, pb[kb][s2], o[db], 0, 0, 0); }
#pragma unroll
            for (int db = 0; db < 4; ++db) store_ot(xo + (size_t)(tok0 + r) * D + hd * XAD + half * 128 + db * 32, o[db], inv, hh);
        }
    }
}
__device__ __forceinline__ void moe_offsets(const gu32* cnt, int (&pstart)[8], int& nblk) {
    int acc = 0;
#pragma unroll
    for (int e = 0; e < 8; ++e) { const int c = (int)__hip_atomic_load(cnt + e, RLX_AGENT); pstart[e] = acc; acc += ((c + 255) >> 8) << 8; }
    nblk = acc >> 8;
}
__device__ __forceinline__ void moe_gather(Frame& F, const bf16* hn, unsigned char* xs, int* tokt, int* blke) {
    int pstart[8], nblk; moe_offsets(F.ctl + CW_CNT, pstart, nblk);
    if (blockIdx.x == 0 && F.tid < MAXBLK + 1) {
        if (F.tid == MAXBLK) blke[MAXBLK] = nblk;
        else { int e = 0;
#pragma unroll
            for (int j = 1; j < 8; ++j) if (F.tid * 256 >= pstart[j]) e = j;
            blke[F.tid] = e; }
    }
    const int gw = F.vcu * NWAVES + F.wave, NGW = F.G * NWAVES, lane = F.lane;
    for (int row = gw; row < NTOK; row += NGW) {
        int* t = tokt + (size_t)row * 8; const int e0 = t[0], p0 = t[1], e1 = t[3], p1 = t[4];
        int s0 = 0, s1 = 0;
#pragma unroll
        for (int j = 0; j < 8; ++j) { s0 = (e0 == j) ? pstart[j] : s0; s1 = (e1 == j) ? pstart[j] : s1; }
        const int d0 = s0 + p0, d1 = s1 + p1;
        const v4u a = *(const v4u*)(hn + (size_t)row * D + 16 * lane), b = *(const v4u*)(hn + (size_t)row * D + 16 * lane + 8);
        v4u o;
        o.x = pg8::pack4_fp8(bflo(a.x) * 8.f, bfhi(a.x) * 8.f, bflo(a.y) * 8.f, bfhi(a.y) * 8.f); o.y = pg8::pack4_fp8(bflo(a.z) * 8.f, bfhi(a.z) * 8.f, bflo(a.w) * 8.f, bfhi(a.w) * 8.f);
        o.z = pg8::pack4_fp8(bflo(b.x) * 8.f, bfhi(b.x) * 8.f, bflo(b.y) * 8.f, bfhi(b.y) * 8.f); o.w = pg8::pack4_fp8(bflo(b.z) * 8.f, bfhi(b.z) * 8.f, bflo(b.w) * 8.f, bfhi(b.w) * 8.f);
        *(v4u*)(xs + (size_t)d0 * D + 16 * lane) = o; *(v4u*)(xs + (size_t)d1 * D + 16 * lane) = o;
        asm volatile("" ::: "memory");
        if (lane == 0) { t[1] = d0; t[4] = d1; }
    }
}

constexpr int NPHASE = 32;
__global__ void __launch_bounds__(NWAVES * 64, 2) fwd(Args args) {
    extern __shared__ __attribute__((aligned(16))) unsigned char lds[];
    Frame F;
    F.lds = (LAS unsigned char*)lds;
    F.tid = threadIdx.x; F.lane = F.tid & 63; F.wave = __builtin_amdgcn_readfirstlane(F.tid >> 6);
    F.roff = 0; F.G = gridDim.x; { const int bx = blockIdx.x; F.vcu = (F.G % 8 == 0) ? (bx % 8) * (F.G / 8) + bx / 8 : bx; }
    F.ctl = (gu32*)(args.ws + WS_CTL);
    volatile LAS unsigned* MISC = (volatile LAS unsigned*)(F.lds + MISC_OFF);
    for (int u = F.tid; u < (LDS_BYTES - LDSCTL_OFF) / 4; u += NWAVES * 64) ((LAS unsigned*)(F.lds + LDSCTL_OFF))[u] = 0u;
    __syncthreads();
    XcdBarrier bar; bar.bar = (unsigned*)(F.ctl + CW_BAR); bar.x = 0; bar.st = nullptr;
    const int lo = args.ph_lo, hi = args.ph_hi;
    if (hi - lo > 1) bar = xcd_barrier_post((unsigned*)(F.ctl + CW_BAR), MISC + 8);
#ifndef PHASE_MASK
#define PHASE_MASK 0xffffffffffull
#endif
#define IN(k) ((((unsigned long long)(PHASE_MASK) >> (k)) & 1ull) && lo <= (k) && (k) < hi && (fresh(F), true))
#define SEAM(k) do { if (IN(k) && IN((k) + 1)) xcd_barrier(bar); } while (0)
#ifndef PROBE_MASK
#define PROBE_MASK 0ull
#endif
#ifndef PROBE2_MASK
#define PROBE2_MASK 0
#endif
#define TWICE(bit, stmt) do { stmt; if ((PROBE2_MASK >> (bit)) & 1) { xcd_barrier(bar); stmt; } } while (0)
#define REP(k) for (int rep_ = 0; rep_ < (int)(1 + (((unsigned long long)(PROBE_MASK) >> (k)) & 1ull)); ++rep_, (rep_ < (int)(1 + (((unsigned long long)(PROBE_MASK) >> (k)) & 1ull)) ? xcd_barrier(bar) : (void)0))
#define ws WSB
#define scr ((LAS float*)(F.lds + RING_OFF + F.wave * 16384))
#define HN ((bf16*)(ws + R2_HN))
#define MIX ((bf16*)(ws + R2_MIX))
#define PROJ ((bf16*)(ws + R1_PROJ))
#define VT ((bf16*)(ws + R1_VT))
#define BA ((bf16*)(ws + R1_A))
#define BB ((bf16*)(ws + R1_B))
#define ACT ((bf16*)(ws + R1_ACT))
#define XS ((bf16*)(ws + R2_XS))
#define XS8 ((unsigned char*)(ws + WS_XS8))
#define ACT8 ((unsigned char*)(ws + R1_ACT8))
#define LOGF ((float*)(ws + WS_LOGF))
#define CCUM ((float*)(ws + WS_CCUM))
#define TOKT ((int*)(ws + WS_TOKT))
#define BLKE ((int*)(ws + WS_BLKE))
#define MNL(l) ((bf16*)(ws + WS_MN + (size_t)(l) * 2 * MiB))
#define XKL(l) ((bf16*)(ws + WS_XKV + (size_t)(l) * 4 * MiB))
#define XVTL(l) ((bf16*)(ws + WS_XKV + (size_t)(l) * 4 * MiB + 2 * MiB))
    const int bx = (int)blockIdx.x;

#define GEMM_PLAIN(Aptr, Btptr, M_, N_, K_, Optr, ldc_) do { pg8::Gemm g{(const pg8::bf16_t*)(Aptr), (const pg8::bf16_t*)(Btptr), (M_), (N_), (K_)}; pg8::StaticOrder S; S.init(g, F.G, bx); \
        pg8::EpiBf16 E{(pg8::bf16_t*)(Optr), (ldc_), 0}; pg8::gemm_phase<pg8::EpiBf16, pg8::StaticOrder, true, true>(F.lds + RING_OFF, (K_), S, E); } while (0)

    if (IN(0)) REP(0) {
        convert_layer_small(F, 0, (bf16*)(ws + WS_WS0), scr);
        convert_layer_small(F, 1, (bf16*)(ws + WS_WS1), scr);
        transpose_gu(F, INP(I_DG), INP(I_DU), (bf16*)(ws + WS_WGU0), scr);
        transpose_mat(F, INP(I_DD), D, 0, D, DFF, (bf16*)(ws + WS_WD0), 0, scr);
        { float* wr = (float*)(ws + WS_WR); for (int i = (F.vcu * NWAVES + F.wave) * 64 + F.lane; i < 8 * D; i += F.G * NWAVES * 64) { const int e = i / D, k = i % D; wr[e * D + k] = INP(I_RW)[(size_t)k * NE + e]; } }
        mem_norm(F, INP(I_MEM), INP(I_MEMN), MNL(0)); mem_norm(F, INP(I_MEM), INP(I_MEMN) + D, MNL(1));
    }
    SEAM(0);
    if (IN(1)) REP(1) {
        { pg8::MultiOrder<4> S; S.G = F.G; S.c = bx; S.tstep = (size_t)256 * D * 2;
#pragma unroll
          for (int l2 = 0; l2 < 2; ++l2) { const char* wkv = (const char*)(ws + (l2 == 0 ? WS_WS0 : WS_WS1) + OW_KV);
              S.sg[2 * l2] = pg8::Seg{(const char*)MNL(l2), wkv, (pg8::bf16_t*)XKL(l2), NMEM / 256, D / 256, D};
              S.sg[2 * l2 + 1] = pg8::Seg{wkv + (size_t)D * D * 2, (const char*)MNL(l2), (pg8::bf16_t*)XVTL(l2), D / 256, NMEM / 256, NMEM}; }
          pg8::EpiBf16U E; pg8::gemm_phase<pg8::EpiBf16U, pg8::MultiOrder<4>, true, true>(F.lds + RING_OFF, D, S, E); }
        thin_rows<0, false, true, 1>(F, INP(I_X), nullptr, nullptr, nullptr, INP(I_MIXPRE), HN, (const float*)(ws + WS_WF), INP(I_BF), LOGF, nullptr, nullptr, 64);
    }
    SEAM(1);
#pragma unroll
    for (int l = 0; l < DEPTH; ++l) {
        const int p0 = (l == 0) ? 2 : 16;
        const bf16* WSL = (const bf16*)(ws + (l == 0 ? WS_WS0 : WS_WS1));
        const float* h_res = (l == 0) ? INP(I_X) : OUTP;
        if (IN(p0)) REP(p0) {
            scan_logf(F, LOGF, CCUM);
            { pg8::MultiOrder<2> S; S.G = F.G; S.c = bx; S.tstep = (size_t)256 * D * 2;
              S.sg[0] = pg8::Seg{(const char*)HN, (const char*)(WSL + OW_IN / 2), (pg8::bf16_t*)PROJ, NTOK / 256, PP / 256, PP};
              S.sg[1] = pg8::Seg{(const char*)(WSL + OW_IN / 2 + (size_t)PP * D), (const char*)HN, (pg8::bf16_t*)VT, VTN / 256, NTOK / 256, VTP};
              pg8::EpiBf16U E; pg8::gemm_phase<pg8::EpiBf16U, pg8::MultiOrder<2>, true, true>(F.lds + RING_OFF, D, S, E); }
        }
        SEAM(p0);
        if (IN(p0 + 1)) REP(p0 + 1) {
            TWICE(0, fox_knorm(F, PROJ, F.ctl + CW_KMAX + l * 24));
            TWICE(1, attn_wg<0>(F, PROJ, VT, nullptr, nullptr, MIX));
            TWICE(2, pool_window(F, PROJ, MIX));
        }
        SEAM(p0 + 1);
        if (IN(p0 + 2)) REP(p0 + 2) {
            attn_wg<1>(F, PROJ, VT, CCUM, F.ctl + CW_KMAX + l * 24, MIX);
        }
        SEAM(p0 + 2);
        if (IN(p0 + 3)) REP(p0 + 3) GEMM_PLAIN(MIX, WSL + OW_OUT / 2, NTOK, D, D, BA, D);
        SEAM(p0 + 3);
        if (IN(p0 + 4)) REP(p0 + 4) thin_rows<1, true, true, 0>(F, h_res, BA, INP(I_MIXPOST) + l * D, OUTP, INP(I_XAPRE) + l * D, HN, nullptr, nullptr, nullptr, nullptr, nullptr);
        SEAM(p0 + 4);
        if (IN(p0 + 5)) REP(p0 + 5) GEMM_PLAIN(HN, WSL + OW_Q / 2, NTOK, D, D, BB, D);
        SEAM(p0 + 5);
        if (IN(p0 + 6)) REP(p0 + 6) { pg8::XaOrder S{F.G, bx, 0, (const char*)BB, (const char*)XKL(l)}; pg8::EpiXaSoftmax E{(pg8::bf16_t*)BA, (PG8_LAS float*)(F.lds + LDSCTL_OFF + 2048)};
            pg8::gemm_phase<pg8::EpiXaSoftmax, pg8::XaOrder, true, true>(F.lds + RING_OFF, XAD, S, E, D, D); }
        SEAM(p0 + 6);
        if (IN(p0 + 7)) REP(p0 + 7) { pg8::XaOrder S{F.G, bx, 1, (const char*)BA, (const char*)XVTL(l)}; pg8::EpiBf16 E{(pg8::bf16_t*)BB, D, 0};
            pg8::gemm_phase<pg8::EpiBf16, pg8::XaOrder, true, true>(F.lds + RING_OFF, XAD, S, E, D, D); }
        SEAM(p0 + 7);
        if (IN(p0 + 8)) REP(p0 + 8) GEMM_PLAIN(BB, WSL + OW_O / 2, NTOK, D, D, BA, D);
        SEAM(p0 + 8);
        if (l == 0) {
            if (IN(11)) REP(11) thin_rows<1, true, true, 0>(F, OUTP, BA, INP(I_XAPOST), OUTP, INP(I_FFPRE), HN, nullptr, nullptr, nullptr, nullptr, nullptr);
            SEAM(11);
            if (IN(12)) REP(12) { pg8::Gemm g{(const pg8::bf16_t*)HN, (const pg8::bf16_t*)(ws + WS_WGU0), NTOK, 2 * DFF, D}; pg8::StaticOrder S; S.init(g, F.G, bx);
                pg8::EpiSwiGLU E{(pg8::bf16_t*)ACT, DFF, 0}; pg8::gemm_phase<pg8::EpiSwiGLU, pg8::StaticOrder, true, true>(F.lds + RING_OFF, D, S, E); }
            SEAM(12);
            if (IN(13)) REP(13) GEMM_PLAIN(ACT, ws + WS_WD0, NTOK, D, DFF, MIX, D);
            SEAM(13);
            if (IN(14)) REP(14) thin_rows<1, true, true, 1>(F, OUTP, MIX, INP(I_FFPOST), OUTP, INP(I_MIXPRE) + D, HN, (const float*)(ws + WS_WF) + 8 * D, INP(I_BF) + NFX, LOGF, nullptr, nullptr);
            SEAM(14);
            if (IN(15)) REP(15) {
                for (int e = 0; e < NE; ++e) {
                    unsigned char* we = ws + WS_WMOE + (size_t)e * MOE_E_BYTES;
                    transpose_gu_f8(F, INP(I_MG) + (size_t)e * D * DFF, INP(I_MU) + (size_t)e * D * DFF, we);
                    transpose_mat_f8(F, INP(I_MD) + (size_t)e * DFF * D, D, D, DFF, we + MOE_GU_BYTES);
                }
            }
            SEAM(15);
        } else {
            if (IN(25)) REP(25) thin_rows<1, true, true, 2>(F, OUTP, BA, INP(I_XAPOST) + D, OUTP, INP(I_FFPRE) + D, BB, (const float*)(ws + WS_WR), nullptr, nullptr, TOKT, F.ctl + CW_CNT);
            SEAM(25);
            if (IN(26)) REP(26) moe_gather(F, BB, XS8, TOKT, BLKE);
            SEAM(26);
#pragma unroll
            for (int ch = 0; ch < 2; ++ch) {
                const int nblk = BLKE[MAXBLK]; const int c0 = ch * CHUNK_BLK, c1 = (ch == 0) ? ((nblk < CHUNK_BLK) ? nblk : CHUNK_BLK) : nblk; const int nb = c1 > c0 ? c1 - c0 : 0;
                if (IN(27 + 2 * ch)) REP(27 + 2 * ch) { pg8::MoeOrder S{nb, 2 * DFF / 256, F.G, bx, c0, 0, (const char*)XS8, (const char*)(ws + WS_WMOE), (size_t)256 * D, MOE_E_BYTES, BLKE};
                    pg8::EpiSwiGLU8 E{ACT8, DFF, c0, 1.f / 2048.f, 8.f}; pg8::gemm_phase<pg8::EpiSwiGLU8, pg8::MoeOrder, true, true, true>(F.lds + RING_OFF, D / 2, S, E); }
                SEAM(27 + 2 * ch);
                if (IN(28 + 2 * ch)) REP(28 + 2 * ch) { pg8::MoeOrder S{nb, D / 256, F.G, bx, c0, c0, (const char*)ACT8, (const char*)(ws + WS_WMOE + MOE_GU_BYTES), (size_t)256 * DFF, MOE_E_BYTES, BLKE};
                    pg8::EpiBf16S E{(pg8::bf16_t*)XS, D, 0, 1.f / 2048.f}; pg8::gemm_phase<pg8::EpiBf16S, pg8::MoeOrder, true, true, true>(F.lds + RING_OFF, DFF / 2, S, E); }
                SEAM(28 + 2 * ch);
            }
            if (IN(31)) REP(31) thin_rows<2, true, false, 0>(F, OUTP, XS, INP(I_FFPOST) + D, OUTP, nullptr, nullptr, nullptr, nullptr, nullptr, TOKT, nullptr);
        }
    }
#undef IN
#undef SEAM
#undef ws
#undef scr
#undef HN
#undef MIX
#undef PROJ
#undef VT
#undef BA
#undef BB
#undef ACT
#undef XS
#undef XS8
#undef ACT8
#undef LOGF
#undef CCUM
#undef TOKT
#undef BLKE
#undef MNL
#undef XKL
#undef XVTL
}

extern "C" void kernel_launch(void* const* d_in, const int* in_sizes, int n_in, void* d_out, int out_size, void* d_ws, size_t ws_size, hipStream_t stream) {
    static int grid = 0;
    if (grid == 0) {
        if (n_in != 24 || in_sizes[0] != NTOK * D || out_size != NTOK * D || ws_size < WS_END) { fprintf(stderr, "kernel_launch: unexpected shapes / workspace (%d inputs, ws %zu < %zu)\n", n_in, ws_size, (size_t)WS_END); grid = -1; return; }
        int dev = 0, cus = 0, per_cu = 0;
        if (hipGetDevice(&dev) != hipSuccess || hipDeviceGetAttribute(&cus, hipDeviceAttributeMultiprocessorCount, dev) != hipSuccess) { grid = -1; return; }
        if (hipFuncSetAttribute((const void*)fwd, hipFuncAttributeMaxDynamicSharedMemorySize, LDS_BYTES) != hipSuccess) { fprintf(stderr, "kernel_launch: hipFuncSetAttribute failed\n"); grid = -1; return; }
        if (hipOccupancyMaxActiveBlocksPerMultiprocessor(&per_cu, (const void*)fwd, NWAVES * 64, LDS_BYTES) != hipSuccess || per_cu < 1) { fprintf(stderr, "kernel_launch: occupancy query reports %d\n", per_cu); }
        (void)hipGetLastError();
        grid = cus;
    }
    if (grid < 0) return;
    (void)hipMemsetAsync((char*)d_ws + WS_CTL, 0, CTL_ZERO_BYTES, stream);
    Args a{};
    for (int i = 0; i < 24; ++i) a.in[i] = (const float*)d_in[i];
    a.out = (float*)d_out; a.ws = (unsigned char*)d_ws;
#if MK_ONE_LAUNCH
    a.ph_lo = 0; a.ph_hi = NPHASE;
    hipLaunchKernelGGL(fwd, dim3(grid), dim3(NWAVES * 64), LDS_BYTES, stream, a);
#else
    for (int p = 0; p < NPHASE; ++p) {
        a.ph_lo = p; a.ph_hi = p + 1;
        hipLaunchKernelGGL(fwd, dim3(grid), dim3(NWAVES * 64), LDS_BYTES, stream, a);
    }
#endif
}
```
